# Optimizing an MI355X kernel written in HIP

```python
import math
import jax, jax.numpy as jnp
from jax import lax
import numpy as np

D_MODEL = 2048
BATCH = 1
SEQ = 16384
DEPTH = 4
DEC_BATCH = 16
DEC_SEQ = 32
PAST_LEN = 1024

CHUNK = 64
N_MIXERS = 2
N_GDN = (DEPTH + 1) // 2
N_ATT = DEPTH // 2
EPS = 1e-6
GDN_QK_HEADS = 16
GDN_V_HEADS = 32
GDN_DK = 128
GDN_DV = 128
CONV_W = 4
GDN_QKV = 2 * GDN_QK_HEADS * GDN_DK + GDN_V_HEADS * GDN_DV
GDN_Z = GDN_V_HEADS * GDN_DV
GDN_PROJ = GDN_QKV + GDN_Z + 2 * GDN_V_HEADS
ATT_HEADS = 16
ATT_DH = D_MODEL // ATT_HEADS
LEFT_CHUNKS = 8
BAND_PAST = LEFT_CHUNKS * CHUNK
BAND = BAND_PAST + CHUNK
MAX_REL = 256
D_FF = -(-8 * D_MODEL // (3 * 256)) * 256

kernel_name = 'hybrid_gdn_chunkband_stream_step'


def rmsnorm(x, w):
    xf = x.astype(jnp.float32)
    y = xf * lax.rsqrt(jnp.mean(xf * xf, axis=-1, keepdims=True) + EPS)
    return (y * w.astype(jnp.float32)).astype(x.dtype)


def l2norm(x):
    xf = x.astype(jnp.float32)
    return xf * lax.rsqrt(jnp.sum(xf * xf, axis=-1, keepdims=True) + EPS)


def swiglu(h, w_gate, w_up, w_down):
    return (jax.nn.silu(h @ w_gate) * (h @ w_up)) @ w_down


def gated_delta_chunked(q, k, v, g, beta, s0, chunk):
    b, l, h, dk = q.shape
    dv = v.shape[-1]
    n = l // chunk

    def blocks(t):
        t = t.reshape((b, n, chunk) + t.shape[2:])
        return jnp.swapaxes(jnp.swapaxes(t, 0, 1), 2, 3)

    idx = jnp.arange(chunk)
    incl = idx[:, None] >= idx[None, :]
    strict = idx[:, None] > idx[None, :]
    eye = jnp.eye(chunk, dtype=jnp.float32)

    def step(s, blk):
        qc, kc, vc, gc, bc = blk
        gcum = jnp.cumsum(gc, axis=-1)
        decay = jnp.exp(jnp.where(incl, gcum[..., :, None] - gcum[..., None, :], -jnp.inf))
        kk = jnp.einsum('bhid,bhjd->bhij', kc, kc)
        a_mat = eye + jnp.where(strict, kk * decay * bc[..., :, None], 0.0)
        rhs = jnp.concatenate([vc * bc[..., None], kc * (bc * jnp.exp(gcum))[..., None]], axis=-1)
        sol = lax.linalg.triangular_solve(a_mat, rhs, left_side=True, lower=True, unit_diagonal=True)
        u, w = sol[..., :dv], sol[..., dv:]
        v_new = u - jnp.einsum('bhck,bhkv->bhcv', w, s)
        qk = jnp.einsum('bhid,bhjd->bhij', qc, kc) * decay
        o = (jnp.einsum('bhck,bhkv->bhcv', qc * jnp.exp(gcum)[..., None], s)
             + jnp.einsum('bhij,bhjv->bhiv', qk, v_new))
        g_last = gcum[..., -1:]
        s_new = (s * jnp.exp(g_last)[..., None]
                 + jnp.einsum('bhck,bhcv->bhkv', kc * jnp.exp(g_last - gcum)[..., None], v_new))
        return s_new, o

    s, o = lax.scan(step, s0, (blocks(q), blocks(k), blocks(v), blocks(g), blocks(beta)))
    o = jnp.swapaxes(jnp.swapaxes(o, 2, 3), 0, 1).reshape(b, l, h, dv)
    return o, s


def gdn_mixer(h, conv_prev, s0, chunk, w_in, w_conv, a_log, dt_bias, w_norm, w_out):
    b, l, _ = h.shape
    proj = h @ w_in
    qkv = proj[..., :GDN_QKV]
    z = proj[..., GDN_QKV:GDN_QKV + GDN_Z]
    beta_in = proj[..., GDN_QKV + GDN_Z:GDN_QKV + GDN_Z + GDN_V_HEADS]
    a_in = proj[..., GDN_QKV + GDN_Z + GDN_V_HEADS:]
    xc = jnp.concatenate([conv_prev.astype(qkv.dtype), qkv], axis=1)
    conv = xc[:, 0:l] * w_conv[0]
    for j in range(1, CONV_W):
        conv = conv + xc[:, j:j + l] * w_conv[j]
    conv = jax.nn.silu(conv)
    new_conv = xc[:, l:]
    nqk = GDN_QK_HEADS * GDN_DK
    rep = GDN_V_HEADS // GDN_QK_HEADS
    q = conv[..., :nqk].reshape(b, l, GDN_QK_HEADS, GDN_DK)
    k = conv[..., nqk:2 * nqk].reshape(b, l, GDN_QK_HEADS, GDN_DK)
    v = conv[..., 2 * nqk:].reshape(b, l, GDN_V_HEADS, GDN_DV).astype(jnp.float32)
    q = jnp.repeat(l2norm(q) * GDN_DK ** -0.5, rep, axis=2)
    k = jnp.repeat(l2norm(k), rep, axis=2)
    beta = jax.nn.sigmoid(beta_in.astype(jnp.float32))
    g = -jnp.exp(a_log.astype(jnp.float32)) * jax.nn.softplus(a_in.astype(jnp.float32) + dt_bias.astype(jnp.float32))
    o, s = gated_delta_chunked(q, k, v, g, beta, s0.astype(jnp.float32), chunk)
    o = o * lax.rsqrt(jnp.mean(o * o, axis=-1, keepdims=True) + EPS) * w_norm.astype(jnp.float32)
    o = o * jax.nn.silu(z.reshape(b, l, GDN_V_HEADS, GDN_DV).astype(jnp.float32))
    y = o.reshape(b, l, GDN_Z).astype(h.dtype) @ w_out
    return y, new_conv, s


def rel_bias(table, q_pos, k_pos):
    rel = jnp.clip(q_pos[:, None] - k_pos[None, :], -MAX_REL, MAX_REL) + MAX_REL
    return table.astype(jnp.float32)[:, rel]


def attend(q, k, v, bias):
    s = jnp.einsum('bqhd,bkhd->bhqk', q, k).astype(jnp.float32) * ATT_DH ** -0.5 + bias
    p = jax.nn.softmax(s, axis=-1).astype(v.dtype)
    return jnp.einsum('bhqk,bkhd->bqhd', p, v)


def att_project(h, w_qkv, b_qkv):
    b, l, _ = h.shape
    q, k, v = jnp.split(h @ w_qkv + b_qkv, 3, axis=-1)
    shape = (b, l, ATT_HEADS, ATT_DH)
    return q.reshape(shape), k.reshape(shape), v.reshape(shape)


def att_prompt(h, w_qkv, b_qkv, table, w_o, b_o):
    b, l, _ = h.shape
    q, k, v = att_project(h, w_qkv, b_qkv)
    nc = l // CHUNK
    pad = ((0, 0), (BAND_PAST, 0), (0, 0), (0, 0))
    kp, vp = jnp.pad(k, pad), jnp.pad(v, pad)
    qc = jnp.swapaxes(q.reshape(b, nc, CHUNK, ATT_HEADS, ATT_DH), 0, 1)
    offs = jnp.arange(BAND)
    bias = rel_bias(table, jnp.arange(CHUNK) + BAND_PAST, offs)

    def one_chunk(args):
        c, q_blk = args
        start = c * CHUNK
        k_blk = lax.dynamic_slice_in_dim(kp, start, BAND, axis=1)
        v_blk = lax.dynamic_slice_in_dim(vp, start, BAND, axis=1)
        valid = start + offs >= BAND_PAST
        return attend(q_blk, k_blk, v_blk, jnp.where(valid, bias, -jnp.inf))

    o = lax.map(one_chunk, (jnp.arange(nc), qc))
    o = jnp.swapaxes(o, 0, 1).reshape(b, l, D_MODEL)
    keep = min(BAND_PAST, l)
    return o @ w_o + b_o, k[:, l - keep:], v[:, l - keep:]


def att_sample(h, cache_k, cache_v, w_qkv, b_qkv, table, w_o, b_o):
    b, l, _ = h.shape
    r = cache_k.shape[1]
    q, k, v = att_project(h, w_qkv, b_qkv)
    k_all = jnp.concatenate([cache_k.astype(k.dtype), k], axis=1)
    v_all = jnp.concatenate([cache_v.astype(v.dtype), v], axis=1)
    bias = rel_bias(table, jnp.arange(l) + r, jnp.arange(r + l))
    o = attend(q, k_all, v_all, bias).reshape(b, l, D_MODEL)
    return o @ w_o + b_o, k, v


def setup_inputs(seed: int = 0) -> dict:
    key = jax.random.key(seed)
    ks = jax.random.split(key, 24)
    f32 = jnp.float32

    def nrm(k, shape, scale):
        return jax.random.normal(k, shape, f32) * scale

    rows = min(BAND_PAST, PAST_LEN)
    dt = jnp.exp(jax.random.uniform(ks[10], (N_GDN, GDN_V_HEADS), f32, math.log(1e-3), math.log(1e-1)))
    return {
        'x_prompt': nrm(ks[0], (BATCH, SEQ, D_MODEL), 1.0),
        'x_sample': nrm(ks[1], (DEC_BATCH, DEC_SEQ, D_MODEL), 1.0),
        'state_gdn_rec': nrm(ks[2], (N_GDN, DEC_BATCH, GDN_V_HEADS, GDN_DK, GDN_DV), 0.1),
        'state_gdn_conv': nrm(ks[3], (N_GDN, DEC_BATCH, CONV_W - 1, GDN_QKV), 1.0),
        'cache_att_k': nrm(ks[4], (N_ATT, DEC_BATCH, rows, ATT_HEADS, ATT_DH), 1.0),
        'cache_att_v': nrm(ks[5], (N_ATT, DEC_BATCH, rows, ATT_HEADS, ATT_DH), 1.0),
        'norm_mix': 1.0 + nrm(ks[6], (DEPTH, D_MODEL), 0.02),
        'norm_ffn': 1.0 + nrm(ks[7], (DEPTH, D_MODEL), 0.02),
        'norm_final': 1.0 + nrm(ks[8], (D_MODEL,), 0.02),
        'gdn_w_in': nrm(ks[9], (N_GDN, D_MODEL, GDN_PROJ), D_MODEL ** -0.5),
        'gdn_w_conv': nrm(ks[11], (N_GDN, CONV_W, GDN_QKV), 0.5),
        'gdn_a_log': jnp.log(jax.random.uniform(ks[12], (N_GDN, GDN_V_HEADS), f32, 1.0, 16.0)),
        'gdn_dt_bias': dt + jnp.log(-jnp.expm1(-dt)),
        'gdn_w_norm': 1.0 + nrm(ks[13], (N_GDN, GDN_DV), 0.02),
        'gdn_w_out': nrm(ks[14], (N_GDN, GDN_Z, D_MODEL), GDN_Z ** -0.5),
        'att_w_qkv': nrm(ks[15], (N_ATT, D_MODEL, 3 * D_MODEL), D_MODEL ** -0.5),
        'att_b_qkv': nrm(ks[16], (N_ATT, 3 * D_MODEL), 0.02),
        'att_rel_bias': nrm(ks[17], (N_ATT, ATT_HEADS, 2 * MAX_REL + 1), 0.5),
        'att_w_o': nrm(ks[18], (N_ATT, D_MODEL, D_MODEL), D_MODEL ** -0.5),
        'att_b_o': nrm(ks[19], (N_ATT, D_MODEL), 0.02),
        'ffn_w_gate': nrm(ks[20], (DEPTH, D_MODEL, D_FF), D_MODEL ** -0.5),
        'ffn_w_up': nrm(ks[21], (DEPTH, D_MODEL, D_FF), D_MODEL ** -0.5),
        'ffn_w_down': nrm(ks[22], (DEPTH, D_FF, D_MODEL), D_FF ** -0.5),
    }


def reference(x_prompt, x_sample, state_gdn_rec, state_gdn_conv, cache_att_k, cache_att_v,
              norm_mix, norm_ffn, norm_final,
              gdn_w_in, gdn_w_conv, gdn_a_log, gdn_dt_bias, gdn_w_norm, gdn_w_out,
              att_w_qkv, att_b_qkv, att_rel_bias, att_w_o, att_b_o,
              ffn_w_gate, ffn_w_up, ffn_w_down):
    xp, xs = x_prompt, x_sample
    bp = xp.shape[0]
    p_rec, p_conv, p_k, p_v = [], [], [], []
    s_rec, s_conv, s_k, s_v = [], [], [], []
    for layer in range(DEPTH):
        j = layer // N_MIXERS
        hp = rmsnorm(xp, norm_mix[layer])
        hs = rmsnorm(xs, norm_mix[layer])
        if layer % N_MIXERS == 0:
            w = (gdn_w_in[j], gdn_w_conv[j], gdn_a_log[j], gdn_dt_bias[j], gdn_w_norm[j], gdn_w_out[j])
            conv0 = jnp.zeros((bp, CONV_W - 1, GDN_QKV), hp.dtype)
            rec0 = jnp.zeros((bp, GDN_V_HEADS, GDN_DK, GDN_DV), jnp.float32)
            yp, cp, rp = gdn_mixer(hp, conv0, rec0, CHUNK, *w)
            ys, cs, rs = gdn_mixer(hs, state_gdn_conv[j], state_gdn_rec[j], xs.shape[1], *w)
            p_conv.append(cp)
            p_rec.append(rp.astype(x_prompt.dtype))
            s_conv.append(cs.astype(state_gdn_conv.dtype))
            s_rec.append(rs.astype(state_gdn_rec.dtype))
        else:
            w = (att_w_qkv[j], att_b_qkv[j], att_rel_bias[j], att_w_o[j], att_b_o[j])
            yp, kp, vp = att_prompt(hp, *w)
            ys, kn, vn = att_sample(hs, cache_att_k[j], cache_att_v[j], *w)
            p_k.append(kp)
            p_v.append(vp)
            s_k.append(kn)
            s_v.append(vn)
        xp = xp + yp
        xs = xs + ys
        xp = xp + swiglu(rmsnorm(xp, norm_ffn[layer]), ffn_w_gate[layer], ffn_w_up[layer], ffn_w_down[layer])
        xs = xs + swiglu(rmsnorm(xs, norm_ffn[layer]), ffn_w_gate[layer], ffn_w_up[layer], ffn_w_down[layer])
    y_prompt = rmsnorm(xp, norm_final)
    y_sample = rmsnorm(xs, norm_final)
    prompt_gdn_rec = jnp.stack(p_rec, axis=0)
    prompt_gdn_conv = jnp.stack(p_conv, axis=0)
    prompt_att_k = jnp.stack(p_k, axis=0)
    prompt_att_v = jnp.stack(p_v, axis=0)
    sample_gdn_rec = jnp.stack(s_rec, axis=0)
    sample_gdn_conv = jnp.stack(s_conv, axis=0)
    sample_att_k = jnp.stack(s_k, axis=0)
    sample_att_v = jnp.stack(s_v, axis=0)
    return (y_prompt, y_sample, prompt_gdn_rec, prompt_gdn_conv, prompt_att_k, prompt_att_v,
            sample_gdn_rec, sample_gdn_conv, sample_att_k, sample_att_v)
```

```cpp
#ifndef EMU
#include <hip/hip_runtime.h>
#include <cstdio>
typedef short bf16x8 __attribute__((ext_vector_type(8)));
typedef short bf16x4 __attribute__((ext_vector_type(4)));
typedef float f32x16 __attribute__((ext_vector_type(16)));
typedef float f32x4 __attribute__((ext_vector_type(4)));
typedef float f32x2 __attribute__((ext_vector_type(2)));
typedef unsigned u32x4 __attribute__((ext_vector_type(4)));
typedef unsigned u32x2 __attribute__((ext_vector_type(2)));
#define LAS __attribute__((address_space(3)))
#define MFMA32(a, b, c) __builtin_amdgcn_mfma_f32_32x32x16_bf16((a), (b), (c), 0, 0, 0)
#define MFMA16(a, b, c) __builtin_amdgcn_mfma_f32_16x16x32_bf16((a), (b), (c), 0, 0, 0)
#define RFL(x) __builtin_amdgcn_readfirstlane(x)
#define WG_BARRIER() do { asm volatile("s_waitcnt lgkmcnt(0)" ::: "memory"); __builtin_amdgcn_s_barrier(); asm volatile("" ::: "memory"); } while (0)
#define WG_BARRIER_WAVE() asm volatile("s_waitcnt lgkmcnt(0)" ::: "memory")
#define FAST_RCP(x) __builtin_amdgcn_rcpf(x)
#define READLANE_F(v, l) __builtin_bit_cast(float, __builtin_amdgcn_readlane(__builtin_bit_cast(int, (float)(v)), (l)))
#define FAST_EXP2(x) __builtin_amdgcn_exp2f(x)
#define ANY_LANE(p) (__builtin_amdgcn_ballot_w64(p) != 0ull)
#define FAST_RSQ(x) __builtin_amdgcn_rsqf(x)
#define CFENCE() asm volatile("" ::: "memory")
#define SCHED_FENCE() __builtin_amdgcn_sched_barrier(0)
#define LOADER_PACE() do {} while (0)
#define PIN_F(x) asm volatile("" : "+v"(x) :: "memory")
typedef short s16x4_t __attribute__((ext_vector_type(4)));
#define LDS_TR16(p) __builtin_bit_cast(u32x2, __builtin_amdgcn_ds_read_tr16_b64_v4i16((LAS s16x4_t*)(p)))
#else
#define LAS
#define MFMA32(a, b, c) emu::mfma32((a), (b), (c))
#define MFMA16(a, b, c) emu::mfma16((a), (b), (c))
#define RFL(x) (x)
#define WG_BARRIER() __syncthreads()
#define WG_BARRIER_WAVE() emu::wave_sync()
#define FAST_RCP(x) (1.0f / (x))
#define READLANE_F(v, l) emu::shfl((float)(v), (l))
#define FAST_EXP2(x) exp2f(x)
#define ANY_LANE(p) (emu::shfl_any(p))
#define FAST_RSQ(x) (1.0f / sqrtf(x))
#define CFENCE() do {} while (0)
#define SCHED_FENCE() do {} while (0)
#define LOADER_PACE() do {} while (0)
#define PIN_F(x) do {} while (0)
static inline u32x2 emu_lds_tr16(const void* p) {
    const int l = emu::lane(); unsigned short e[4];
    for (int q = 0; q < 4; ++q) { const unsigned long long a = emu::shfl((unsigned long long)(size_t)p, (l & ~15) + 4 * q + ((l & 15) >> 2)); e[q] = *(const unsigned short*)((size_t)a + 2 * (l & 3)); }
    u32x2 r; r.x = e[0] | ((unsigned)e[1] << 16); r.y = e[2] | ((unsigned)e[3] << 16); return r;
}
#define LDS_TR16(p) emu_lds_tr16((const void*)(p))
#endif
typedef unsigned short bf16;
#ifndef EMU
__device__ __forceinline__ int tid_opaque() { int t = threadIdx.x; asm volatile("" : "+v"(t)); return t; }
#else
static inline int tid_opaque() { return threadIdx.x; }
#endif

constexpr int DM = 2048, SEQ = 16384, DEPTH = 4, DECB = 16, DECS = 32;
constexpr int MTOK = SEQ + DECB * DECS;
constexpr int NCH = SEQ / 64;
constexpr int NCIDX = NCH + DECB;
constexpr int GQKV = 8192, GZ = 4096, GPROJ = 12352, GPROJ_PAD = 12544, PPITCH = 12288;
constexpr int HV = 32, HK = 16, DK = 128;
constexpr int DFF = 5632;
constexpr int AH = 16, ADH = 128, MAXREL = 256;
constexpr float EPS = 1e-6f;

__device__ __forceinline__ unsigned f2bf(float f) { unsigned u = __builtin_bit_cast(unsigned, f); return (u + 0x7fffu + ((u >> 16) & 1u)) >> 16; }
#ifndef EMU
typedef __bf16 bf16v2_t __attribute__((ext_vector_type(2)));
__device__ __forceinline__ unsigned pk2(float lo, float hi) { f32x2 v; v.x = lo; v.y = hi; return __builtin_bit_cast(unsigned, __builtin_convertvector(v, bf16v2_t)); }
#else
__device__ __forceinline__ unsigned pk2(float lo, float hi) { return f2bf(lo) | (f2bf(hi) << 16); }
#endif
__device__ __forceinline__ float bf2f(unsigned short b) { return __builtin_bit_cast(float, ((unsigned)b) << 16); }
__device__ __forceinline__ float bflo(unsigned w) { return __builtin_bit_cast(float, w << 16); }
__device__ __forceinline__ float bfhi(unsigned w) { return __builtin_bit_cast(float, w & 0xffff0000u); }
__device__ __forceinline__ float wave_sum(float v) {
#pragma unroll
    for (int o = 1; o < 64; o <<= 1) v += __shfl_xor(v, o);
    return v;
}
__device__ __forceinline__ float sigmoidf_(float x) { return FAST_RCP(1.0f + __expf(-x)); }
__device__ __forceinline__ float siluf_(float x) { return x * FAST_RCP(1.0f + __expf(-x)); }
__device__ __forceinline__ float softplusf_(float x) { return x > 20.f ? x : log1pf(__expf(x)); }
__device__ __forceinline__ bf16x8 pack8(float a0, float a1, float a2, float a3, float a4, float a5, float a6, float a7) {
    u32x4 w; w.x = pk2(a0, a1); w.y = pk2(a2, a3); w.z = pk2(a4, a5); w.w = pk2(a6, a7); return __builtin_bit_cast(bf16x8, w);
}
__device__ __forceinline__ bf16x8 acc_frag(const f32x16& v, int s) {
    return s == 0 ? pack8(v[0], v[1], v[2], v[3], v[4], v[5], v[6], v[7]) : pack8(v[8], v[9], v[10], v[11], v[12], v[13], v[14], v[15]);
}
__device__ __forceinline__ int accrow(int r, int h) { return (r & 3) + 8 * (r >> 2) + 4 * h; }
__device__ __forceinline__ int permk(int h, int j) { return 8 * (j >> 2) + 4 * h + (j & 3); }
#ifndef EMU
namespace pg8 {
#define PG8_LAS __attribute__((address_space(3)))
typedef unsigned short bf16_t;
typedef short bf16x8 __attribute__((ext_vector_type(8)));
typedef float f32x4 __attribute__((ext_vector_type(4)));
typedef unsigned u32x4 __attribute__((ext_vector_type(4)));
constexpr int BM = 256, BK = 64, HALF = 128, HTB = HALF * BK * 2  , STAGE_BYTES = 8 * HTB, NXCD = 8, WGM = 4;

__host__ __device__ __forceinline__ int lds_byte(int r, int c) { const int st = (r >> 4) * 2 + (c >> 5), rr = r & 15, cc = c & 31, ob = rr * 64 + cc * 2; return st * 1024 + (ob ^ (((ob >> 9) & 1) << 5)); }
__host__ __device__ __forceinline__ void stage_rc(int b, int& R, int& C) { const int st = b / 1024, sb = b % 1024, swz = sb ^ (((sb >> 9) & 1) << 5); R = (st >> 1) * 16 + swz / 64; C = (st & 1) * 32 + (swz % 64) / 2; }
__host__ __device__ __forceinline__ int perm32(int rho) { const int n = rho >> 4, i = rho & 15; return 8 * (i >> 2) + 4 * n + (i & 3); }

struct Unit { int pm, pn; };
struct Gemm { const bf16_t* A; const bf16_t* Bt; int M, N, K, ld; const bf16_t* A2 = nullptr; int msplit = 1 << 30; const float* R = nullptr; };

struct StaticOrder {
    int nM, nN, nwg, G, c;
    __host__ __device__ void init(int M, int N, int G_, int c_) { nM = M / BM; nN = N / BM; nwg = nM * nN; G = G_; c = c_; }
    __host__ __device__ bool next(int i, Unit& u) const {
        const long L = (long)i * G + c; if (L >= nwg) return false;
        int wgid = (int)L; { const int q = nwg / NXCD, r = nwg % NXCD, xcd = wgid % NXCD, off = wgid / NXCD; wgid = (xcd < r ? xcd * (q + 1) : r * (q + 1) + (xcd - r) * q) + off; }
        const int nig = WGM * nN, gid = wgid / nig, fm = gid * WGM, gsz = (nM - fm) < WGM ? (nM - fm) : WGM;
        u.pm = fm + ((wgid % nig) % gsz); u.pn = (wgid % nig) / gsz; return true;
    }
    __device__ __forceinline__ void a_ready(const Unit&) const {}
    __device__ __forceinline__ void done(const Unit&) const {}
};
__device__ __forceinline__ unsigned cvt_pk_bf16(float lo, float hi) { unsigned r; asm volatile("v_cvt_pk_bf16_f32 %0, %1, %2" : "=v"(r) : "v"(lo), "v"(hi)); return r; }

__device__ __forceinline__ float silu_f(float x) { return x * __builtin_amdgcn_rcpf(1.0f + __expf(-x)); }
struct EpiProj {
    static constexpr bool PERM = true, AFTER_DRAIN = false;
    bf16_t* O; int ldc; float* BA; int n_main;
    __device__ __forceinline__ void operator()(const f32x4 (&acc)[2][2][4][2], const Unit& u, int wr, int wc, int fr, int fq) const {
        const int row0 = u.pm * BM + wr * 64 + fr, col0 = u.pn * BM + wc * 32 + 8 * fq;
        if (u.pn * BM < n_main) {
#pragma unroll
            for (int ai = 0; ai < 2; ++ai)
#pragma unroll
                for (int m = 0; m < 4; ++m) { bf16_t* rowp = O + (size_t)(row0 + ai * HALF + m * 16) * ldc + col0;
#pragma unroll
                    for (int bj = 0; bj < 2; ++bj) { const f32x4 v0 = acc[ai][bj][m][0], v1 = acc[ai][bj][m][1];
                        u32x4 w; w.x = cvt_pk_bf16(v0[0], v0[1]); w.y = cvt_pk_bf16(v0[2], v0[3]); w.z = cvt_pk_bf16(v1[0], v1[1]); w.w = cvt_pk_bf16(v1[2], v1[3]);
                        *(u32x4*)(rowp + bj * HALF) = w; } }
        } else if (wc < 2) {
#pragma unroll
            for (int ai = 0; ai < 2; ++ai)
#pragma unroll
                for (int m = 0; m < 4; ++m) { float* rowp = BA + (size_t)(row0 + ai * HALF + m * 16) * 64 + wc * 32 + 8 * fq;
                    *(f32x4*)(rowp) = acc[ai][0][m][0]; *(f32x4*)(rowp + 4) = acc[ai][0][m][1]; }
        }
    }
};
struct EpiResid {
    static constexpr bool PERM = false, AFTER_DRAIN = false;
    float* X; int ldc; const float* bias; const float* Xin;
    __device__ __forceinline__ void operator()(const f32x4 (&acc)[2][2][4][2], const Unit& u, int wr, int wc, int fr, int fq) const {
        const int row0 = u.pm * BM + wr * 64 + fr, col0 = u.pn * BM + wc * 32 + 4 * fq;
        f32x4 bv[2][2];
#pragma unroll
        for (int bj = 0; bj < 2; ++bj)
#pragma unroll
            for (int n = 0; n < 2; ++n) bv[bj][n] = bias ? *(const f32x4*)(bias + col0 + bj * HALF + n * 16) : (f32x4){0.f, 0.f, 0.f, 0.f};
#pragma unroll
        for (int ai = 0; ai < 2; ++ai)
#pragma unroll
            for (int m = 0; m < 4; ++m) { float* rowp = X + (size_t)(row0 + ai * HALF + m * 16) * ldc + col0;
                f32x4 xv[2][2];
#pragma unroll
                for (int bj = 0; bj < 2; ++bj)
#pragma unroll
                    for (int n = 0; n < 2; ++n) xv[bj][n] = *(const f32x4*)(Xin + (size_t)(row0 + ai * HALF + m * 16) * ldc + col0 + bj * HALF + n * 16);
#pragma unroll
                for (int bj = 0; bj < 2; ++bj)
#pragma unroll
                    for (int n = 0; n < 2; ++n) *(f32x4*)(rowp + bj * HALF + n * 16) = xv[bj][n] + acc[ai][bj][m][n] + bv[bj][n]; }
    }
};
template <bool FIRST> struct EpiResidH {
    static constexpr bool PERM = true, AFTER_DRAIN = false;
    bf16_t* XH; int ldc; const float* bias; const float* Xf; float* SL;
    __device__ __forceinline__ void operator()(const f32x4 (&acc)[2][2][4][2], const Unit& u, int wr, int wc, int fr, int fq) const {
        const int row0 = u.pm * BM + wr * 64 + fr, col0 = u.pn * BM + wc * 32 + 8 * fq;
        f32x4 bv[2][2];
#pragma unroll
        for (int bj = 0; bj < 2; ++bj)
#pragma unroll
            for (int n = 0; n < 2; ++n) bv[bj][n] = bias ? *(const f32x4*)(bias + col0 + bj * HALF + 4 * n) : (f32x4){0.f, 0.f, 0.f, 0.f};
#pragma unroll
        for (int ai = 0; ai < 2; ++ai)
#pragma unroll
            for (int m = 0; m < 4; ++m) { const size_t ro = (size_t)(row0 + ai * HALF + m * 16) * ldc + col0;
                f32x4 x0[2], x1[2];
                if constexpr (FIRST) {
#pragma unroll
                    for (int bj = 0; bj < 2; ++bj) { x0[bj] = *(const f32x4*)(Xf + ro + bj * HALF); x1[bj] = *(const f32x4*)(Xf + ro + bj * HALF + 4); }
                } else {
                    u32x4 xw[2];
#pragma unroll
                    for (int bj = 0; bj < 2; ++bj) xw[bj] = *(const u32x4*)(XH + ro + bj * HALF);
#pragma unroll
                    for (int bj = 0; bj < 2; ++bj) { x0[bj] = (f32x4){bflo(xw[bj].x), bfhi(xw[bj].x), bflo(xw[bj].y), bfhi(xw[bj].y)}; x1[bj] = (f32x4){bflo(xw[bj].z), bfhi(xw[bj].z), bflo(xw[bj].w), bfhi(xw[bj].w)}; }
                }
                float ss = 0.f;
#pragma unroll
                for (int bj = 0; bj < 2; ++bj) { const f32x4 v0 = x0[bj] + acc[ai][bj][m][0] + bv[bj][0], v1 = x1[bj] + acc[ai][bj][m][1] + bv[bj][1];
                    u32x4 w; w.x = cvt_pk_bf16(v0[0], v0[1]); w.y = cvt_pk_bf16(v0[2], v0[3]); w.z = cvt_pk_bf16(v1[0], v1[1]); w.w = cvt_pk_bf16(v1[2], v1[3]);
                    *(u32x4*)(XH + ro + bj * HALF) = w;
                    ss += ((v0[0] * v0[0] + v0[1] * v0[1]) + (v0[2] * v0[2] + v0[3] * v0[3])) + ((v1[0] * v1[0] + v1[1] * v1[1]) + (v1[2] * v1[2] + v1[3] * v1[3])); }
                ss += __shfl_xor(ss, 16); ss += __shfl_xor(ss, 32);
                if (fq == 0) SL[(size_t)(row0 + ai * HALF + m * 16) * 32 + u.pn * 4 + wc] = ss; }
    }
};
struct SingleUnit {
    int pm, pn; bool valid;
    __device__ bool next(int i, Unit& u) const { if (i != 0 || !valid) return false; u.pm = pm; u.pn = pn; return true; }
    __device__ __forceinline__ void a_ready(const Unit&) const {}
    __device__ __forceinline__ void done(const Unit&) const {}
};
struct EpiAtomic {
    static constexpr bool PERM = false, AFTER_DRAIN = false;
    float* X; int ldc; const float* bias;
    __device__ __forceinline__ void operator()(const f32x4 (&acc)[2][2][4][2], const Unit& u, int wr, int wc, int fr, int fq) const {
        const int row0 = u.pm * BM + wr * 64 + fr, col0 = u.pn * BM + wc * 32 + 4 * fq;
#pragma unroll
        for (int ai = 0; ai < 2; ++ai)
#pragma unroll
            for (int m = 0; m < 4; ++m) { float* rowp = X + (size_t)(row0 + ai * HALF + m * 16) * ldc + col0;
#pragma unroll
                for (int bj = 0; bj < 2; ++bj)
#pragma unroll
                    for (int n = 0; n < 2; ++n) { f32x4 v = acc[ai][bj][m][n]; if (bias) v = v + *(const f32x4*)(bias + col0 + bj * HALF + n * 16);
                        float* q = rowp + bj * HALF + n * 16; unsafeAtomicAdd(q, v[0]); unsafeAtomicAdd(q + 1, v[1]); unsafeAtomicAdd(q + 2, v[2]); unsafeAtomicAdd(q + 3, v[3]); } }
    }
};
struct EpiQkv {
    static constexpr bool PERM = true, AFTER_DRAIN = false;
    bf16_t* O; int ldc; const float* bias; float* kp; long dv, ds;
    __device__ __forceinline__ void operator()(const f32x4 (&acc)[2][2][4][2], const Unit& u, int wr, int wc, int fr, int fq) const {
        const int row0 = u.pm * BM + wr * 64 + fr, col0 = u.pn * BM + wc * 32 + 8 * fq;
        f32x4 bv[2][2];
#pragma unroll
        for (int bj = 0; bj < 2; ++bj)
#pragma unroll
            for (int n = 0; n < 2; ++n) bv[bj][n] = *(const f32x4*)(bias + col0 + bj * HALF + 4 * n);
        const int sect = (u.pn * BM) >> 11;
        const bool keep = (u.pm >= 62) && sect > 0;
        float* kvbase = kp + (sect == 2 ? dv : 0l) + (u.pm >= 64 ? ds : 0l);
        const int rbase = (u.pm < 64) ? 62 * BM : 64 * BM;
#pragma unroll
        for (int ai = 0; ai < 2; ++ai)
#pragma unroll
            for (int m = 0; m < 4; ++m) { const int row = row0 + ai * HALF + m * 16; bf16_t* rowp = O + (size_t)row * ldc + col0;
#pragma unroll
                for (int bj = 0; bj < 2; ++bj) { const f32x4 v0 = acc[ai][bj][m][0] + bv[bj][0], v1 = acc[ai][bj][m][1] + bv[bj][1];
                    u32x4 w; w.x = cvt_pk_bf16(v0[0], v0[1]); w.y = cvt_pk_bf16(v0[2], v0[3]); w.z = cvt_pk_bf16(v1[0], v1[1]); w.w = cvt_pk_bf16(v1[2], v1[3]);
                    *(u32x4*)(rowp + bj * HALF) = w;
                    if (keep) { float* fp = kvbase + (size_t)(row - rbase) * 2048 + (col0 + bj * HALF - sect * 2048); *(f32x4*)(fp) = v0; *(f32x4*)(fp + 4) = v1; } } }
    }
};
struct EpiSwiglu {
    static constexpr bool PERM = true, AFTER_DRAIN = false;
    bf16_t* O; int ldc;
    __device__ __forceinline__ void operator()(const f32x4 (&acc)[2][2][4][2], const Unit& u, int wr, int wc, int fr, int fq) const {
        const int row0 = u.pm * BM + wr * 64 + fr, col0 = u.pn * HALF + wc * 32 + 8 * fq;
#pragma unroll
        for (int ai = 0; ai < 2; ++ai)
#pragma unroll
            for (int m = 0; m < 4; ++m) { bf16_t* rowp = O + (size_t)(row0 + ai * HALF + m * 16) * ldc + col0;
                const f32x4 g0 = acc[ai][0][m][0], g1 = acc[ai][0][m][1], u0 = acc[ai][1][m][0], u1 = acc[ai][1][m][1];
                u32x4 w; w.x = cvt_pk_bf16(silu_f(g0[0]) * u0[0], silu_f(g0[1]) * u0[1]); w.y = cvt_pk_bf16(silu_f(g0[2]) * u0[2], silu_f(g0[3]) * u0[3]);
                w.z = cvt_pk_bf16(silu_f(g1[0]) * u1[0], silu_f(g1[1]) * u1[1]); w.w = cvt_pk_bf16(silu_f(g1[2]) * u1[2], silu_f(g1[3]) * u1[3]);
                *(u32x4*)(rowp) = w; }
    }
};

typedef __bf16 bf16v2_pg8 __attribute__((ext_vector_type(2)));
constexpr int RMS_LDS = STAGE_BYTES;
template <class Epi, class Sched, bool ALIGN_EPI = false, bool SP2 = false, bool RMS = false>
__device__ __forceinline__ void gemm_phase(PG8_LAS unsigned char* lds, const Gemm g, const Sched& S, const Epi& E) {
    const int tid = tid_opaque(), wid = __builtin_amdgcn_readfirstlane(tid >> 6), lane = tid & 63, wr = wid >> 2, wc = wid & 3, fr = lane & 15, fq = lane >> 4;
    const int K = g.ld, nt = g.K / BK;
    unsigned voffA[2], voffB[2];
#pragma unroll
    for (int i = 0; i < 2; ++i) { int R, C; stage_rc(tid * 16 + i * 8192, R, C); const int Rb = Epi::PERM ? ((R & ~31) + perm32(R & 31)) : R;
        voffA[i] = (unsigned)(R * K + C) * 2u; voffB[i] = (unsigned)(Rb * K + C) * 2u; }
    const size_t kstep = (size_t)(BK * 2);
    const size_t hstep = (size_t)HALF * K * 2;
    const size_t tstep = 2 * hstep;
    const unsigned ldsw = (unsigned)wid * 1024u;
    const int aoff = lds_byte(wr * 64 + fr, fq * 8), boff = lds_byte(wc * 32 + fr, fq * 8);
#define PG8_SA(b, h) (((b) * 2 + (h)) * HTB)
#define PG8_SB(b, h) ((4 + (b) * 2 + (h)) * HTB)
#define PG8_STAGE(bufoff, gbase, voff) do { _Pragma("unroll") for (int _i = 0; _i < 2; ++_i) \
        __builtin_amdgcn_global_load_lds((const unsigned*)((const char*)(gbase) + (voff)[_i]), (PG8_LAS unsigned*)(lds + (bufoff) + ldsw + _i * 8192), 16, 0, 0); } while (0)
#define PG8_LDA(dst, b, h) do { _Pragma("unroll") for (int m = 0; m < 4; ++m) _Pragma("unroll") for (int k = 0; k < 2; ++k) dst[m][k] = *(const PG8_LAS bf16x8*)(lds + PG8_SA(b, h) + aoff + m * 2048 + k * 1024); } while (0)
#define PG8_LDB(dst, b, h) do { _Pragma("unroll") for (int n = 0; n < 2; ++n) _Pragma("unroll") for (int k = 0; k < 2; ++k) dst[n][k] = *(const PG8_LAS bf16x8*)(lds + PG8_SB(b, h) + boff + n * 2048 + k * 1024); } while (0)
#define PG8_MMA(ai, bj, At, Bt) do { __builtin_amdgcn_s_setprio(1); _Pragma("unroll") for (int m = 0; m < 4; ++m) _Pragma("unroll") for (int n = 0; n < 2; ++n) _Pragma("unroll") for (int k = 0; k < 2; ++k) { \
        acc[ai][bj][m][n] = __builtin_amdgcn_mfma_f32_16x16x32_bf16(Bt[n][k], At[m][k], acc[ai][bj][m][n], 0, 0, 0); } \
        __builtin_amdgcn_s_setprio(0); } while (0)
#define PG8_WAIT_V(n) asm volatile("s_waitcnt vmcnt(" #n ")" ::: "memory")
#define PG8_WAIT_L(n) asm volatile("s_waitcnt lgkmcnt(" #n ")" ::: "memory")
#define PG8_BAR __builtin_amdgcn_s_barrier()
#define PG8_SCHED __builtin_amdgcn_sched_barrier(0)
    Unit cur, nxt; int ui = 0;
    if (!S.next(0, cur)) return;
    f32x4 acc[2][2][4][2];
#pragma unroll
    for (int a = 0; a < 2; ++a)
#pragma unroll
        for (int b = 0; b < 2; ++b)
#pragma unroll
            for (int m = 0; m < 4; ++m)
#pragma unroll
                for (int n = 0; n < 2; ++n) acc[a][b][m][n] = (f32x4){0.f, 0.f, 0.f, 0.f};
    bf16x8 At[4][2], B0[2][2], B1[2][2];
#define PG8_RFETCH(pm_, par_) do { if constexpr (RMS) { if (wid < 4) __builtin_amdgcn_global_load_lds((const unsigned*)(g.R + (size_t)(pm_) * BM + wid * 64 + lane), (PG8_LAS unsigned*)(lds + RMS_LDS + (par_) * 1024 + wid * 256), 4, 0, 0); } } while (0)
#define PG8_ABASE(pm_) ((pm_) < g.msplit ? (const char*)g.A + (size_t)(pm_) * tstep : (const char*)g.A2 + (size_t)((pm_) - g.msplit) * tstep)
    const char* cA = PG8_ABASE(cur.pm); const char* cB = (const char*)g.Bt + (size_t)cur.pn * tstep;
    S.a_ready(cur);
    PG8_RFETCH(cur.pm, 0);
    if constexpr (SP2) {
        PG8_STAGE(PG8_SB(0, 0), cB, voffB); PG8_STAGE(PG8_SB(0, 1), cB + hstep, voffB); PG8_STAGE(PG8_SA(0, 0), cA, voffA); PG8_STAGE(PG8_SA(0, 1), cA + hstep, voffA);
        if (wr == 1) PG8_BAR;
        PG8_WAIT_V(2); PG8_BAR;
        PG8_STAGE(PG8_SB(1, 0), cB + kstep, voffB); PG8_STAGE(PG8_SA(1, 0), cA + kstep, voffA); PG8_STAGE(PG8_SB(1, 1), cB + hstep + kstep, voffB);
        PG8_WAIT_V(6); PG8_BAR;
    } else {
        PG8_STAGE(PG8_SB(0, 0), cB, voffB); PG8_STAGE(PG8_SA(0, 0), cA, voffA); PG8_STAGE(PG8_SB(0, 1), cB + hstep, voffB); PG8_STAGE(PG8_SA(0, 1), cA + hstep, voffA);
        if (wr == 1) PG8_BAR;
        PG8_WAIT_V(4); PG8_BAR;
        PG8_STAGE(PG8_SB(1, 0), cB + kstep, voffB); PG8_STAGE(PG8_SA(1, 0), cA + kstep, voffA); PG8_STAGE(PG8_SB(1, 1), cB + hstep + kstep, voffB);
        PG8_WAIT_V(6); PG8_BAR;
    }
    for (;;) {
        const bool has_next = S.next(ui + 1, nxt);
        const char* nA = has_next ? PG8_ABASE(nxt.pm) : cA; const char* nB = has_next ? (const char*)g.Bt + (size_t)nxt.pn * tstep : cB;
        for (int t = 0; t < nt; t += 2) {
            const bool last = (t == nt - 2);
            const char* a1 = cA + (size_t)(t + 1) * kstep;
            const char* a2 = last ? nA : cA + (size_t)(t + 2) * kstep; const char* b2 = last ? nB : cB + (size_t)(t + 2) * kstep;
            const char* a3 = a2 + kstep; const char* b3 = b2 + kstep;
            if (last && has_next) S.a_ready(nxt);
            if constexpr (SP2) {
            PG8_LDB(B0, 0, 0); PG8_LDB(B1, 0, 1); PG8_SCHED; PG8_LDA(At, 0, 0); PG8_STAGE(PG8_SA(1, 1), a1 + hstep, voffA);
            PG8_WAIT_V(8); PG8_WAIT_L(0); PG8_BAR; PG8_MMA(0, 0, At, B0); PG8_MMA(0, 1, At, B1); PG8_BAR; PG8_SCHED;
            PG8_LDA(At, 0, 1); PG8_STAGE(PG8_SB(0, 0), b2, voffB); PG8_STAGE(PG8_SB(0, 1), b2 + hstep, voffB); PG8_STAGE(PG8_SA(0, 0), a2, voffA);
            PG8_WAIT_V(8); PG8_WAIT_L(0); PG8_BAR; PG8_MMA(1, 0, At, B0); PG8_MMA(1, 1, At, B1); PG8_BAR; PG8_SCHED;
            PG8_LDB(B0, 1, 0); PG8_LDB(B1, 1, 1); PG8_SCHED; PG8_LDA(At, 1, 0); PG8_STAGE(PG8_SA(0, 1), a2 + hstep, voffA);
            PG8_WAIT_V(8); PG8_WAIT_L(0); PG8_BAR; PG8_MMA(0, 0, At, B0); PG8_MMA(0, 1, At, B1); PG8_BAR; PG8_SCHED;
            PG8_LDA(At, 1, 1); PG8_STAGE(PG8_SB(1, 0), b3, voffB); PG8_STAGE(PG8_SB(1, 1), b3 + hstep, voffB); PG8_STAGE(PG8_SA(1, 0), a3, voffA);
            PG8_WAIT_V(8); PG8_WAIT_L(0); PG8_BAR; PG8_MMA(1, 0, At, B0); PG8_MMA(1, 1, At, B1); PG8_BAR; PG8_SCHED;
            } else {
            PG8_LDB(B0, 0, 0); PG8_SCHED; PG8_LDA(At, 0, 0); PG8_STAGE(PG8_SA(1, 1), a1 + hstep, voffA);
            PG8_WAIT_L(8); PG8_BAR; PG8_WAIT_L(0); PG8_MMA(0, 0, At, B0); PG8_BAR; PG8_SCHED;
            PG8_LDB(B1, 0, 1); PG8_STAGE(PG8_SB(0, 0), b2, voffB);
            PG8_BAR; PG8_WAIT_L(0); PG8_MMA(0, 1, At, B1); PG8_BAR;
            PG8_LDA(At, 0, 1); PG8_STAGE(PG8_SA(0, 0), a2, voffA);
            PG8_BAR; PG8_WAIT_L(0); PG8_MMA(1, 0, At, B0); PG8_BAR; PG8_SCHED;
            PG8_STAGE(PG8_SB(0, 1), b2 + hstep, voffB);
            PG8_WAIT_V(6); PG8_BAR; PG8_MMA(1, 1, At, B1); PG8_BAR;
            PG8_LDB(B0, 1, 0); PG8_SCHED; PG8_LDA(At, 1, 0); PG8_STAGE(PG8_SA(0, 1), a2 + hstep, voffA);
            PG8_WAIT_L(8); PG8_BAR; PG8_WAIT_L(0); PG8_MMA(0, 0, At, B0); PG8_BAR; PG8_SCHED;
            PG8_LDB(B1, 1, 1); PG8_STAGE(PG8_SB(1, 0), b3, voffB);
            PG8_BAR; PG8_WAIT_L(0); PG8_MMA(0, 1, At, B1); PG8_BAR;
            PG8_LDA(At, 1, 1); PG8_STAGE(PG8_SA(1, 0), a3, voffA);
            PG8_BAR; PG8_WAIT_L(0); PG8_MMA(1, 0, At, B0); PG8_BAR; PG8_SCHED;
            PG8_STAGE(PG8_SB(1, 1), b3 + hstep, voffB);
            PG8_WAIT_V(6); PG8_BAR; PG8_MMA(1, 1, At, B1); PG8_BAR;
            }
        }
        if constexpr (ALIGN_EPI) { if (wr == 0) PG8_BAR; }
        if constexpr (RMS) {
            const PG8_LAS float* rl = (const PG8_LAS float*)(lds + RMS_LDS + (ui & 1) * 1024) + wr * 64 + fr;
#pragma unroll
            for (int a = 0; a < 2; ++a)
#pragma unroll
                for (int m = 0; m < 4; ++m) { const float r = rl[a * HALF + m * 16];
#pragma unroll
                    for (int b = 0; b < 2; ++b)
#pragma unroll
                        for (int n = 0; n < 2; ++n) acc[a][b][m][n] = acc[a][b][m][n] * r; }
        }
        if constexpr (!Epi::AFTER_DRAIN) { E(acc, cur, wr, wc, fr, fq); S.done(cur); }
        if (!has_next) break;
#pragma unroll
        for (int a = 0; a < 2; ++a)
#pragma unroll
            for (int b = 0; b < 2; ++b)
#pragma unroll
                for (int m = 0; m < 4; ++m)
#pragma unroll
                    for (int n = 0; n < 2; ++n) acc[a][b][m][n] = (f32x4){0.f, 0.f, 0.f, 0.f};
        cur = nxt; cA = nA; cB = nB; ++ui;
        PG8_RFETCH(cur.pm, ui & 1);
        if constexpr (ALIGN_EPI) { if (wr == 1) PG8_BAR; }
    }
    PG8_WAIT_V(0);
    if constexpr (!ALIGN_EPI) { if (wr == 0) PG8_BAR; }
    PG8_BAR;
    if constexpr (Epi::AFTER_DRAIN) { E.fused(acc, cur, wr, wc, fr, fq, lds, wid, lane); S.done(cur); }
#undef PG8_SA
#undef PG8_ABASE
#undef PG8_RFETCH
#undef PG8_SB
#undef PG8_STAGE
#undef PG8_LDA
#undef PG8_LDB
#undef PG8_MMA
#undef PG8_WAIT_V
#undef PG8_WAIT_L
#undef PG8_BAR
#undef PG8_SCHED
}
}
#endif
#ifndef EMU
#define XB_TMO      128
#define XB_XCNT(j)  (256  + 64 * (j))
#define XB_XSUB(j)  (1280 + 64 * (j))
#define XB_XGEN(j)  (2304 + 64 * (j))
#define XB_TOP      3328
#define XB_TOPGEN   3392
#define XCD_BAR_WORDS 3456
#define XB_SPIN_CAP (1u << 18)

__device__ __forceinline__ unsigned xb_ld(unsigned* p)              { return __hip_atomic_load(p, __ATOMIC_RELAXED, __HIP_MEMORY_SCOPE_AGENT); }
__device__ __forceinline__ unsigned xb_add(unsigned* p, unsigned v) { return __hip_atomic_fetch_add(p, v, __ATOMIC_RELAXED, __HIP_MEMORY_SCOPE_AGENT); }
__device__ __forceinline__ unsigned xb_xcc_id() { return (unsigned)__builtin_amdgcn_s_getreg((3 << 11) | 20) & 0xFu; }
#define XB_SPIN(cond, bar) do { unsigned _sp = 0; while (cond) { __builtin_amdgcn_s_sleep(1); \
    if ((++_sp & 255u) == 0u) { if (xb_ld(&(bar)[XB_TMO])) break; if (_sp > XB_SPIN_CAP) { atomicAdd(&(bar)[XB_TMO], 1u); break; } } } } while (0)

struct XcdBarrier {
    unsigned* bar; unsigned x;
    volatile LAS unsigned* st;
};

__device__ __forceinline__ XcdBarrier xcd_barrier_post(unsigned* bar, volatile LAS unsigned* st) {
    XcdBarrier b; b.bar = bar; b.x = xb_xcc_id(); b.st = st;
    if (threadIdx.x == 0) (void)xb_add(&bar[XB_XCNT(b.x)], 1u);
    return b;
}
__device__ __forceinline__ void xcd_barrier_complete(unsigned* bar, unsigned x, unsigned& nloc, unsigned& nx) {
    const unsigned G = gridDim.x * gridDim.y * gridDim.z;
    unsigned sum, cnt, mine, sp = 0u;
    for (;;) {
        sum = 0u; cnt = 0u; mine = 0u;
#pragma unroll
        for (unsigned j = 0; j < 16; ++j) { const unsigned c = xb_ld(&bar[XB_XCNT(j)]); sum += c; cnt += (c > 0u) ? 1u : 0u; mine = (j == x) ? c : mine; }
        if (sum == G) break;
        __builtin_amdgcn_s_sleep(1);
        if ((++sp & 255u) == 0u) { if (xb_ld(&bar[XB_TMO])) break; if (sp > XB_SPIN_CAP) { atomicAdd(&bar[XB_TMO], 1u); break; } }
    }
    nloc = mine > 0u ? mine : 1u; nx = cnt > 0u ? cnt : 1u;
}

__device__ __forceinline__ void xcd_barrier(const XcdBarrier& b) {
    asm volatile("s_waitcnt vmcnt(0)" ::: "memory");
    __syncthreads();
    if (threadIdx.x == 0) {
        unsigned* bar = b.bar;
        __builtin_amdgcn_s_waitcnt(0);
        unsigned nloc = b.st[0], nx = b.st[1];
        if (nloc == 0u) { xcd_barrier_complete(bar, b.x, nloc, nx); b.st[0] = nloc; b.st[1] = nx; }
        const unsigned old = xb_add(&bar[XB_XSUB(b.x)], 1u);
        const unsigned gen = old / nloc;
        if (old + 1u == (gen + 1u) * nloc) {
            __builtin_amdgcn_fence(__ATOMIC_RELEASE, "agent");
            asm volatile("s_waitcnt vmcnt(0)" ::: "memory");
            const unsigned og = xb_add(&bar[XB_TOP], 1u);
            const unsigned tg = og / nx;
            if (og + 1u == (tg + 1u) * nx) xb_add(&bar[XB_TOPGEN], 1u);
            else XB_SPIN(xb_ld(&bar[XB_TOPGEN]) == tg, bar);
            __builtin_amdgcn_fence(__ATOMIC_ACQUIRE, "agent");
            xb_add(&bar[XB_XGEN(b.x)], 1u);
            asm volatile("s_waitcnt vmcnt(0)" ::: "memory");
        } else {
            XB_SPIN(xb_ld(&bar[XB_XGEN(b.x)]) == gen, bar);
            __builtin_amdgcn_fence(__ATOMIC_ACQUIRE, "agent");
            asm volatile("s_waitcnt vmcnt(0)" ::: "memory");
        }
    }
    __syncthreads();
}
#endif
__device__ __forceinline__ void wt_item(const float* W, int K, int N, bf16* WT, int k0, int n0, int orow0, LAS float* scr, int lane) {
#pragma unroll 8
    for (int i = 0; i < 32; ++i) { const int kk = 2 * i + (lane >> 5); scr[kk * 33 + (lane & 31)] = W[(size_t)(k0 + kk) * N + n0 + (lane & 31)]; }
    WG_BARRIER_WAVE();
    const int c = lane & 7;
#pragma unroll
    for (int j = 0; j < 4; ++j) { const int n = (lane >> 3) + 8 * j; const LAS float* s = scr + (8 * c) * 33 + n;
        u32x4 o; o.x = pk2(s[0 * 33], s[1 * 33]); o.y = pk2(s[2 * 33], s[3 * 33]); o.z = pk2(s[4 * 33], s[5 * 33]); o.w = pk2(s[6 * 33], s[7 * 33]);
        *(u32x4*)(WT + (size_t)(orow0 + n) * K + k0 + 8 * c) = o; }
    WG_BARRIER_WAVE();
}
constexpr int WT_SCR = 64 * 65 * 4;
struct WtItem { const float* W; bf16* WT; int K, N, k0, n0, orow0; const float* scale; };
__device__ __forceinline__ void wt_load(const WtItem& it, f32x4 (&v)[16], float& scl, int lane) {
    const float* src = it.W + (size_t)(it.k0 + (lane >> 4)) * it.N + it.n0 + 4 * (lane & 15);
#pragma unroll
    for (int i = 0; i < 16; ++i) v[i] = *(const f32x4*)(src + (size_t)(4 * i) * it.N);
    scl = it.scale ? it.scale[it.k0 + lane] : 1.0f;
}
__device__ __forceinline__ void wt_store(const WtItem& it, const f32x4 (&v)[16], float scl, LAS float* scr, int lane) {
#pragma unroll
    for (int i = 0; i < 16; ++i) { LAS float* d = scr + (4 * i + (lane >> 4)) * 65 + 4 * (lane & 15); const float s = __shfl(scl, 4 * i + (lane >> 4)); d[0] = v[i].x * s; d[1] = v[i].y * s; d[2] = v[i].z * s; d[3] = v[i].w * s; }
    WG_BARRIER_WAVE();
    const int c = lane & 7;
#pragma unroll
    for (int j = 0; j < 8; ++j) { const int n = (lane >> 3) + 8 * j; const LAS float* s = scr + (8 * c) * 65 + n;
        u32x4 o; o.x = pk2(s[0 * 65], s[1 * 65]); o.y = pk2(s[2 * 65], s[3 * 65]); o.z = pk2(s[4 * 65], s[5 * 65]); o.w = pk2(s[6 * 65], s[7 * 65]);
        *(u32x4*)(it.WT + (size_t)(it.orow0 + n) * it.K + it.k0 + 8 * c) = o; }
    WG_BARRIER_WAVE();
}
struct WtJob { const float* W; bf16* WT; int K, N, mode; const float* scale; };
__device__ __forceinline__ int wt_items(const WtJob& j) { return (j.K / 64) * (j.N / 64); }
__device__ __forceinline__ WtItem wt_item_of(const WtJob& j, int item) {
    const int nblk = j.N / 64, kb = item / nblk, nb = item - kb * nblk, n0 = 64 * nb;
    const int orow0 = j.mode == 0 ? n0 : ((n0 >> 7) * 256 + (j.mode == 2 ? 128 : 0) + (n0 & 127));
    return WtItem{j.W, j.WT, j.K, j.N, 64 * kb, n0, orow0, j.scale};
}
__device__ __forceinline__ void wt_run(const WtJob& j, int item, LAS float* scr, int lane) {
    const WtItem it = wt_item_of(j, item); f32x4 v[16]; float scl; wt_load(it, v, scl, lane); wt_store(it, v, scl, scr, lane);
}
__device__ __forceinline__ void rms_row(const float* xrow, const float* w, float* xcopy, bf16* obf, float* of32, int lane) {
    const f32x4* xr = (const f32x4*)xrow + lane; const f32x4* wr = (const f32x4*)w + lane;
    f32x4 v[8]; float ss = 0.f;
#pragma unroll
    for (int j = 0; j < 8; ++j) { v[j] = xr[64 * j]; ss += (v[j].x * v[j].x + v[j].y * v[j].y) + (v[j].z * v[j].z + v[j].w * v[j].w); }
    if (xcopy) {
#pragma unroll
        for (int j = 0; j < 8; ++j) ((f32x4*)xcopy + lane)[64 * j] = v[j]; }
    const float r = 1.0f / sqrtf(wave_sum(ss) * (1.0f / DM) + EPS);
#pragma unroll
    for (int j = 0; j < 8; ++j) { const f32x4 ww = wr[64 * j]; f32x4 y; y.x = v[j].x * r * ww.x; y.y = v[j].y * r * ww.y; y.z = v[j].z * r * ww.z; y.w = v[j].w * r * ww.w;
        if (obf) { u32x2 o; o.x = pk2(y.x, y.y); o.y = pk2(y.z, y.w); ((u32x2*)obf + lane)[64 * j] = o; }
        if (of32) ((f32x4*)of32 + lane)[64 * j] = y; }
}

__device__ __forceinline__ void rms_rows(const float* x, const float* w, float* xcopy, bf16* obf, float* of32, int nrows, int gw, int NGW, int lane) {
    const f32x4* wr = (const f32x4*)w + lane;
    f32x4 v[8], vn[8];
    int m = gw;
    if (m < nrows) { const f32x4* xr = (const f32x4*)(x + (size_t)m * DM) + lane;
#pragma unroll
        for (int j = 0; j < 8; ++j) v[j] = xr[64 * j]; }
#pragma unroll 1
    while (m < nrows) {
        const int mn = m + NGW;
        if (mn < nrows) { const f32x4* xr = (const f32x4*)(x + (size_t)mn * DM) + lane;
#pragma unroll
            for (int j = 0; j < 8; ++j) vn[j] = xr[64 * j]; }
        float ss = 0.f;
#pragma unroll
        for (int j = 0; j < 8; ++j) ss += (v[j].x * v[j].x + v[j].y * v[j].y) + (v[j].z * v[j].z + v[j].w * v[j].w);
        if (xcopy) {
#pragma unroll
            for (int j = 0; j < 8; ++j) ((f32x4*)(xcopy + (size_t)m * DM) + lane)[64 * j] = v[j]; }
        const float r = FAST_RSQ(wave_sum(ss) * (1.0f / DM) + EPS);
#pragma unroll
        for (int j = 0; j < 8; ++j) { const f32x4 ww = wr[64 * j]; f32x4 y; y.x = v[j].x * r * ww.x; y.y = v[j].y * r * ww.y; y.z = v[j].z * r * ww.z; y.w = v[j].w * r * ww.w;
            if (obf) { u32x2 o; o.x = pk2(y.x, y.y); o.y = pk2(y.z, y.w); ((u32x2*)(obf + (size_t)m * DM) + lane)[64 * j] = o; }
            if (of32) ((f32x4*)(of32 + (size_t)m * DM) + lane)[64 * j] = y; }
#pragma unroll
        for (int j = 0; j < 8; ++j) v[j] = vn[j];
        m = mn;
    }
}
__device__ __forceinline__ void rms_h_load(const bf16* xh, int m, u32x4 (&v)[4], int lane) {
    const u32x4* xr = (const u32x4*)(xh + (size_t)m * DM) + lane;
#pragma unroll
    for (int j = 0; j < 4; ++j) v[j] = xr[64 * j];
}
__device__ __forceinline__ void rms_h_finish(const u32x4 (&v)[4], const float* w, bf16* obf, float* of32, int m, int lane) {
    const f32x4* wr = (const f32x4*)w + 2 * lane;
    float ss = 0.f;
#pragma unroll
    for (int j = 0; j < 4; ++j) { const float a0 = bflo(v[j].x), a1 = bfhi(v[j].x), a2 = bflo(v[j].y), a3 = bfhi(v[j].y), a4 = bflo(v[j].z), a5 = bfhi(v[j].z), a6 = bflo(v[j].w), a7 = bfhi(v[j].w);
        ss += ((a0 * a0 + a1 * a1) + (a2 * a2 + a3 * a3)) + ((a4 * a4 + a5 * a5) + (a6 * a6 + a7 * a7)); }
    const float r = FAST_RSQ(wave_sum(ss) * (1.0f / DM) + EPS);
#pragma unroll
    for (int j = 0; j < 4; ++j) { const f32x4 w0 = wr[128 * j], w1 = wr[128 * j + 1];
        f32x4 y0, y1; y0.x = bflo(v[j].x) * r * w0.x; y0.y = bfhi(v[j].x) * r * w0.y; y0.z = bflo(v[j].y) * r * w0.z; y0.w = bfhi(v[j].y) * r * w0.w;
        y1.x = bflo(v[j].z) * r * w1.x; y1.y = bfhi(v[j].z) * r * w1.y; y1.z = bflo(v[j].w) * r * w1.z; y1.w = bfhi(v[j].w) * r * w1.w;
        if (obf) { u32x4 o; o.x = pk2(y0.x, y0.y); o.y = pk2(y0.z, y0.w); o.z = pk2(y1.x, y1.y); o.w = pk2(y1.z, y1.w); ((u32x4*)(obf + (size_t)m * DM) + lane)[64 * j] = o; }
        if (of32) { f32x4* op = (f32x4*)(of32 + (size_t)m * DM) + 2 * lane; op[128 * j] = y0; op[128 * j + 1] = y1; } }
}
__device__ __forceinline__ void rms_rows_h(const bf16* xh, const float* w, bf16* obf, float* of32, int nrows, int gw, int NGW, int lane) {
    u32x4 v[4], vn[4];
    int m = gw;
    if (m < nrows) rms_h_load(xh, m, v, lane);
#pragma unroll 1
    while (m < nrows) {
        const int mn = m + NGW;
        if (mn < nrows) rms_h_load(xh, mn, vn, lane);
        rms_h_finish(v, w, obf, of32, m, lane);
#pragma unroll
        for (int j = 0; j < 4; ++j) v[j] = vn[j];
        m = mn;
    }
}
__device__ __forceinline__ void cvt_rows(const float* x, float* xcopy, bf16* obf, float* rout, int nrows, int gw, int NGW, int lane) {
#pragma unroll 1
    for (int m = gw; m < nrows; m += NGW) { const f32x4* xr = (const f32x4*)(x + (size_t)m * DM) + 2 * lane;
        f32x4 a[4], b[4]; float ss = 0.f;
#pragma unroll
        for (int j = 0; j < 4; ++j) { a[j] = xr[128 * j]; b[j] = xr[128 * j + 1]; }
#pragma unroll
        for (int j = 0; j < 4; ++j) { u32x4 o; o.x = pk2(a[j].x, a[j].y); o.y = pk2(a[j].z, a[j].w); o.z = pk2(b[j].x, b[j].y); o.w = pk2(b[j].z, b[j].w); ((u32x4*)(obf + (size_t)m * DM) + lane)[64 * j] = o;
            ss += ((a[j].x * a[j].x + a[j].y * a[j].y) + (a[j].z * a[j].z + a[j].w * a[j].w)) + ((b[j].x * b[j].x + b[j].y * b[j].y) + (b[j].z * b[j].z + b[j].w * b[j].w));
            if (xcopy) { f32x4* xc = (f32x4*)(xcopy + (size_t)m * DM) + 2 * lane; xc[128 * j] = a[j]; xc[128 * j + 1] = b[j]; } }
        const float r = FAST_RSQ(wave_sum(ss) * (1.0f / DM) + EPS);
        if (lane == 0) rout[m] = r;
    }
}
__device__ __forceinline__ void slots_to_r(const float* sl, float* rout, int nrows, int tlin, int ntlin) {
#pragma unroll 1
    for (int i = tlin; i < nrows * 8; i += ntlin) { const f32x4 v = ((const f32x4*)sl)[i]; float s = (v.x + v.y) + (v.z + v.w);
        s += __shfl_xor(s, 1); s += __shfl_xor(s, 2); s += __shfl_xor(s, 4);
        if ((i & 7) == 0) rout[i >> 3] = FAST_RSQ(s * (1.0f / DM) + EPS); }
}
struct GdnP {
    const bf16* proj;
    const float* ba;
    const float* wconv;
    const float* a_log;
    const float* dt_bias;
    const float* conv_state;
    const float* rec_state;
    float* out_pconv;
    float* out_sconv;
    float* out_prec;
    float* out_srec;
    bf16 *U, *WN, *QG, *KG, *QK;
    float* DEC;
    bf16* o;
};


__device__ __forceinline__ void store_frag16(bf16* fragbase, size_t subtile_stride, const f32x16& v, int lane) {
    const int h = lane >> 5, l31 = lane & 31;
    bf16* fb = fragbase + (size_t)(l31 >> 4) * subtile_stride;
#pragma unroll
    for (int g = 0; g < 4; ++g) { const int lanep = (l31 & 15) + 16 * (2 * (g & 1) + h);
        u32x2 w; w.x = pk2(v[4 * g], v[4 * g + 1]); w.y = pk2(v[4 * g + 2], v[4 * g + 3]);
        *(u32x2*)(fb + lanep * 8 + 4 * (g >> 1)) = w; }
}
__device__ __forceinline__ int perm16(int q, int j) { return 16 * (j >> 2) + 4 * q + (j & 3); }
constexpr int PL_QN = 0, PL_KN = 17408, PL_KT = 34816, PL_VT = 53248, PL_LT = 90112, PL_TB = 126976, PL_END = 129536;

template <int C> struct PrepIn { float s0_b, s0_a; float w0[2], w1[2], w2[2], w3[2]; unsigned hw[3]; f32x2 hs[3]; unsigned xr[C / 2]; };
template <int C>
__device__ __forceinline__ void gdn_prep_fetch(const GdnP& p, int cidx, int hk, PrepIn<C>& in, int lane, int wid) {
    constexpr bool SAMPLE = (C == 32); constexpr int NT = C / 2;
    const int bsm = cidx - NCH;
    const int row0 = SAMPLE ? SEQ + 32 * bsm : 64 * cidx;
    in.s0_b = 0.f; in.s0_a = 0.f;
    if (wid < 2 && lane < C) { const float* bar = p.ba + (size_t)(row0 + lane) * 64; in.s0_b = bar[2 * hk + wid]; in.s0_a = bar[32 + 2 * hk + wid]; }
    const int arr = wid & 3, half = wid >> 2;
    const int chbase = arr == 0 ? hk * 128 : (arr == 1 ? 2048 + hk * 128 : 4096 + (2 * hk + (arr - 2)) * 128);
    const int ch = chbase + 2 * lane;
#pragma unroll
    for (int e = 0; e < 2; ++e) { in.w0[e] = p.wconv[0 * 8192 + ch + e]; in.w1[e] = p.wconv[1 * 8192 + ch + e]; in.w2[e] = p.wconv[2 * 8192 + ch + e]; in.w3[e] = p.wconv[3 * 8192 + ch + e]; }
    const int t0 = half * (C / 2);
#pragma unroll
    for (int q = 0; q < 3; ++q) { const int t = t0 - 3 + q; const int rr = row0 + t; const int rc = SAMPLE ? row0 + (t < 0 ? 0 : t) : (rr < 0 ? 0 : rr);
        in.hw[q] = *(const unsigned*)(p.proj + (size_t)rc * PPITCH + ch);
        if (SAMPLE) { const int si = (3 + t) < 0 ? 0 : ((3 + t) > 2 ? 2 : (3 + t)); in.hs[q] = *(const f32x2*)(p.conv_state + ((size_t)bsm * 3 + si) * 8192 + ch); } else in.hs[q] = (f32x2){0.f, 0.f}; }
#pragma unroll
    for (int tt = 0; tt < NT; ++tt) in.xr[tt] = *(const unsigned*)(p.proj + (size_t)(row0 + t0 + tt) * PPITCH + ch);
}
template <int C>
__device__ __forceinline__ void gdn_prep_unit(const GdnP& p, LAS unsigned char* lds, int cidx, int hk, PrepIn<C>& in, int nx_cidx, int nx_hk) {
    constexpr int NM = C / 32, NKS = C / 16;
    constexpr bool SAMPLE = (C == 32);
    const int tid = tid_opaque(), lane = tid & 63, wid = RFL(tid >> 6), h = lane >> 5, l31 = lane & 31;
    const int bsm = cidx - NCH;
    const int row0 = SAMPLE ? SEQ + 32 * bsm : 64 * cidx;
    LAS bf16* QN = (LAS bf16*)(lds + PL_QN);
    LAS bf16* KN = (LAS bf16*)(lds + PL_KN);
    LAS bf16* KT = (LAS bf16*)(lds + PL_KT);
    LAS bf16* VT = (LAS bf16*)(lds + PL_VT);
    LAS float* LT = (LAS float*)(lds + PL_LT);
    LAS float* TB = (LAS float*)(lds + PL_TB);
    const float s0_b = in.s0_b, s0_a = in.s0_a;
    {
        const int arr = wid & 3, half = wid >> 2;
        const int chbase = arr == 0 ? hk * 128 : (arr == 1 ? 2048 + hk * 128 : 4096 + (2 * hk + (arr - 2)) * 128);
        const int ch = chbase + 2 * lane;
        float w0[2], w1[2], w2[2], w3[2];
#pragma unroll
        for (int e = 0; e < 2; ++e) { w0[e] = in.w0[e]; w1[e] = in.w1[e]; w2[e] = in.w2[e]; w3[e] = in.w3[e]; }
        const int t0 = half * (C / 2);
        float xw[3][2];
#pragma unroll
        for (int q = 0; q < 3; ++q) { const int t = t0 - 3 + q; const int rr = row0 + t; float a = bflo(in.hw[q]), b = bfhi(in.hw[q]);
            if (SAMPLE) { if (t < 0) { a = in.hs[q].x; b = in.hs[q].y; } } else if (rr < 0) { a = 0.f; b = 0.f; }
            xw[q][0] = a; xw[q][1] = b; }
        const bool lastchunk = SAMPLE || (cidx == NCH - 1);
        constexpr int NT = C / 2;
        unsigned xr[NT];
#pragma unroll
        for (int tt = 0; tt < NT; ++tt) xr[tt] = in.xr[tt];
        float ya[NT], yb[NT];
#pragma unroll
        for (int tt = 0; tt < NT; ++tt) {
            const int c = t0 + tt;
            const float x0 = bflo(xr[tt]), x1 = bfhi(xr[tt]);
            const float y0 = w0[0] * xw[0][0] + w1[0] * xw[1][0] + w2[0] * xw[2][0] + w3[0] * x0;
            const float y1 = w0[1] * xw[0][1] + w1[1] * xw[1][1] + w2[1] * xw[2][1] + w3[1] * x1;
            xw[0][0] = xw[1][0]; xw[0][1] = xw[1][1]; xw[1][0] = xw[2][0]; xw[1][1] = xw[2][1]; xw[2][0] = x0; xw[2][1] = x1;
            ya[tt] = siluf_(y0); yb[tt] = siluf_(y1);
        }
        if (lastchunk && half == 1) {
#pragma unroll
            for (int q = 0; q < 3; ++q) { const unsigned w = xr[NT - 3 + q]; float* dst = SAMPLE ? p.out_sconv + ((size_t)bsm * 3 + q) * 8192 + ch : p.out_pconv + (size_t)q * 8192 + ch; dst[0] = bflo(w); dst[1] = bfhi(w); } }
        if (arr < 2) {
            LAS float* scr = (LAS float*)(lds + PL_LT) + (arr + 2 * half) * 2304;
            LAS float* PS = scr + 64 * (NT + 1); LAS float* SC = PS + 64;
#pragma unroll
            for (int tt = 0; tt < NT; ++tt) scr[lane * (NT + 1) + tt] = ya[tt] * ya[tt] + yb[tt] * yb[tt];
            WG_BARRIER_WAVE();
            { const int tq = lane & (NT - 1), part = lane / NT; float s = 0.f;
#pragma unroll
              for (int r = 0; r < NT; ++r) s += scr[(part * NT + r) * (NT + 1) + tq];
              PS[lane] = s; }
            WG_BARRIER_WAVE();
            if (lane < NT) { float s = 0.f;
#pragma unroll
                for (int q = 0; q < 64 / NT; ++q) s += PS[q * NT + lane];
                SC[lane] = FAST_RSQ(s + EPS) * (arr == 0 ? 0.08838834764831845f : 1.0f); }
            WG_BARRIER_WAVE();
#pragma unroll
            for (int tt = 0; tt < NT; ++tt) { const int c = t0 + tt; const float r = SC[tt]; const float y0 = ya[tt] * r, y1 = yb[tt] * r;
                if (arr == 0) *(LAS unsigned*)(QN + c * 136 + 2 * lane) = pk2(y0, y1);
                else { const unsigned w = pk2(y0, y1); *(LAS unsigned*)(KN + c * 136 + 2 * lane) = w; KT[(2 * lane) * 72 + c] = (bf16)(w & 0xffffu); KT[(2 * lane + 1) * 72 + c] = (bf16)(w >> 16); } }
        } else {
#pragma unroll
            for (int tt = 0; tt < NT; ++tt) { const int c = t0 + tt; const unsigned w = pk2(ya[tt], yb[tt]); LAS bf16* vt = VT + ((arr - 2) * 128 + 2 * lane) * 72 + c; vt[0] = (bf16)(w & 0xffffu); vt[72] = (bf16)(w >> 16); }
        }
    }
    if (wid < 2) {
        const int hvl = wid, hv = 2 * hk + hvl, c = lane;
        float g = 0.f, beta = 0.f;
        if (c < C) { beta = sigmoidf_(s0_b); g = -__expf(p.a_log[hv]) * softplusf_(s0_a + p.dt_bias[hv]); }
        float gc = g;
#pragma unroll
        for (int d = 1; d < 64; d <<= 1) { const float t = __shfl_up(gc, d); if (lane >= d) gc += t; }
        const float glast = __shfl(gc, C - 1);
        if (c < C) { const float eg = __expf(gc);
            TB[(0 * 2 + hvl) * 64 + c] = beta; TB[(1 * 2 + hvl) * 64 + c] = gc; TB[(2 * 2 + hvl) * 64 + c] = beta * eg;
            TB[(3 * 2 + hvl) * 64 + c] = eg; TB[(4 * 2 + hvl) * 64 + c] = __expf(glast - gc); }
        if (lane == 0) p.DEC[cidx * 32 + hv] = __expf(glast);
    }
    if (nx_cidx >= 0) gdn_prep_fetch<C>(p, nx_cidx, nx_hk, in, lane, wid);
    WG_BARRIER();
    {
        const int kind = wid >> 2, mr = (wid >> 1) & 1, mc = wid & 1;
        const bool act = (mr < NM) && (mc < NM) && !(kind == 1 && mr > mc);
        if (act) {
            f32x16 acc;
#pragma unroll
            for (int r = 0; r < 16; ++r) acc[r] = 0.f;
            const LAS bf16* Arow = KN + (32 * mr + l31) * 136 + 8 * h;
            const LAS bf16* Brow = (kind == 0 ? KN : QN) + (32 * mc + l31) * 136 + 8 * h;
#pragma unroll
            for (int s = 0; s < 8; ++s) acc = MFMA32(*(const LAS bf16x8*)(Arow + 16 * s), *(const LAS bf16x8*)(Brow + 16 * s), acc);
            const int colx = 32 * mc + l31;
#pragma unroll
            for (int hvl = 0; hvl < 2; ++hvl) {
                const LAS float* beta = TB + (0 * 2 + hvl) * 64; const LAS float* gcv = TB + (1 * 2 + hvl) * 64;
                const float gcol = gcv[colx];
                f32x4 gr[4], br[4];
#pragma unroll
                for (int gq = 0; gq < 4; ++gq) { gr[gq] = *(const LAS f32x4*)(gcv + 32 * mr + 8 * gq + 4 * h); if (kind == 0) br[gq] = *(const LAS f32x4*)(beta + 32 * mr + 8 * gq + 4 * h); }
                if (kind == 0) {
#pragma unroll
                    for (int r = 0; r < 16; ++r) { const int c = 32 * mr + accrow(r, h); const float gcr = gr[r >> 2][r & 3], bcr = br[r >> 2][r & 3];
                        const float e = __expf(fminf(gcr - gcol, 0.f));
                        LT[(hvl * 64 + c) * 72 + colx] = (c > colx) ? bcr * acc[r] * e : 0.f; }
                } else {
                    float v[16];
#pragma unroll
                    for (int r = 0; r < 16; ++r) { const int cp = 32 * mr + accrow(r, h); const float e = __expf(fminf(gcol - gr[r >> 2][r & 3], 0.f)); v[r] = (colx >= cp) ? acc[r] * e : 0.f; }
                    f32x16 vv;
#pragma unroll
                    for (int r = 0; r < 16; ++r) vv[r] = v[r];
                    store_frag16(p.QK + (size_t)(cidx * 32 + 2 * hk + hvl) * 4096 + (size_t)((2 * mc) * NM + mr) * 512, (size_t)NM * 512, vv, lane);
                }
            }
        }
    }
    WG_BARRIER();
    if (wid < 2) {
        const int hvl = wid; LAS float* L = LT + hvl * 64 * 72;
        const int blk = (C == 64) ? h : 0;
        const bool lact = (C == 64) || lane < 32;
        const LAS float* Lb = L + (32 * blk) * 72 + 32 * blk;
        float T[32];
#pragma unroll
        for (int i = 0; i < 32; ++i) {
            float s0 = (i == l31) ? 1.f : 0.f, s1 = 0.f, s2 = 0.f, s3 = 0.f;
#pragma unroll
            for (int j = 0; j < i; ++j) { const float pr = Lb[i * 72 + j] * T[j]; if ((j & 3) == 0) s0 -= pr; else if ((j & 3) == 1) s1 -= pr; else if ((j & 3) == 2) s2 -= pr; else s3 -= pr; }
            float s = (s0 + s1) + (s2 + s3);
            PIN_F(s);
            T[i] = s;
        }
        f32x16 X;
        if (C == 64) {
            LAS bf16* scrA = (LAS bf16*)(L + l31 * 72 + 32);
            if (h == 0) {
#pragma unroll
                for (int q = 0; q < 4; ++q) *(LAS u32x4*)(scrA + 8 * q) = (u32x4){pk2(T[8 * q], T[8 * q + 1]), pk2(T[8 * q + 2], T[8 * q + 3]), pk2(T[8 * q + 4], T[8 * q + 5]), pk2(T[8 * q + 6], T[8 * q + 7])};
            } else {
#pragma unroll
                for (int i = 0; i < 32; ++i) ((LAS bf16*)(L + i * 72 + 32))[32 + l31] = (bf16)f2bf(T[i]);
            }
            WG_BARRIER_WAVE();
            f32x16 Pm;
#pragma unroll
            for (int r = 0; r < 16; ++r) Pm[r] = 0.f;
#pragma unroll
            for (int s = 0; s < 2; ++s) { const LAS float* ar = L + (32 + l31) * 72 + 16 * s + 8 * h; const f32x4 a0 = *(const LAS f32x4*)ar, a1 = *(const LAS f32x4*)(ar + 4);
                const bf16x8 af = pack8(a0.x, a0.y, a0.z, a0.w, a1.x, a1.y, a1.z, a1.w);
                const bf16x8 bfr = *(const LAS bf16x8*)(scrA + 16 * s + 8 * h);
                Pm = MFMA32(af, bfr, Pm); }
#pragma unroll
            for (int r = 0; r < 16; ++r) X[r] = 0.f;
#pragma unroll
            for (int s = 0; s < 2; ++s) { const LAS bf16* tb = scrA + 32 + 16 * s + 4 * h; const u32x2 x0 = *(const LAS u32x2*)tb, x1 = *(const LAS u32x2*)(tb + 8);
                X = MFMA32(__builtin_bit_cast(bf16x8, (u32x4){x0.x, x0.y, x1.x, x1.y}), acc_frag(Pm, s), X); }
        }
        WG_BARRIER_WAVE();
        LAS bf16* TU = (LAS bf16*)L; LAS bf16* TW = TU + 64 * 72;
        if (lact) {
            const int col = 32 * blk + l31;
            const float bcol = TB[(0 * 2 + hvl) * 64 + col], bbcol = TB[(2 * 2 + hvl) * 64 + col];
#pragma unroll
            for (int i = 0; i < 32; ++i) { TU[(32 * blk + i) * 72 + col] = (bf16)f2bf(T[i] * bcol); TW[(32 * blk + i) * 72 + col] = (bf16)f2bf(T[i] * bbcol); }
        }
        if (C == 64) {
            const float bc0 = TB[(0 * 2 + hvl) * 64 + l31], bbc0 = TB[(2 * 2 + hvl) * 64 + l31];
#pragma unroll
            for (int r = 0; r < 16; ++r) { const int i = accrow(r, h);
                TU[(32 + i) * 72 + l31] = (bf16)f2bf(-X[r] * bc0); TW[(32 + i) * 72 + l31] = (bf16)f2bf(-X[r] * bbc0);
                TU[i * 72 + 32 + l31] = (bf16)0; TW[i * 72 + 32 + l31] = (bf16)0; }
        }
    } else {
        constexpr int NCT = C / 16, NKC = C / 32;
    #pragma unroll 1
        for (int it = tid - 128; it < 2 * NCT * 4 * 64; it += 384) {
            const int ln = it & 63, ks = (it >> 6) & 3, ct = (it >> 8) % NCT, hvl = (it >> 8) / NCT, q = ln >> 4;
            const int c = 16 * ct + (ln & 15); const float sc = TB[(3 * 2 + hvl) * 64 + c];
            const LAS bf16* src = QN + c * 136 + 32 * ks + 4 * q;
            const u32x2 a = *(const LAS u32x2*)(src), b = *(const LAS u32x2*)(src + 16);
            *(bf16x8*)(p.QG + (size_t)(cidx * 32 + 2 * hk + hvl) * 8192 + ((ct * 4 + ks) * 64 + ln) * 8) =
                pack8(bflo(a.x) * sc, bfhi(a.x) * sc, bflo(a.y) * sc, bfhi(a.y) * sc, bflo(b.x) * sc, bfhi(b.x) * sc, bflo(b.y) * sc, bfhi(b.y) * sc);
        }
    #pragma unroll 1
        for (int it = tid - 128; it < 2 * 8 * NKC * 64; it += 384) {
            const int ln = it & 63, ks = (it >> 6) % NKC, t = ((it >> 6) / NKC) & 7, hvl = (it >> 6) / (NKC * 8), q = ln >> 4;
            const int dkr = 16 * t + (ln & 15); const int c0 = 32 * ks + 4 * q;
            const LAS bf16* src = KT + dkr * 72 + c0; const LAS float* ek = TB + (4 * 2 + hvl) * 64 + c0;
            const u32x2 a = *(const LAS u32x2*)(src), b = *(const LAS u32x2*)(src + 16);
            *(bf16x8*)(p.KG + (size_t)(cidx * 32 + 2 * hk + hvl) * 8192 + ((t * NKC + ks) * 64 + ln) * 8) =
                pack8(bflo(a.x) * ek[0], bfhi(a.x) * ek[1], bflo(a.y) * ek[2], bfhi(a.y) * ek[3], bflo(b.x) * ek[16], bfhi(b.x) * ek[17], bflo(b.y) * ek[18], bfhi(b.y) * ek[19]);
        }

    }
    WG_BARRIER();
#pragma unroll 1
    for (int t = 0; t < 4; ++t) {
        const int id = wid * 4 + t, hvl = id >> 4, kind = (id >> 3) & 1, idx = id & 7, hv = 2 * hk + hvl;
        const LAS bf16* TU = (const LAS bf16*)(LT + hvl * 64 * 72); const LAS bf16* TW = TU + 64 * 72;
        const int m = kind == 0 ? (idx >> 2) : (idx & 1);
        if (m >= NM) continue;
        f32x16 acc;
#pragma unroll
        for (int r = 0; r < 16; ++r) acc[r] = 0.f;
        const LAS bf16* Arow; const LAS bf16* Brow;
        if (kind == 0) { const int vt = idx & 3; Arow = TU + (32 * m + l31) * 72 + 8 * h; Brow = VT + (hvl * 128 + 32 * vt + l31) * 72 + 8 * h; }
        else { const int i = idx >> 1; Arow = KT + (32 * i + l31) * 72 + 8 * h; Brow = TW + (32 * m + l31) * 72 + 8 * h; }
#pragma unroll
        for (int s = 0; s < NKS; ++s) acc = MFMA32(*(const LAS bf16x8*)(Arow + 16 * s), *(const LAS bf16x8*)(Brow + 16 * s), acc);
        if (kind == 0) {
            const int vt = idx & 3; bf16* ub = p.U + (size_t)(cidx * 32 + hv) * 8192;
#pragma unroll
            for (int gq = 0; gq < 4; ++gq) { const int ct = 2 * m + (gq >> 1), vs = 2 * vt + (l31 >> 4), lanep = (l31 & 15) + 16 * (2 * (gq & 1) + h);
                u32x2 w; w.x = pk2(acc[4 * gq], acc[4 * gq + 1]); w.y = pk2(acc[4 * gq + 2], acc[4 * gq + 3]);
                *(u32x2*)(ub + ((ct * 8 + vs) * 64 + lanep) * 4) = w; } }
        else {
            const int i = idx >> 1;
#pragma unroll
            for (int r = 0; r < 16; ++r) acc[r] = -acc[r];
            store_frag16(p.WN + (size_t)(cidx * 32 + hv) * 8192 + (size_t)((2 * m) * 4 + i) * 512, (size_t)4 * 512, acc, lane); }
    }
    WG_BARRIER();
}

template <int C>
__device__ __forceinline__ void gdn_prep_unit(const GdnP& p, LAS unsigned char* lds, int cidx, int hk) {
    const int tid = tid_opaque(); PrepIn<C> in; gdn_prep_fetch<C>(p, cidx, hk, in, tid & 63, RFL(tid >> 6)); gdn_prep_unit<C>(p, lds, cidx, hk, in, -1, 0);
}
constexpr int SCAN_BUF = 61440;
typedef f32x4 acc4;
__device__ __forceinline__ bf16x8 pack_2tiles(const acc4& a, const acc4& b) { return pack8(a[0], a[1], a[2], a[3], b[0], b[1], b[2], b[3]); }
__device__ __forceinline__ void scan_fetch(u32x4 (&v)[15], const GdnP& p, int cidx, int hv, int vt, int tl) {
    const size_t ub = (size_t)(cidx * 32 + hv);
    const u32x4* s0 = (const u32x4*)(p.WN + ub * 8192); const u32x4* s1 = (const u32x4*)(p.QG + ub * 8192);
    const u32x4* s2 = (const u32x4*)(p.KG + ub * 8192); const u32x4* s3 = (const u32x4*)(p.QK + ub * 4096);
#pragma unroll
    for (int i = 0; i < 4; ++i) { v[i] = s0[i * 256 + tl]; v[4 + i] = s1[i * 256 + tl]; v[8 + i] = s2[i * 256 + tl]; }
    v[12] = s3[tl]; v[13] = s3[256 + tl];
    v[14] = ((const u32x4*)(p.U + ub * 8192))[((tl >> 6) * 8 + 2 * vt + ((tl >> 5) & 1)) * 32 + (tl & 31)];
}
__device__ __forceinline__ void scan_put(const u32x4 (&v)[15], LAS unsigned char* buf, int tl) {
#pragma unroll
    for (int i = 0; i < 15; ++i) { *(LAS u32x4*)(buf + (i * 256 + tl) * 16) = v[i]; LOADER_PACE(); }
}
template <int NCT>
__device__ __forceinline__ void scan16_step(acc4 (&S)[8], const LAS unsigned char* buf, int w, float dec, bf16* orow, int lane) {
    constexpr int NKC = NCT / 2;
    const int q = lane >> 4, l15 = lane & 15;
    const LAS bf16x8* WNf = (const LAS bf16x8*)(buf) + lane;
    const LAS bf16x8* QGf = (const LAS bf16x8*)(buf + 16384) + lane;
    const LAS bf16x8* KGf = (const LAS bf16x8*)(buf + 32768) + lane;
    const LAS bf16x8* QKf = (const LAS bf16x8*)(buf + 49152) + lane;
    bf16x8 Sb[4];
#pragma unroll
    for (int ks = 0; ks < 4; ++ks) Sb[ks] = pack_2tiles(S[2 * ks], S[2 * ks + 1]);
    acc4 V[NCT];
#pragma unroll
    for (int ct = 0; ct < NCT; ++ct) { const u32x2 u = *(const LAS u32x2*)(buf + 57344 + (ct * 2 + w) * 512 + lane * 8);
        V[ct][0] = bflo(u.x); V[ct][1] = bfhi(u.x); V[ct][2] = bflo(u.y); V[ct][3] = bfhi(u.y);
#pragma unroll
        for (int ks = 0; ks < 4; ++ks) V[ct] = MFMA16(WNf[(ct * 4 + ks) * 64], Sb[ks], V[ct]); }
    bf16x8 Vb[NKC];
#pragma unroll
    for (int ks = 0; ks < NKC; ++ks) Vb[ks] = pack_2tiles(V[2 * ks], V[2 * ks + 1]);
#pragma unroll
    for (int ct = 0; ct < NCT; ++ct) { acc4 O = (acc4){0.f, 0.f, 0.f, 0.f};
#pragma unroll
        for (int ks = 0; ks < 4; ++ks) O = MFMA16(Sb[ks], QGf[(ct * 4 + ks) * 64], O);
#pragma unroll
        for (int ks = 0; ks <= (ct >> 1); ++ks) O = MFMA16(Vb[ks], QKf[(ct * NKC + ks) * 64], O);
        u32x2 o2; o2.x = pk2(O[0], O[1]); o2.y = pk2(O[2], O[3]);
        *(u32x2*)(orow + (size_t)(16 * ct + l15) * PPITCH + 4 * q) = o2; }
#pragma unroll
    for (int t = 0; t < 8; ++t) { S[t] = S[t] * dec;
#pragma unroll
        for (int ks = 0; ks < NKC; ++ks) S[t] = MFMA16(KGf[(t * NKC + ks) * 64], Vb[ks], S[t]); }
}
#define SCAN_LD4(dst, p0, p1, p2, p3) do { SCHED_FENCE(); dst[0] = (p0); dst[1] = (p1); dst[2] = (p2); dst[3] = (p3); SCHED_FENCE(); } while (0)
#define SCAN_LD(dst, ...) SCAN_LD4(dst, __VA_ARGS__)
__device__ __forceinline__ void scan16_step2(acc4 (&S)[8], const LAS unsigned char* buf, int w, float dec, bf16* orow, int lane) {
    const int q = lane >> 4, l15 = lane & 15;
    const LAS bf16x8* WNf = (const LAS bf16x8*)(buf) + lane;
    const LAS bf16x8* QGf = (const LAS bf16x8*)(buf + 16384) + lane;
    const LAS bf16x8* KGf = (const LAS bf16x8*)(buf + 32768) + lane;
    const LAS bf16x8* QKf = (const LAS bf16x8*)(buf + 49152) + lane;
#define WN_(ct, ks) WNf[((ct) * 4 + (ks)) * 64]
#define QG_(ct, ks) QGf[((ct) * 4 + (ks)) * 64]
#define KG_(t, ks) KGf[((t) * 2 + (ks)) * 64]
#define QK_(ct, ks) QKf[((ct) * 2 + (ks)) * 64]
#define V_GRP(Fc, ks) do { _Pragma("unroll") for (int ct = 0; ct < 4; ++ct) V[ct] = MFMA16(Fc[ct], Sb[ks], V[ct]); } while (0)
#define Q_GRP(Fc, ks) do { _Pragma("unroll") for (int ct = 0; ct < 4; ++ct) O[ct] = MFMA16(Sb[ks], Fc[ct], O[ct]); } while (0)
    bf16x8 F[6][4];
    u32x2 uu[4];
#pragma unroll
    for (int ct = 0; ct < 4; ++ct) uu[ct] = *(const LAS u32x2*)(buf + 57344 + (ct * 2 + w) * 512 + lane * 8);
    SCAN_LD(F[0], WN_(0, 0), WN_(1, 0), WN_(2, 0), WN_(3, 0));
    SCAN_LD(F[1], WN_(0, 1), WN_(1, 1), WN_(2, 1), WN_(3, 1));
    SCAN_LD(F[2], WN_(0, 2), WN_(1, 2), WN_(2, 2), WN_(3, 2));
    SCAN_LD(F[3], WN_(0, 3), WN_(1, 3), WN_(2, 3), WN_(3, 3));
    SCAN_LD(F[4], QG_(0, 0), QG_(1, 0), QG_(2, 0), QG_(3, 0));
    bf16x8 Sb[4];
    Sb[0] = pack_2tiles(S[0], S[1]); Sb[1] = pack_2tiles(S[2], S[3]); Sb[2] = pack_2tiles(S[4], S[5]); Sb[3] = pack_2tiles(S[6], S[7]);
    acc4 V[4], O[4];
#pragma unroll
    for (int ct = 0; ct < 4; ++ct) { V[ct][0] = bflo(uu[ct].x); V[ct][1] = bfhi(uu[ct].x); V[ct][2] = bflo(uu[ct].y); V[ct][3] = bfhi(uu[ct].y); O[ct] = (acc4){0.f, 0.f, 0.f, 0.f}; }
    bf16x8 Vb0, Vb1;
    SCAN_LD(F[5], QG_(0, 1), QG_(1, 1), QG_(2, 1), QG_(3, 1));
    V_GRP(F[0], 0);
    SCAN_LD(F[0], QG_(0, 2), QG_(1, 2), QG_(2, 2), QG_(3, 2));
    V_GRP(F[1], 1);
    SCAN_LD(F[1], QG_(0, 3), QG_(1, 3), QG_(2, 3), QG_(3, 3));
    V_GRP(F[2], 2);
    SCAN_LD(F[2], QK_(0, 0), QK_(1, 0), QK_(2, 0), QK_(3, 0));
    V_GRP(F[3], 3);
    SCAN_LD(F[3], QK_(2, 1), QK_(3, 1), KG_(0, 0), KG_(1, 0));
    Q_GRP(F[4], 0);
    Vb0 = pack_2tiles(V[0], V[1]); Vb1 = pack_2tiles(V[2], V[3]);
    SCAN_LD(F[4], KG_(2, 0), KG_(3, 0), KG_(4, 0), KG_(5, 0));
    Q_GRP(F[5], 1);
    SCAN_LD(F[5], KG_(6, 0), KG_(7, 0), KG_(0, 1), KG_(1, 1));
    Q_GRP(F[0], 2);
    SCAN_LD(F[0], KG_(2, 1), KG_(3, 1), KG_(4, 1), KG_(5, 1));
    Q_GRP(F[1], 3);
    SCAN_LD(F[1], KG_(6, 1), KG_(7, 1), KG_(6, 1), KG_(7, 1));
    _Pragma("unroll") for (int ct = 0; ct < 4; ++ct) O[ct] = MFMA16(Vb0, F[2][ct], O[ct]);
    _Pragma("unroll") for (int t = 0; t < 8; ++t) S[t] = S[t] * dec;
    O[2] = MFMA16(Vb1, F[3][0], O[2]); O[3] = MFMA16(Vb1, F[3][1], O[3]); S[0] = MFMA16(F[3][2], Vb0, S[0]); S[1] = MFMA16(F[3][3], Vb0, S[1]);
    S[2] = MFMA16(F[4][0], Vb0, S[2]); S[3] = MFMA16(F[4][1], Vb0, S[3]); S[4] = MFMA16(F[4][2], Vb0, S[4]); S[5] = MFMA16(F[4][3], Vb0, S[5]);
    _Pragma("unroll") for (int ct = 0; ct < 4; ++ct) { u32x2 o2; o2.x = pk2(O[ct][0], O[ct][1]); o2.y = pk2(O[ct][2], O[ct][3]); *(u32x2*)(orow + (size_t)(16 * ct + l15) * PPITCH + 4 * q) = o2; }
    S[6] = MFMA16(F[5][0], Vb0, S[6]); S[7] = MFMA16(F[5][1], Vb0, S[7]); S[0] = MFMA16(F[5][2], Vb1, S[0]); S[1] = MFMA16(F[5][3], Vb1, S[1]);
    S[2] = MFMA16(F[0][0], Vb1, S[2]); S[3] = MFMA16(F[0][1], Vb1, S[3]); S[4] = MFMA16(F[0][2], Vb1, S[4]); S[5] = MFMA16(F[0][3], Vb1, S[5]);
    S[6] = MFMA16(F[1][0], Vb1, S[6]); S[7] = MFMA16(F[1][1], Vb1, S[7]);
#undef WN_
#undef QG_
#undef KG_
#undef QK_
#undef V_GRP
#undef Q_GRP
}
template <int NM>
__device__ __forceinline__ void gdn_scan_unit(const GdnP& p, LAS unsigned char* lds, int hv, int vt, int cidx0, int nsteps, const float* s_init, float* s_out, int row0) {
    const int tid = tid_opaque(), lane = tid & 63, wid = RFL(tid >> 6), q = lane >> 4, l15 = lane & 15;
    if (wid < 2) {
        const int vcol = 32 * vt + 16 * wid + l15;
        acc4 S[8];
#pragma unroll
        for (int t = 0; t < 8; ++t)
#pragma unroll
            for (int r = 0; r < 4; ++r) S[t][r] = s_init ? s_init[(size_t)(16 * t + 4 * q + r) * 128 + vcol] : 0.f;
        float dreg[4];
#pragma unroll
        for (int i = 0; i < 4; ++i) { const int ti = 64 * i + lane; dreg[i] = ti < nsteps ? p.DEC[(cidx0 + ti) * 32 + hv] : 0.f; }
        WG_BARRIER();
#pragma unroll 1
        for (int t = 0; t < nsteps; ++t) {
            const int tq = t >> 6; const float dsel = tq == 0 ? dreg[0] : (tq == 1 ? dreg[1] : (tq == 2 ? dreg[2] : dreg[3]));
            const float dec = READLANE_F(dsel, t & 63);
            bf16* orow = p.o + (size_t)(row0 + 32 * NM * t) * PPITCH + hv * 128 + 32 * vt + 16 * wid;
            if constexpr (NM == 2) scan16_step2(S, lds + (t & 1) * SCAN_BUF, wid, dec, orow, lane);
            else scan16_step<2 * NM>(S, lds + (t & 1) * SCAN_BUF, wid, dec, orow, lane);
            WG_BARRIER();
        }
#pragma unroll
        for (int t = 0; t < 8; ++t)
#pragma unroll
            for (int r = 0; r < 4; ++r) s_out[(size_t)(16 * t + 4 * q + r) * 128 + vcol] = S[t][r];
    } else if (wid < 4) {
        WG_BARRIER();
#pragma unroll 1
        for (int t = 0; t < nsteps; ++t) WG_BARRIER();
    } else {
        const int tl = tid - 256; u32x4 la[15], lb[15];
        const int clast = cidx0 + nsteps - 1;
        scan_fetch(la, p, cidx0, hv, vt, tl); scan_put(la, lds, tl);
        if (nsteps > 1) {
            scan_fetch(la, p, cidx0 + 1, hv, vt, tl);
            scan_fetch(lb, p, (cidx0 + 2 < clast ? cidx0 + 2 : clast), hv, vt, tl);
        }
        WG_BARRIER();
        if (nsteps > 1) {
#pragma unroll 1
            for (int t = 0; t < nsteps; t += 2) {
                scan_put(la, lds + SCAN_BUF, tl); { const int cn = cidx0 + t + 3; scan_fetch(la, p, cn < clast ? cn : clast, hv, vt, tl); }
                WG_BARRIER();
                scan_put(lb, lds, tl); { const int cn = cidx0 + t + 4; scan_fetch(lb, p, cn < clast ? cn : clast, hv, vt, tl); }
                WG_BARRIER();
            }
        } else WG_BARRIER();
    }
}

__device__ __forceinline__ void gdn_gate_row(const bf16* prow  , const float* wnorm, bf16* og  , int lane) {
    const u32x4* o4 = (const u32x4*)prow + lane; const u32x4* z4 = (const u32x4*)(prow + GQKV) + lane;
    const f32x4* w4 = (const f32x4*)(wnorm + 8 * (lane & 15));
    const f32x4 wa = w4[0], wb = w4[1];
    u32x4* d4 = (u32x4*)og + lane;
#pragma unroll 1
    for (int qh = 0; qh < 2; ++qh) {
        u32x4 ow[4], zw[4];
#pragma unroll
        for (int q = 0; q < 4; ++q) { ow[q] = o4[64 * (4 * qh + q)]; zw[q] = z4[64 * (4 * qh + q)]; }
#pragma unroll
        for (int q = 0; q < 4; ++q) {
            const u32x4 w = ow[q]; const float o0 = bflo(w.x), o1 = bfhi(w.x), o2 = bflo(w.y), o3 = bfhi(w.y), o5 = bfhi(w.z), o4v = bflo(w.z), o6 = bflo(w.w), o7 = bfhi(w.w);
            float ss = (o0 * o0 + o1 * o1) + (o2 * o2 + o3 * o3) + (o4v * o4v + o5 * o5) + (o6 * o6 + o7 * o7);
            ss += __shfl_xor(ss, 1); ss += __shfl_xor(ss, 2); ss += __shfl_xor(ss, 4); ss += __shfl_xor(ss, 8);
            const float r = FAST_RSQ(ss * (1.0f / 128.0f) + EPS);
            const u32x4 z = zw[q]; u32x4 d;
            d.x = pk2(o0 * r * wa.x * siluf_(bflo(z.x)), o1 * r * wa.y * siluf_(bfhi(z.x)));
            d.y = pk2(o2 * r * wa.z * siluf_(bflo(z.y)), o3 * r * wa.w * siluf_(bfhi(z.y)));
            d.z = pk2(o4v * r * wb.x * siluf_(bflo(z.z)), o5 * r * wb.y * siluf_(bfhi(z.z)));
            d.w = pk2(o6 * r * wb.z * siluf_(bflo(z.w)), o7 * r * wb.w * siluf_(bfhi(z.w)));
            d4[64 * (4 * qh + q)] = d; }
    }
}

__device__ __forceinline__ void gdn_gate_rows(const bf16* proj, const float* wnorm, bf16* og, int gw, int NGW, int lane) {
    const f32x4* w4 = (const f32x4*)(wnorm + 8 * (lane & 15)); const f32x4 wa = w4[0], wb = w4[1];
    u32x4 ow[4], zw[4], on[4], zn[4];
    int m = gw, qh = 0;
    if (m < MTOK) { const u32x4* o4 = (const u32x4*)(proj + (size_t)m * PPITCH) + lane; const u32x4* z4 = (const u32x4*)(proj + (size_t)m * PPITCH + GQKV) + lane;
#pragma unroll
        for (int q = 0; q < 4; ++q) { ow[q] = o4[64 * q]; zw[q] = z4[64 * q]; } }
#pragma unroll 1
    while (m < MTOK) {
        const int mn = qh ? m + NGW : m, qn = qh ^ 1;
        if (mn < MTOK) { const u32x4* o4 = (const u32x4*)(proj + (size_t)mn * PPITCH) + lane; const u32x4* z4 = (const u32x4*)(proj + (size_t)mn * PPITCH + GQKV) + lane;
#pragma unroll
            for (int q = 0; q < 4; ++q) { on[q] = o4[64 * (4 * qn + q)]; zn[q] = z4[64 * (4 * qn + q)]; } }
        u32x4* d4 = (u32x4*)(og + (size_t)m * GZ) + lane;
#pragma unroll
        for (int q = 0; q < 4; ++q) {
            const u32x4 w = ow[q]; const float o0 = bflo(w.x), o1 = bfhi(w.x), o2 = bflo(w.y), o3 = bfhi(w.y), o5 = bfhi(w.z), o4v = bflo(w.z), o6 = bflo(w.w), o7 = bfhi(w.w);
            float ss = (o0 * o0 + o1 * o1) + (o2 * o2 + o3 * o3) + (o4v * o4v + o5 * o5) + (o6 * o6 + o7 * o7);
            ss += __shfl_xor(ss, 1); ss += __shfl_xor(ss, 2); ss += __shfl_xor(ss, 4); ss += __shfl_xor(ss, 8);
            const float r = FAST_RSQ(ss * (1.0f / 128.0f) + EPS);
            const u32x4 z = zw[q]; u32x4 d;
            d.x = pk2(o0 * r * wa.x * siluf_(bflo(z.x)), o1 * r * wa.y * siluf_(bfhi(z.x)));
            d.y = pk2(o2 * r * wa.z * siluf_(bflo(z.y)), o3 * r * wa.w * siluf_(bfhi(z.y)));
            d.z = pk2(o4v * r * wb.x * siluf_(bflo(z.z)), o5 * r * wb.y * siluf_(bfhi(z.z)));
            d.w = pk2(o6 * r * wb.z * siluf_(bflo(z.w)), o7 * r * wb.w * siluf_(bfhi(z.w)));
            d4[64 * (4 * qh + q)] = d; }
#pragma unroll
        for (int q = 0; q < 4; ++q) { ow[q] = on[q]; zw[q] = zn[q]; }
        m = mn; qh = qn;
    }
}
struct AttP {
    const bf16* qkv;
    const float* cache_k;
    const float* cache_v;
    const float* relb;
    bf16* ao;
};
constexpr int AL_K = 0, AL_VT = 17408, AL_VP = 160, AL_TILE = AL_VT + 64 * AL_VP * 2, AL_BIAS = 2 * AL_TILE, AL_END = AL_BIAS + 2064;
constexpr int QKVP = 6144;
constexpr float ATT_SCALE = 0.08838834764831845f;

struct AttTileRegs { u32x4 k[2], v[2]; };
__device__ __forceinline__ void att_load_bf16(AttTileRegs& R, const bf16* krow0, const bf16* vrow0, size_t pitch, int nkeys, int tid) {
#pragma unroll
    for (int i = 0; i < 2; ++i) { const int id = tid + 512 * i, key = id >> 4, part = id & 15;
        R.k[i] = key < nkeys ? *(const u32x4*)(krow0 + (size_t)key * pitch + part * 8) : (u32x4){0u, 0u, 0u, 0u};
        R.v[i] = key < nkeys ? *(const u32x4*)(vrow0 + (size_t)key * pitch + part * 8) : (u32x4){0u, 0u, 0u, 0u}; }
}
__device__ __forceinline__ void att_load_f32(AttTileRegs& R, const float* krow0, const float* vrow0, size_t pitch, int tid) {
#pragma unroll
    for (int i = 0; i < 2; ++i) { const int id = tid + 512 * i, key = id >> 4, part = id & 15;
        const f32x4* ks = (const f32x4*)(krow0 + (size_t)key * pitch + part * 8); const f32x4* vs = (const f32x4*)(vrow0 + (size_t)key * pitch + part * 8);
        const f32x4 a = ks[0], b = ks[1], c = vs[0], d = vs[1];
        R.k[i] = (u32x4){pk2(a.x, a.y), pk2(a.z, a.w), pk2(b.x, b.y), pk2(b.z, b.w)};
        R.v[i] = (u32x4){pk2(c.x, c.y), pk2(c.z, c.w), pk2(d.x, d.y), pk2(d.z, d.w)}; }
}
__device__ __forceinline__ void att_store_tile(const AttTileRegs& R, LAS unsigned char* lds, int tid) {
    LAS bf16* K = (LAS bf16*)(lds + AL_K); LAS bf16* V = (LAS bf16*)(lds + AL_VT);
#pragma unroll
    for (int i = 0; i < 2; ++i) { const int id = tid + 512 * i, key = id >> 4, part = id & 15;
        *(LAS u32x4*)(K + key * 136 + part * 8) = R.k[i];
        *(LAS u32x4*)(V + key * AL_VP + part * 8) = R.v[i]; }
}
struct AttState { f32x16 OT[4]; float m, l; };
constexpr float ATT_C1 = ATT_SCALE * 1.4426950408889634f;
constexpr float ATT_DEFER = 8.0f;
template <int NSUB>
__device__ __forceinline__ void att_tile(AttState& st, const bf16x8 (&qf)[8], const LAS unsigned char* lds, const LAS unsigned char* ldsb, int rel0, int lane, int nvalid = 64) {
    const int h = lane >> 5, l31 = lane & 31;
    const LAS bf16* K = (const LAS bf16*)(lds + AL_K); const LAS bf16* V = (const LAS bf16*)(lds + AL_VT); const LAS float* bias = (const LAS float*)(ldsb + AL_BIAS);
    f32x16 sc[NSUB]; float mx = -1e30f;
#pragma unroll
    for (int sub = 0; sub < NSUB; ++sub) {
#pragma unroll
        for (int r = 0; r < 16; ++r) sc[sub][r] = 0.f;
        const LAS bf16* Arow = K + (32 * sub + l31) * 136 + 8 * h;
#pragma unroll
        for (int s = 0; s < 8; ++s) sc[sub] = MFMA32(*(const LAS bf16x8*)(Arow + 16 * s), qf[s], sc[sub]);
        if (rel0 - 63 >= MAXREL) {
            const float bc = bias[2 * MAXREL];
#pragma unroll
            for (int r = 0; r < 16; ++r) { const float x = sc[sub][r] * ATT_C1 + bc; sc[sub][r] = x; mx = fmaxf(mx, x); }
        } else {
#pragma unroll
            for (int r = 0; r < 16; ++r) { int rel = rel0 + l31 - (32 * sub + accrow(r, h)); rel = rel < -MAXREL ? -MAXREL : (rel > MAXREL ? MAXREL : rel);
                const float x = sc[sub][r] * ATT_C1 + bias[rel + MAXREL]; sc[sub][r] = x; mx = fmaxf(mx, x); }
        }
    }
    if (nvalid < 64) {
        mx = -1e30f;
#pragma unroll
        for (int sub = 0; sub < NSUB; ++sub)
#pragma unroll
            for (int r = 0; r < 16; ++r) { if (32 * sub + accrow(r, h) >= nvalid) sc[sub][r] = -1e30f; mx = fmaxf(mx, sc[sub][r]); }
    }
    mx = fmaxf(mx, __shfl_xor(mx, 32));
    if (ANY_LANE(mx > st.m + ATT_DEFER)) {
        const float mnew = fmaxf(st.m, mx), alpha = FAST_EXP2(st.m - mnew);
        st.m = mnew; st.l *= alpha;
#pragma unroll
        for (int dt = 0; dt < 4; ++dt)
#pragma unroll
            for (int r = 0; r < 16; ++r) st.OT[dt][r] *= alpha;
    }
    const float mcur = st.m; float ps = 0.f;
#pragma unroll
    for (int sub = 0; sub < NSUB; ++sub)
#pragma unroll
        for (int r = 0; r < 16; ++r) { const float pv = FAST_EXP2(sc[sub][r] - mcur); sc[sub][r] = pv; ps += pv; }
    st.l += ps;
#pragma unroll
    for (int sub = 0; sub < NSUB; ++sub) {
        const bf16x8 pf0 = acc_frag(sc[sub], 0), pf1 = acc_frag(sc[sub], 1);
        const LAS bf16* vblk = V + (32 * sub + 4 * h + ((lane & 15) >> 2)) * AL_VP + 16 * ((lane >> 4) & 1) + 4 * (lane & 3);
#pragma unroll
        for (int dt = 0; dt < 4; ++dt) {
            const LAS bf16* vb = vblk + 32 * dt;
            u32x4 a0, a1; { const u32x2 x = LDS_TR16(vb), y = LDS_TR16(vb + 8 * AL_VP); a0 = (u32x4){x.x, x.y, y.x, y.y}; }
            { const u32x2 x = LDS_TR16(vb + 16 * AL_VP), y = LDS_TR16(vb + 24 * AL_VP); a1 = (u32x4){x.x, x.y, y.x, y.y}; }
            st.OT[dt] = MFMA32(__builtin_bit_cast(bf16x8, a0), pf0, st.OT[dt]);
            st.OT[dt] = MFMA32(__builtin_bit_cast(bf16x8, a1), pf1, st.OT[dt]);
        }
    }
}
__device__ __forceinline__ void att_init(AttState& st) {
#pragma unroll
    for (int dt = 0; dt < 4; ++dt)
#pragma unroll
        for (int r = 0; r < 16; ++r) st.OT[dt][r] = 0.f;
    st.m = -1e30f; st.l = 0.f;
}
__device__ __forceinline__ void att_load_q(bf16x8 (&qf)[8], const bf16* qrow  , int h) {
#pragma unroll
    for (int s = 0; s < 8; ++s) qf[s] = *(const bf16x8*)(qrow + 16 * s + 8 * h);
}
__device__ __forceinline__ void att_finish(AttState& st, bf16* orow  , int h) {
    const float lt = st.l + __shfl_xor(st.l, 32); const float inv = 1.0f / lt;
#pragma unroll
    for (int dt = 0; dt < 4; ++dt)
#pragma unroll
        for (int g = 0; g < 4; ++g) { u32x2 w; w.x = pk2(st.OT[dt][4 * g] * inv, st.OT[dt][4 * g + 1] * inv); w.y = pk2(st.OT[dt][4 * g + 2] * inv, st.OT[dt][4 * g + 3] * inv);
            *(u32x2*)(orow + 32 * dt + 8 * g + 4 * h) = w; }
}
__device__ __forceinline__ void att_load_bias(const AttP& p, LAS unsigned char* lds, int head, int tid) {
    LAS float* bias = (LAS float*)(lds + AL_BIAS);
    for (int i = tid; i < 2 * MAXREL + 1; i += 512) bias[i] = p.relb[head * (2 * MAXREL + 1) + i] * 1.4426950408889634f;
}
__device__ __forceinline__ void att_prompt_unit(const AttP& p, LAS unsigned char* lds, int g4, int head) {
    const int tid = tid_opaque(), lane = tid & 63, wid = RFL(tid >> 6), h = lane >> 5, l31 = lane & 31;
    const int cq = 4 * g4 + (wid >> 1), q0 = 64 * cq + 32 * (wid & 1);
    att_load_bias(p, lds, head, tid);
    bf16x8 qf[8]; att_load_q(qf, p.qkv + (size_t)(q0 + l31) * QKVP + head * 128, h);
    AttState st; att_init(st);
    const int kc0 = (4 * g4 - 8) > 0 ? (4 * g4 - 8) : 0, kc1 = 4 * g4 + 3;
    AttTileRegs R;
    att_load_bf16(R, p.qkv + (size_t)(64 * kc0) * QKVP + 2048 + head * 128, p.qkv + (size_t)(64 * kc0) * QKVP + 4096 + head * 128, QKVP, 64, tid);
    att_store_tile(R, lds, tid);
    WG_BARRIER();
    for (int kc = kc0; kc <= kc1; ++kc) {
        const int cur = (kc - kc0) & 1;
        if (kc < kc1) att_load_bf16(R, p.qkv + (size_t)(64 * (kc + 1)) * QKVP + 2048 + head * 128, p.qkv + (size_t)(64 * (kc + 1)) * QKVP + 4096 + head * 128, QKVP, 64, tid);
        if (kc >= cq - 8 && kc <= cq) att_tile<2>(st, qf, lds + cur * AL_TILE, lds, q0 - 64 * kc, lane);
        if (kc < kc1) att_store_tile(R, lds + (cur ^ 1) * AL_TILE, tid);
        WG_BARRIER();
    }
    att_finish(st, p.ao + (size_t)(q0 + l31) * DM + head * 128, h);
}
__device__ __forceinline__ void att_sample_unit(const AttP& p, LAS unsigned char* lds, int b, int head) {
    const int tid = tid_opaque(), lane = tid & 63, wid = RFL(tid >> 6), h = lane >> 5, l31 = lane & 31;
    const int row0 = SEQ + 32 * b;
    att_load_bias(p, lds, head, tid);
    bf16x8 qf[8]; AttState st;
    if (wid == 0) { att_load_q(qf, p.qkv + (size_t)(row0 + l31) * QKVP + head * 128, h); att_init(st); }
    const float* ck = p.cache_k + ((size_t)b * 512 * 16 + head) * 128; const float* cv = p.cache_v + ((size_t)b * 512 * 16 + head) * 128;
    AttTileRegs R;
    att_load_f32(R, ck, cv, 2048, tid);
    att_store_tile(R, lds, tid);
    WG_BARRIER();
    for (int t = 0; t < 9; ++t) {
        const int cur = t & 1;
        if (t < 7) att_load_f32(R, ck + (size_t)(64 * (t + 1)) * 2048, cv + (size_t)(64 * (t + 1)) * 2048, 2048, tid);
        else if (t == 7) att_load_bf16(R, p.qkv + (size_t)row0 * QKVP + 2048 + head * 128, p.qkv + (size_t)row0 * QKVP + 4096 + head * 128, QKVP, 32, tid);
        if (wid == 0) att_tile<2>(st, qf, lds + cur * AL_TILE, lds, 512 - 64 * t, lane, t < 8 ? 64 : 32);
        if (t < 8) att_store_tile(R, lds + (cur ^ 1) * AL_TILE, tid);
        WG_BARRIER();
    }
    if (wid == 0) att_finish(st, p.ao + (size_t)(row0 + l31) * DM + head * 128, h);
}
#ifndef EMU
constexpr size_t MiB = 1u << 20;
constexpr size_t WS_CTL = 0, CTL_ZERO_BYTES = 1 * MiB;
constexpr size_t WS_BA = 1 * MiB;
constexpr size_t WS_DEC = 6 * MiB;
constexpr size_t WS_WIN = 7 * MiB;
constexpr size_t WS_WOUT = WS_WIN + 49 * MiB;
constexpr size_t WS_WGU = WS_WOUT + 16 * MiB;
constexpr size_t WS_WDN = WS_WGU + 44 * MiB;
constexpr size_t WS_XB = WS_WDN + 22 * MiB;
constexpr size_t WS_PROJ = WS_XB + 66 * MiB;
constexpr size_t WS_U = WS_PROJ + 396 * MiB;
constexpr size_t WS_WN = WS_U + 136 * MiB, WS_QG = WS_WN + 136 * MiB, WS_KG = WS_QG + 136 * MiB, WS_QK = WS_KG + 136 * MiB;
constexpr size_t WS_WIN_B = WS_QK + 68 * MiB;
constexpr size_t WS_WOUT_B = WS_WIN_B + 24 * MiB, WS_WGU_B = WS_WOUT_B + 8 * MiB, WS_WDN_B = WS_WGU_B + 44 * MiB;
constexpr size_t WS_SL = WS_WDN_B + 22 * MiB;
constexpr size_t WS_END = WS_SL + 2 * MiB;
constexpr size_t WS_R = WS_DEC + MiB / 2;
template <int layer> struct WB { static constexpr size_t WIN = (layer & 1) ? WS_WIN_B : WS_WIN, WOUT = (layer & 1) ? WS_WOUT_B : WS_WOUT, WGU = (layer & 1) ? WS_WGU_B : WS_WGU, WDN = (layer & 1) ? WS_WDN_B : WS_WDN; };
static_assert((size_t)GPROJ_PAD * DM * 2 <= 49 * MiB && (size_t)MTOK * DM * 2 <= 66 * MiB && (size_t)MTOK * PPITCH * 2 <= 396 * MiB && (size_t)NCIDX * 32 * 8192 * 2 <= 136 * MiB && (size_t)MTOK * 4096 * 2 <= 136 * MiB, "ws map");
constexpr int CW_BAR = 4096;
constexpr int LDS_MISC = 133120, LDS_ARGS = LDS_MISC + 64, LDS_BYTES = LDS_MISC + 512;
static_assert(PL_END <= LDS_MISC && 2 * SCAN_BUF <= LDS_MISC && AL_END <= LDS_MISC && 8 * WT_SCR <= LDS_MISC && pg8::STAGE_BYTES <= LDS_MISC, "LDS map");
constexpr size_t O_YP = 0, O_YS = 33554432, O_PREC = 34603008, O_PCONV = 35651584, O_PK = 35700736, O_PV = 37797888, O_SREC = 39895040, O_SCONV = 56672256, O_SK = 57458688, O_SV = 59555840, O_END = 61652992;

struct KArgs { const float* in[23]; float* out; unsigned char* ws; };
__device__ __forceinline__ unsigned long long ldarg_u64(LAS unsigned char* lds, int i) {
    volatile LAS unsigned* p = (volatile LAS unsigned*)(lds + LDS_ARGS) + 2 * i; const unsigned lo = RFL(p[0]), hi = RFL(p[1]); return ((unsigned long long)hi << 32) | lo; }
#define ARGF(i) ((const float*)ldarg_u64(lds, (i)))
#define ARGOUT() ((float*)ldarg_u64(lds, 23))
#define ARGWS() ((unsigned char*)ldarg_u64(lds, 24))
#define XHP() ((bf16*)(ARGOUT() + (size_t)SEQ * DM / 2))

#ifndef PROBE_REP_GEMM
#define PROBE_REP_GEMM 0
#endif
#ifndef PROBE_REP_GDN
#define PROBE_REP_GDN 0
#endif
#ifndef PROBE_REP_PREP
#define PROBE_REP_PREP PROBE_REP_GDN
#endif
#ifndef PROBE_REP_SCAN
#define PROBE_REP_SCAN PROBE_REP_GDN
#endif
#ifndef PROBE_REP_GATE
#define PROBE_REP_GATE PROBE_REP_GDN
#endif
#ifndef PROBE_REP_ATT
#define PROBE_REP_ATT 0
#endif
#ifndef PROBE_REP_THIN
#define PROBE_REP_THIN 0
#endif
#define PHASE_IDS() int G = G0, bid = bid0; LAS unsigned char* lds = lds0; asm volatile("" : "+s"(G), "+s"(bid), "+s"(lds)); const int tidp = tid_opaque(), lane = tidp & 63, wid = RFL(tidp >> 6), gw = bid * 8 + wid, NGW = G * 8; (void)lane; (void)gw; (void)NGW; (void)tidp
#define GRID_BAR() do { XcdBarrier b_ = bar; unsigned* bp_ = b_.bar; unsigned bx_ = b_.x; asm volatile("" : "+s"(bp_), "+s"(bx_)); b_.bar = bp_; b_.x = bx_; xcd_barrier(b_); } while (0)
#define WSP(T, off) ((T*)(ARGWS() + (off)))
#define PHASE_FN template <int layer> __device__ __forceinline__ void
#define PHASE_ARGS LAS unsigned char* const lds0, const int G0, const int bid0
template <int layer> __device__ __forceinline__ WtItem conv_item(LAS unsigned char* lds, int r) {
    constexpr int L_ = layer, J_ = layer >> 1;
#define WT_JOB(Wp, WTp, Kv, Nv, modev, scl) { const WtJob jb{(Wp), (WTp), (Kv), (Nv), (modev), (scl)}; const int nj = wt_items(jb); if (r < nj) return wt_item_of(jb, r); r -= nj; }
    if (L_ & 1) { WT_JOB(ARGF(15) + (size_t)J_ * DM * 3 * DM, WSP(bf16, WB<layer>::WIN), DM, 3 * DM, 0, ARGF(6) + (size_t)L_ * DM) WT_JOB(ARGF(18) + (size_t)J_ * DM * DM, WSP(bf16, WB<layer>::WOUT), DM, DM, 0, nullptr) }
    else { WT_JOB(ARGF(9) + (size_t)J_ * DM * GPROJ, WSP(bf16, WB<layer>::WIN), DM, GPROJ, 0, ARGF(6) + (size_t)L_ * DM) WT_JOB(ARGF(14) + (size_t)J_ * GZ * DM, WSP(bf16, WB<layer>::WOUT), GZ, DM, 0, nullptr) }
    WT_JOB(ARGF(20) + (size_t)L_ * DM * DFF, WSP(bf16, WB<layer>::WGU), DM, DFF, 1, ARGF(7) + (size_t)L_ * DM) WT_JOB(ARGF(21) + (size_t)L_ * DM * DFF, WSP(bf16, WB<layer>::WGU), DM, DFF, 2, ARGF(7) + (size_t)L_ * DM)
    { const WtJob jb{ARGF(22) + (size_t)L_ * DFF * DM, WSP(bf16, WB<layer>::WDN), DFF, DM, 0, nullptr}; return wt_item_of(jb, r); }
#undef WT_JOB
}
#ifndef CONV_PACE
#define CONV_PACE 100
#endif
template <int layer, int PART, bool PACED = false> __device__ __forceinline__ void convert_layer(LAS unsigned char* lds, int gwr, int nw, int wid, int lane, int tlin, int ntlin) {
    constexpr int nffn = 3 * (DM / 64) * (DFF / 64); constexpr int nmix = (layer & 1) ? (DM / 64) * (3 * DM / 64) + (DM / 64) * (DM / 64) : (DM / 64) * (GPROJ / 64) + (GZ / 64) * (DM / 64);
    constexpr int nfirst = (layer & 1) ? (DM / 64) * (3 * DM / 64) : (DM / 64) * (GPROJ / 64);
    constexpr int ibeg = PART == 1 ? nfirst : 0, iend = PART == 0 ? nfirst : nffn + nmix;
    LAS float* scr = (LAS float*)(lds + wid * WT_SCR);
    int it = ibeg + gwr; f32x4 va[16], vb[16]; float sa = 1.f, sb = 1.f;
    if (it < iend) { const WtItem I = conv_item<layer>(lds, it); wt_load(I, va, sa, lane); }
#pragma unroll 1
    while (it < iend) {
        const int nx = it + nw; const bool more = nx < iend;
        if (more) { const WtItem N = conv_item<layer>(lds, nx); wt_load(N, vb, sb, lane); }
        { const WtItem I = conv_item<layer>(lds, it); wt_store(I, va, sa, scr, lane); }
        if constexpr (PACED && CONV_PACE > 0) __builtin_amdgcn_s_sleep(CONV_PACE);
#pragma unroll
        for (int i = 0; i < 16; ++i) va[i] = vb[i];
        sa = sb;
        it = nx;
    }
    if (!(layer & 1) && PART != 1) { u32x4* z = (u32x4*)(WSP(bf16, WB<layer>::WIN) + (size_t)GPROJ * DM); const int nz = (GPROJ_PAD - GPROJ) * DM * 2 / 16; for (int i = tlin; i < nz; i += ntlin) z[i] = (u32x4){0u, 0u, 0u, 0u}; }
}
PHASE_FN ph_convert(PHASE_ARGS) { PHASE_IDS(); convert_layer<layer, 0>(lds, gw, NGW, wid, lane, bid * 512 + tidp, G * 512); }
PHASE_FN ph_rms_in(PHASE_ARGS) {
    PHASE_IDS(); const float* xp = ARGF(0); const float* xs = ARGF(1); float* xres = ARGOUT(); bf16* XB = WSP(bf16, WS_XB);
    cvt_rows(xp, nullptr, XHP(), WSP(float, WS_R), SEQ, gw, NGW, lane);
    cvt_rows(xs, xres + (size_t)SEQ * DM, XB + (size_t)SEQ * DM, WSP(float, WS_R) + SEQ, DECB * DECS, NGW - 1 - gw, NGW, lane);
}
PHASE_FN ph_smp(PHASE_ARGS) {
    PHASE_IDS(); const float* xres = ARGOUT(); bf16* XB = WSP(bf16, WS_XB);
    cvt_rows(xres + (size_t)SEQ * DM, nullptr, XB + (size_t)SEQ * DM, WSP(float, WS_R) + SEQ, DECB * DECS, NGW - 1 - gw, NGW, lane);
    slots_to_r(WSP(float, WS_SL), WSP(float, WS_R), SEQ, bid * 512 + tidp, G * 512);
}
__device__ __forceinline__ void ph_final(PHASE_ARGS, const XcdBarrier& bar) {
    PHASE_IDS(); float* xres = ARGOUT(); const float* nw = ARGF(8); const bf16* XH = XHP();
    u32x4 hold[4][4];
#pragma unroll
    for (int i = 0; i < 4; ++i) { const int m = SEQ / 2 + gw + NGW * i; if (m < SEQ) rms_h_load(XH, m, hold[i], lane); }
    rms_rows_h(XH, nw, nullptr, xres, SEQ / 2, gw, NGW, lane);
    rms_rows(xres + (size_t)SEQ * DM, nw, nullptr, nullptr, xres + (size_t)SEQ * DM, DECB * DECS, NGW - 1 - gw, NGW, lane);
    asm volatile("s_waitcnt vmcnt(0)" ::: "memory");
    GRID_BAR();
#pragma unroll
    for (int i = 0; i < 4; ++i) { const int m = SEQ / 2 + gw + NGW * i; if (m < SEQ) rms_h_finish(hold[i], nw, nullptr, xres, m, lane); }
}
PHASE_FN ph_g1(PHASE_ARGS) {
    PHASE_IDS(); pg8::Gemm g{XHP(), WSP(bf16, WB<layer>::WIN), MTOK, GPROJ_PAD, DM, DM, WSP(bf16, WS_XB) + (size_t)SEQ * DM, SEQ / 256, WSP(float, WS_R)}; pg8::StaticOrder S; S.init(MTOK, GPROJ_PAD, G, bid);
    pg8::EpiProj E{WSP(bf16, WS_PROJ), PPITCH, WSP(float, WS_BA), 12288};
    pg8::gemm_phase<pg8::EpiProj, pg8::StaticOrder, true, true, true>(lds, g, S, E);
}
#define MAKE_GDNP(gp) constexpr int j = layer >> 1; const float* in10_ = ARGF(10); const float* in11_ = ARGF(11); const float* in12_ = ARGF(12); const float* in3_ = ARGF(3); const float* in2_ = ARGF(2); float* out_ = ARGOUT(); unsigned char* ws_ = ARGWS(); \
        const GdnP gp{(const bf16*)(ws_ + WS_PROJ), (const float*)(ws_ + WS_BA), in10_ + (size_t)j * 4 * GQKV, in11_ + j * 32, in12_ + j * 32, in3_ + (size_t)j * DECB * 3 * GQKV, in2_ + (size_t)j * DECB * HV * 16384, \
                out_ + O_PCONV + (size_t)j * 3 * GQKV, out_ + O_SCONV + (size_t)j * DECB * 3 * GQKV, out_ + O_PREC + (size_t)j * HV * 16384, out_ + O_SREC + (size_t)j * DECB * HV * 16384, \
                (bf16*)(ws_ + WS_U), (bf16*)(ws_ + WS_WN), (bf16*)(ws_ + WS_QG), (bf16*)(ws_ + WS_KG), (bf16*)(ws_ + WS_QK), (float*)(ws_ + WS_DEC), (bf16*)(ws_ + WS_PROJ)}
PHASE_FN ph_prep(PHASE_ARGS) {
    PHASE_IDS(); MAKE_GDNP(gp);
    PrepIn<64> in; int u = bid;
    if (u < NCH * HK) gdn_prep_fetch<64>(gp, u >> 4, u & 15, in, lane, wid);
#pragma unroll 1
    for (; u < NCH * HK; u += G) { const int un = u + G; const bool more = un < NCH * HK;
        gdn_prep_unit<64>(gp, lds, u >> 4, u & 15, in, more ? (un >> 4) : -1, un & 15); }
#pragma unroll 1
    for (; u < NCH * HK + DECB * HK; u += G) gdn_prep_unit<32>(gp, lds, NCH + ((u - NCH * HK) >> 4), u & 15);
}
template <int layer, bool CONV> __device__ __forceinline__ void ph_scan_(PHASE_ARGS) {
    PHASE_IDS(); MAKE_GDNP(gp);
    if (bid < 4 * HV) { const int x = bid & 7, q = bid >> 3, hv = x + 8 * (q >> 2), vt = q & 3;
        gdn_scan_unit<2>(gp, lds, hv, vt, 0, NCH, nullptr, gp.out_prec + (size_t)hv * 16384, 0);
#ifdef PROBE_SCAN_TWICE
        gdn_scan_unit<2>(gp, lds, hv, vt, 0, NCH, nullptr, gp.out_prec + (size_t)hv * 16384, 0);
#endif
        }
    else {
#ifdef PROBE_OTHER_TWICE
#pragma unroll 1
      for (int rep_ = 0; rep_ < 2; ++rep_) {
#else
      {
#endif
#pragma unroll 1
        for (int u = bid - 4 * HV; u < DECB * HV * 4; u += G - 4 * HV) { const int b = u >> 7, hv = (u >> 2) & 31, vt = u & 3;
            gdn_scan_unit<1>(gp, lds, hv, vt, NCH + b, 1, gp.rec_state + ((size_t)b * HV + hv) * 16384, gp.out_srec + ((size_t)b * HV + hv) * 16384, SEQ + 32 * b); }
        if constexpr (CONV) {
            convert_layer<layer, 1, true>(lds, (bid - 4 * HV) * 8 + wid, (G - 4 * HV) * 8, wid, lane, (bid - 4 * HV) * 512 + tidp, (G - 4 * HV) * 512);
            if constexpr (layer + 1 < DEPTH) convert_layer<layer + 1, 2, true>(lds, (bid - 4 * HV) * 8 + wid, (G - 4 * HV) * 8, wid, lane, (bid - 4 * HV) * 512 + tidp, (G - 4 * HV) * 512); }
        __syncthreads();
      }
    }
}
PHASE_FN ph_scan(PHASE_ARGS) { ph_scan_<layer, true>(lds0, G0, bid0); }
PHASE_FN ph_scan_noconv(PHASE_ARGS) { ph_scan_<layer, false>(lds0, G0, bid0); }
PHASE_FN ph_gate(PHASE_ARGS) {
    PHASE_IDS(); constexpr int j = layer >> 1; const bf16* PROJ = WSP(bf16, WS_PROJ); bf16* OG = WSP(bf16, WS_U); const float* wn = ARGF(13) + j * 128;
    gdn_gate_rows(PROJ, wn, OG, gw, NGW, lane);
}
template <int KC, int SPL, bool DUMMY, bool FIRST = false> __device__ __forceinline__ void resid_gemm(PHASE_ARGS, size_t a_off, size_t b_off, int bias_arg, size_t bias_off) {
    PHASE_IDS(); pg8::Gemm g{WSP(bf16, a_off), WSP(bf16, b_off), SEQ, DM, KC, KC}; pg8::StaticOrder S; S.init(SEQ, DM, G, bid);
    float* X = DUMMY ? WSP(float, WS_END) : ARGOUT(); const float* bias = bias_arg >= 0 ? ARGF(bias_arg) + bias_off : nullptr;
    pg8::EpiResidH<FIRST> E{DUMMY ? WSP(bf16, WS_END) : XHP(), DM, bias, ARGF(0), WSP(float, WS_SL)};
    pg8::gemm_phase<pg8::EpiResidH<FIRST>, pg8::StaticOrder, true, true>(lds, g, S, E);
    __syncthreads();
    { constexpr int KS = KC / SPL; const int su = bid / SPL, ks = bid - su * SPL;
      pg8::Gemm g2{WSP(bf16, a_off) + ks * KS, WSP(bf16, b_off) + ks * KS, MTOK, DM, KS, KC}; const pg8::SingleUnit S2{64 + (su >> 3), su & 7, bid < 16 * SPL};
      pg8::EpiAtomic E2{X, DM, ks == 0 ? bias : nullptr};
      pg8::gemm_phase<pg8::EpiAtomic, pg8::SingleUnit, false, true>(lds, g2, S2, E2); }
}
template <int layer, bool DUMMY> __device__ __forceinline__ void ph_g5(PHASE_ARGS) { resid_gemm<GZ, 16, DUMMY, layer == 0>(lds0, G0, bid0, WS_U, WB<layer>::WOUT, -1, 0); }
PHASE_FN ph_a1(PHASE_ARGS) {
    PHASE_IDS(); constexpr int j = layer >> 1; pg8::Gemm g{XHP(), WSP(bf16, WB<layer>::WIN), MTOK, 3 * DM, DM, DM, WSP(bf16, WS_XB) + (size_t)SEQ * DM, SEQ / 256, WSP(float, WS_R)}; pg8::StaticOrder S; S.init(MTOK, 3 * DM, G, bid);
    static_assert(O_PV - O_PK == O_SV - O_SK, "k/v output spacing");
    pg8::EpiQkv E{WSP(bf16, WS_PROJ), QKVP, ARGF(16) + (size_t)j * 3 * DM, ARGOUT() + O_PK + (size_t)j * 512 * DM, (long)(O_PV - O_PK), (long)(O_SK - O_PK)};
    pg8::gemm_phase<pg8::EpiQkv, pg8::StaticOrder, true, true, true>(lds, g, S, E);
}
PHASE_FN ph_att(PHASE_ARGS) {
    PHASE_IDS(); constexpr int j = layer >> 1;
    const AttP ap{WSP(bf16, WS_PROJ), ARGF(4) + (size_t)j * DECB * 512 * DM, ARGF(5) + (size_t)j * DECB * 512 * DM, ARGF(17) + (size_t)j * AH * 513, WSP(bf16, WS_XB)};
#pragma unroll 1
    for (int u = bid; u < 64 * AH + DECB * AH; u += G) {
        if (u < 64 * AH) att_prompt_unit(ap, lds, u >> 4, u & 15);
        else att_sample_unit(ap, lds, (u - 64 * AH) >> 4, u & 15);
    }
}
template <int layer, bool DUMMY> __device__ __forceinline__ void ph_a3(PHASE_ARGS) { resid_gemm<DM, 8, DUMMY>(lds0, G0, bid0, WS_XB, WB<layer>::WOUT, 19, (size_t)(layer >> 1) * DM); }
PHASE_FN ph_f1(PHASE_ARGS) {
    PHASE_IDS(); pg8::Gemm g{XHP(), WSP(bf16, WB<layer>::WGU), MTOK, 2 * DFF, DM, DM, WSP(bf16, WS_XB) + (size_t)SEQ * DM, SEQ / 256, WSP(float, WS_R)}; pg8::StaticOrder S; S.init(MTOK, 2 * DFF, G, bid);
    pg8::EpiSwiglu E{WSP(bf16, WS_PROJ), DFF};
    pg8::gemm_phase<pg8::EpiSwiglu, pg8::StaticOrder, true, true, true>(lds, g, S, E);
}
template <int layer, bool DUMMY> __device__ __forceinline__ void ph_f2(PHASE_ARGS) { resid_gemm<DFF, 11, DUMMY>(lds0, G0, bid0, WS_PROJ, WB<layer>::WDN, -1, 0); }

#define PH(call, nrep) do { call(lds0, G0, bid0); GRID_BAR(); if constexpr ((nrep) >= 1) { call(lds0, G0, bid0); GRID_BAR(); } if constexpr ((nrep) >= 2) { call(lds0, G0, bid0); GRID_BAR(); } } while (0)
#define PH_RES(fn, nrep) do { fn<layer, false>(lds0, G0, bid0); GRID_BAR(); if constexpr ((nrep) >= 1) { fn<layer, true>(lds0, G0, bid0); GRID_BAR(); } if constexpr ((nrep) >= 2) { fn<layer, true>(lds0, G0, bid0); GRID_BAR(); } } while (0)
template <int layer>
__device__ __forceinline__ void layer_body(LAS unsigned char* const lds0, const int G0, const int bid0, const XcdBarrier& bar) {
    if constexpr ((layer & 1) == 0) {
        PH(ph_g1<layer>, PROBE_REP_GEMM);
        PH(ph_prep<layer>, PROBE_REP_PREP);
        PH(ph_scan<layer>, 0);
        if constexpr (PROBE_REP_SCAN >= 1) { ph_scan_noconv<layer>(lds0, G0, bid0); GRID_BAR(); }
        PH(ph_gate<layer>, PROBE_REP_GATE);
        PH_RES(ph_g5, PROBE_REP_GEMM);
    } else {
        PH(ph_a1<layer>, PROBE_REP_GEMM);
        PH(ph_att<layer>, PROBE_REP_ATT);
        PH_RES(ph_a3, PROBE_REP_GEMM);
    }
    { constexpr auto f0 = 0; (void)f0; }
    PH(ph_smp<layer>, PROBE_REP_THIN);
    PH(ph_f1<layer>, PROBE_REP_GEMM);
    PH_RES(ph_f2, PROBE_REP_GEMM);
    if constexpr (layer + 1 < DEPTH) {
        if constexpr (layer & 1) { ph_convert<layer + 1>(lds0, G0, bid0);
            if constexpr (PROBE_REP_THIN >= 1) ph_convert<layer + 1>(lds0, G0, bid0); }
        PH(ph_smp<layer>, PROBE_REP_THIN);
    } else {
        ph_final(lds0, G0, bid0, bar);
    }
}

__global__ void __launch_bounds__(512, 2) fwd_kernel(KArgs a) {
    extern __shared__ __attribute__((aligned(16))) unsigned char smem[];
    LAS unsigned char* const lds0 = (LAS unsigned char*)smem;
    const int tid = threadIdx.x;
    const int G0 = gridDim.x, bid0 = blockIdx.x;
    volatile LAS unsigned* MISC = (volatile LAS unsigned*)(lds0 + LDS_MISC);
    if (tid < 4) MISC[tid] = 0u;
    if (tid < 25) { const unsigned long long v = tid < 23 ? (unsigned long long)a.in[tid] : (tid == 23 ? (unsigned long long)a.out : (unsigned long long)a.ws);
        volatile LAS unsigned* p = (volatile LAS unsigned*)(lds0 + LDS_ARGS) + 2 * tid; p[0] = (unsigned)v; p[1] = (unsigned)(v >> 32); }
    __syncthreads();
    XcdBarrier bar = xcd_barrier_post((unsigned*)(a.ws + WS_CTL) + CW_BAR, MISC);
    ph_convert<0>(lds0, G0, bid0);
    if constexpr (PROBE_REP_THIN >= 1) ph_convert<0>(lds0, G0, bid0);
    PH(ph_rms_in<0>, PROBE_REP_THIN);
    layer_body<0>(lds0, G0, bid0, bar);
    layer_body<1>(lds0, G0, bid0, bar);
    layer_body<2>(lds0, G0, bid0, bar);
    layer_body<3>(lds0, G0, bid0, bar);
}

extern "C" void kernel_launch(void* const* d_in, const int* in_sizes, int n_in, void* d_out, int out_size, void* d_ws, size_t ws_size, hipStream_t stream) {
    static int grid = 0;
    if (grid == 0) {
        if (n_in != 23 || (size_t)out_size != O_END || ws_size < WS_END + ((PROBE_REP_GEMM > 0) ? (size_t)MTOK * DM * 4 : 0)) { fprintf(stderr, "kernel_launch: unexpected sizes (n_in %d out %d ws %zu, need ws %zu)\n", n_in, out_size, ws_size, (size_t)WS_END); grid = -1; return; }
        int dev = 0, cus = 0;
        if (hipGetDevice(&dev) != hipSuccess || hipDeviceGetAttribute(&cus, hipDeviceAttributeMultiprocessorCount, dev) != hipSuccess) { grid = -1; return; }
        if (hipFuncSetAttribute((const void*)fwd_kernel, hipFuncAttributeMaxDynamicSharedMemorySize, LDS_BYTES) != hipSuccess) { fprintf(stderr, "kernel_launch: hipFuncSetAttribute failed\n"); grid = -1; return; }
        int per_cu = 0;
        if (hipOccupancyMaxActiveBlocksPerMultiprocessor(&per_cu, (const void*)fwd_kernel, 512, LDS_BYTES) != hipSuccess || per_cu < 1) fprintf(stderr, "kernel_launch: occupancy query says %d\n", per_cu);
        (void)hipGetLastError();
        if (cus * 8 * 4 < SEQ / 2) { fprintf(stderr, "kernel_launch: %d CUs: the final norm holds 4 rows per wave\n", cus); grid = -1; return; }
        grid = cus;
    }
    if (grid < 0) return;
    if (hipMemsetAsync((char*)d_ws + WS_CTL, 0, CTL_ZERO_BYTES, stream) != hipSuccess) return;
    KArgs a{};
    for (int i = 0; i < 23; ++i) a.in[i] = (const float*)d_in[i];
    a.out = (float*)d_out; a.ws = (unsigned char*)d_ws;
    hipLaunchKernelGGL(fwd_kernel, dim3(grid), dim3(512), LDS_BYTES, stream, a);
}
#endif
```

```cpp
#ifndef EMU
#include <hip/hip_runtime.h>
#include <cstdio>
typedef short bf16x8 __attribute__((ext_vector_type(8)));
typedef short bf16x4 __attribute__((ext_vector_type(4)));
typedef float f32x16 __attribute__((ext_vector_type(16)));
typedef float f32x4 __attribute__((ext_vector_type(4)));
typedef float f32x2 __attribute__((ext_vector_type(2)));
typedef unsigned u32x4 __attribute__((ext_vector_type(4)));
typedef unsigned u32x2 __attribute__((ext_vector_type(2)));
#define LAS __attribute__((address_space(3)))
#define MFMA32(a, b, c) __builtin_amdgcn_mfma_f32_32x32x16_bf16((a), (b), (c), 0, 0, 0)
#define MFMA16(a, b, c) __builtin_amdgcn_mfma_f32_16x16x32_bf16((a), (b), (c), 0, 0, 0)
#define RFL(x) __builtin_amdgcn_readfirstlane(x)
#define WG_BARRIER() do { asm volatile("s_waitcnt lgkmcnt(0)" ::: "memory"); __builtin_amdgcn_s_barrier(); asm volatile("" ::: "memory"); } while (0)
#define WG_BARRIER_WAVE() asm volatile("s_waitcnt lgkmcnt(0)" ::: "memory")
#define FAST_RCP(x) __builtin_amdgcn_rcpf(x)
#define READLANE_F(v, l) __builtin_bit_cast(float, __builtin_amdgcn_readlane(__builtin_bit_cast(int, (float)(v)), (l)))
#define FAST_EXP2(x) __builtin_amdgcn_exp2f(x)
#define ANY_LANE(p) (__builtin_amdgcn_ballot_w64(p) != 0ull)
#define FAST_RSQ(x) __builtin_amdgcn_rsqf(x)
#define CFENCE() asm volatile("" ::: "memory")
#define SCHED_FENCE() __builtin_amdgcn_sched_barrier(0)
#define LOADER_PACE() do {} while (0)
#define PIN_F(x) asm volatile("" : "+v"(x) :: "memory")
typedef short s16x4_t __attribute__((ext_vector_type(4)));
#define LDS_TR16(p) __builtin_bit_cast(u32x2, __builtin_amdgcn_ds_read_tr16_b64_v4i16((LAS s16x4_t*)(p)))
#else
#define LAS
#define MFMA32(a, b, c) emu::mfma32((a), (b), (c))
#define MFMA16(a, b, c) emu::mfma16((a), (b), (c))
#define RFL(x) (x)
#define WG_BARRIER() __syncthreads()
#define WG_BARRIER_WAVE() emu::wave_sync()
#define FAST_RCP(x) (1.0f / (x))
#define READLANE_F(v, l) emu::shfl((float)(v), (l))
#define FAST_EXP2(x) exp2f(x)
#define ANY_LANE(p) (emu::shfl_any(p))
#define FAST_RSQ(x) (1.0f / sqrtf(x))
#define CFENCE() do {} while (0)
#define SCHED_FENCE() do {} while (0)
#define LOADER_PACE() do {} while (0)
#define PIN_F(x) do {} while (0)
static inline u32x2 emu_lds_tr16(const void* p) {
    const int l = emu::lane(); unsigned short e[4];
    for (int q = 0; q < 4; ++q) { const unsigned long long a = emu::shfl((unsigned long long)(size_t)p, (l & ~15) + 4 * q + ((l & 15) >> 2)); e[q] = *(const unsigned short*)((size_t)a + 2 * (l & 3)); }
    u32x2 r; r.x = e[0] | ((unsigned)e[1] << 16); r.y = e[2] | ((unsigned)e[3] << 16); return r;
}
#define LDS_TR16(p) emu_lds_tr16((const void*)(p))
#endif
typedef unsigned short bf16;
#ifndef EMU
__device__ __forceinline__ int tid_opaque() { int t = threadIdx.x; asm volatile("" : "+v"(t)); return t; }
#else
static inline int tid_opaque() { return threadIdx.x; }
#endif

constexpr int DM = 2048, SEQ = 16384, DEPTH = 4, DECB = 16, DECS = 32;
constexpr int MTOK = SEQ + DECB * DECS;
constexpr int NCH = SEQ / 64;
constexpr int NCIDX = NCH + DECB;
constexpr int GQKV = 8192, GZ = 4096, GPROJ = 12352, GPROJ_PAD = 12544, PPITCH = 12288;
constexpr int HV = 32, HK = 16, DK = 128;
constexpr int DFF = 5632;
constexpr int AH = 16, ADH = 128, MAXREL = 256;
constexpr float EPS = 1e-6f;

__device__ __forceinline__ unsigned f2bf(float f) { unsigned u = __builtin_bit_cast(unsigned, f); return (u + 0x7fffu + ((u >> 16) & 1u)) >> 16; }
#ifndef EMU
typedef __bf16 bf16v2_t __attribute__((ext_vector_type(2)));
__device__ __forceinline__ unsigned pk2(float lo, float hi) { f32x2 v; v.x = lo; v.y = hi; return __builtin_bit_cast(unsigned, __builtin_convertvector(v, bf16v2_t)); }
#else
__device__ __forceinline__ unsigned pk2(float lo, float hi) { return f2bf(lo) | (f2bf(hi) << 16); }
#endif
__device__ __forceinline__ float bf2f(unsigned short b) { return __builtin_bit_cast(float, ((unsigned)b) << 16); }
__device__ __forceinline__ float bflo(unsigned w) { return __builtin_bit_cast(float, w << 16); }
__device__ __forceinline__ float bfhi(unsigned w) { return __builtin_bit_cast(float, w & 0xffff0000u); }
__device__ __forceinline__ float wave_sum(float v) {
#pragma unroll
    for (int o = 1; o < 64; o <<= 1) v += __shfl_xor(v, o);
    return v;
}
__device__ __forceinline__ float sigmoidf_(float x) { return FAST_RCP(1.0f + __expf(-x)); }
__device__ __forceinline__ float siluf_(float x) { return x * FAST_RCP(1.0f + __expf(-x)); }
__device__ __forceinline__ float softplusf_(float x) { return x > 20.f ? x : log1pf(__expf(x)); }
__device__ __forceinline__ bf16x8 pack8(float a0, float a1, float a2, float a3, float a4, float a5, float a6, float a7) {
    u32x4 w; w.x = pk2(a0, a1); w.y = pk2(a2, a3); w.z = pk2(a4, a5); w.w = pk2(a6, a7); return __builtin_bit_cast(bf16x8, w);
}
__device__ __forceinline__ bf16x8 acc_frag(const f32x16& v, int s) {
    return s == 0 ? pack8(v[0], v[1], v[2], v[3], v[4], v[5], v[6], v[7]) : pack8(v[8], v[9], v[10], v[11], v[12], v[13], v[14], v[15]);
}
__device__ __forceinline__ int accrow(int r, int h) { return (r & 3) + 8 * (r >> 2) + 4 * h; }
__device__ __forceinline__ int permk(int h, int j) { return 8 * (j >> 2) + 4 * h + (j & 3); }
#ifndef EMU
namespace pg8 {
#define PG8_LAS __attribute__((address_space(3)))
typedef unsigned short bf16_t;
typedef short bf16x8 __attribute__((ext_vector_type(8)));
typedef float f32x4 __attribute__((ext_vector_type(4)));
typedef unsigned u32x4 __attribute__((ext_vector_type(4)));
constexpr int BM = 256, BK = 64, HALF = 128, HTB = HALF * BK * 2  , STAGE_BYTES = 8 * HTB, NXCD = 8, WGM = 4;

__host__ __device__ __forceinline__ int lds_byte(int r, int c) { const int st = (r >> 4) * 2 + (c >> 5), rr = r & 15, cc = c & 31, ob = rr * 64 + cc * 2; return st * 1024 + (ob ^ (((ob >> 9) & 1) << 5)); }
__host__ __device__ __forceinline__ void stage_rc(int b, int& R, int& C) { const int st = b / 1024, sb = b % 1024, swz = sb ^ (((sb >> 9) & 1) << 5); R = (st >> 1) * 16 + swz / 64; C = (st & 1) * 32 + (swz % 64) / 2; }
__host__ __device__ __forceinline__ int perm32(int rho) { const int n = rho >> 4, i = rho & 15; return 8 * (i >> 2) + 4 * n + (i & 3); }

struct Unit { int pm, pn; };
struct Gemm { const bf16_t* A; const bf16_t* Bt; int M, N, K, ld; const bf16_t* A2 = nullptr; int msplit = 1 << 30; const float* R = nullptr; };

struct StaticOrder {
    int nM, nN, nwg, G, c;
    __host__ __device__ void init(int M, int N, int G_, int c_) { nM = M / BM; nN = N / BM; nwg = nM * nN; G = G_; c = c_; }
    __host__ __device__ bool next(int i, Unit& u) const {
        const long L = (long)i * G + c; if (L >= nwg) return false;
        int wgid = (int)L; { const int q = nwg / NXCD, r = nwg % NXCD, xcd = wgid % NXCD, off = wgid / NXCD; wgid = (xcd < r ? xcd * (q + 1) : r * (q + 1) + (xcd - r) * q) + off; }
        const int nig = WGM * nN, gid = wgid / nig, fm = gid * WGM, gsz = (nM - fm) < WGM ? (nM - fm) : WGM;
        u.pm = fm + ((wgid % nig) % gsz); u.pn = (wgid % nig) / gsz; return true;
    }
    __device__ __forceinline__ void a_ready(const Unit&) const {}
    __device__ __forceinline__ void done(const Unit&) const {}
};
__device__ __forceinline__ unsigned cvt_pk_bf16(float lo, float hi) { unsigned r; asm volatile("v_cvt_pk_bf16_f32 %0, %1, %2" : "=v"(r) : "v"(lo), "v"(hi)); return r; }

__device__ __forceinline__ float silu_f(float x) { return x * __builtin_amdgcn_rcpf(1.0f + __expf(-x)); }
struct EpiProj {
    static constexpr bool PERM = true, AFTER_DRAIN = false;
    bf16_t* O; int ldc; float* BA; int n_main;
    __device__ __forceinline__ void operator()(const f32x4 (&acc)[2][2][4][2], const Unit& u, int wr, int wc, int fr, int fq) const {
        const int row0 = u.pm * BM + wr * 64 + fr, col0 = u.pn * BM + wc * 32 + 8 * fq;
        if (u.pn * BM < n_main) {
#pragma unroll
            for (int ai = 0; ai < 2; ++ai)
#pragma unroll
                for (int m = 0; m < 4; ++m) { bf16_t* rowp = O + (size_t)(row0 + ai * HALF + m * 16) * ldc + col0;
#pragma unroll
                    for (int bj = 0; bj < 2; ++bj) { const f32x4 v0 = acc[ai][bj][m][0], v1 = acc[ai][bj][m][1];
                        u32x4 w; w.x = cvt_pk_bf16(v0[0], v0[1]); w.y = cvt_pk_bf16(v0[2], v0[3]); w.z = cvt_pk_bf16(v1[0], v1[1]); w.w = cvt_pk_bf16(v1[2], v1[3]);
                        *(u32x4*)(rowp + bj * HALF) = w; } }
        } else if (wc < 2) {
#pragma unroll
            for (int ai = 0; ai < 2; ++ai)
#pragma unroll
                for (int m = 0; m < 4; ++m) { float* rowp = BA + (size_t)(row0 + ai * HALF + m * 16) * 64 + wc * 32 + 8 * fq;
                    *(f32x4*)(rowp) = acc[ai][0][m][0]; *(f32x4*)(rowp + 4) = acc[ai][0][m][1]; }
        }
    }
};
struct EpiResid {
    static constexpr bool PERM = false, AFTER_DRAIN = false;
    float* X; int ldc; const float* bias; const float* Xin;
    __device__ __forceinline__ void operator()(const f32x4 (&acc)[2][2][4][2], const Unit& u, int wr, int wc, int fr, int fq) const {
        const int row0 = u.pm * BM + wr * 64 + fr, col0 = u.pn * BM + wc * 32 + 4 * fq;
        f32x4 bv[2][2];
#pragma unroll
        for (int bj = 0; bj < 2; ++bj)
#pragma unroll
            for (int n = 0; n < 2; ++n) bv[bj][n] = bias ? *(const f32x4*)(bias + col0 + bj * HALF + n * 16) : (f32x4){0.f, 0.f, 0.f, 0.f};
#pragma unroll
        for (int ai = 0; ai < 2; ++ai)
#pragma unroll
            for (int m = 0; m < 4; ++m) { float* rowp = X + (size_t)(row0 + ai * HALF + m * 16) * ldc + col0;
                f32x4 xv[2][2];
#pragma unroll
                for (int bj = 0; bj < 2; ++bj)
#pragma unroll
                    for (int n = 0; n < 2; ++n) xv[bj][n] = *(const f32x4*)(Xin + (size_t)(row0 + ai * HALF + m * 16) * ldc + col0 + bj * HALF + n * 16);
#pragma unroll
                for (int bj = 0; bj < 2; ++bj)
#pragma unroll
                    for (int n = 0; n < 2; ++n) *(f32x4*)(rowp + bj * HALF + n * 16) = xv[bj][n] + acc[ai][bj][m][n] + bv[bj][n]; }
    }
};
template <bool FIRST> struct EpiResidH {
    static constexpr bool PERM = true, AFTER_DRAIN = false;
    bf16_t* XH; int ldc; const float* bias; const float* Xf; float* SL;
    __device__ __forceinline__ void operator()(const f32x4 (&acc)[2][2][4][2], const Unit& u, int wr, int wc, int fr, int fq) const {
        const int row0 = u.pm * BM + wr * 64 + fr, col0 = u.pn * BM + wc * 32 + 8 * fq;
        f32x4 bv[2][2];
#pragma unroll
        for (int bj = 0; bj < 2; ++bj)
#pragma unroll
            for (int n = 0; n < 2; ++n) bv[bj][n] = bias ? *(const f32x4*)(bias + col0 + bj * HALF + 4 * n) : (f32x4){0.f, 0.f, 0.f, 0.f};
#pragma unroll
        for (int ai = 0; ai < 2; ++ai)
#pragma unroll
            for (int m = 0; m < 4; ++m) { const size_t ro = (size_t)(row0 + ai * HALF + m * 16) * ldc + col0;
                f32x4 x0[2], x1[2];
                if constexpr (FIRST) {
#pragma unroll
                    for (int bj = 0; bj < 2; ++bj) { x0[bj] = *(const f32x4*)(Xf + ro + bj * HALF); x1[bj] = *(const f32x4*)(Xf + ro + bj * HALF + 4); }
                } else {
                    u32x4 xw[2];
#pragma unroll
                    for (int bj = 0; bj < 2; ++bj) xw[bj] = *(const u32x4*)(XH + ro + bj * HALF);
#pragma unroll
                    for (int bj = 0; bj < 2; ++bj) { x0[bj] = (f32x4){bflo(xw[bj].x), bfhi(xw[bj].x), bflo(xw[bj].y), bfhi(xw[bj].y)}; x1[bj] = (f32x4){bflo(xw[bj].z), bfhi(xw[bj].z), bflo(xw[bj].w), bfhi(xw[bj].w)}; }
                }
                float ss = 0.f;
#pragma unroll
                for (int bj = 0; bj < 2; ++bj) { const f32x4 v0 = x0[bj] + acc[ai][bj][m][0] + bv[bj][0], v1 = x1[bj] + acc[ai][bj][m][1] + bv[bj][1];
                    u32x4 w; w.x = cvt_pk_bf16(v0[0], v0[1]); w.y = cvt_pk_bf16(v0[2], v0[3]); w.z = cvt_pk_bf16(v1[0], v1[1]); w.w = cvt_pk_bf16(v1[2], v1[3]);
                    *(u32x4*)(XH + ro + bj * HALF) = w;
                    ss += ((v0[0] * v0[0] + v0[1] * v0[1]) + (v0[2] * v0[2] + v0[3] * v0[3])) + ((v1[0] * v1[0] + v1[1] * v1[1]) + (v1[2] * v1[2] + v1[3] * v1[3])); }
                ss += __shfl_xor(ss, 16); ss += __shfl_xor(ss, 32);
                if (fq == 0) SL[(size_t)(row0 + ai * HALF + m * 16) * 32 + u.pn * 4 + wc] = ss; }
    }
};
struct SingleUnit {
    int pm, pn; bool valid;
    __device__ bool next(int i, Unit& u) const { if (i != 0 || !valid) return false; u.pm = pm; u.pn = pn; return true; }
    __device__ __forceinline__ void a_ready(const Unit&) const {}
    __device__ __forceinline__ void done(const Unit&) const {}
};
struct EpiAtomic {
    static constexpr bool PERM = false, AFTER_DRAIN = false;
    float* X; int ldc; const float* bias;
    __device__ __forceinline__ void operator()(const f32x4 (&acc)[2][2][4][2], const Unit& u, int wr, int wc, int fr, int fq) const {
        const int row0 = u.pm * BM + wr * 64 + fr, col0 = u.pn * BM + wc * 32 + 4 * fq;
#pragma unroll
        for (int ai = 0; ai < 2; ++ai)
#pragma unroll
            for (int m = 0; m < 4; ++m) { float* rowp = X + (size_t)(row0 + ai * HALF + m * 16) * ldc + col0;
#pragma unroll
                for (int bj = 0; bj < 2; ++bj)
#pragma unroll
                    for (int n = 0; n < 2; ++n) { f32x4 v = acc[ai][bj][m][n]; if (bias) v = v + *(const f32x4*)(bias + col0 + bj * HALF + n * 16);
                        float* q = rowp + bj * HALF + n * 16; unsafeAtomicAdd(q, v[0]); unsafeAtomicAdd(q + 1, v[1]); unsafeAtomicAdd(q + 2, v[2]); unsafeAtomicAdd(q + 3, v[3]); } }
    }
};
struct EpiQkv {
    static constexpr bool PERM = true, AFTER_DRAIN = false;
    bf16_t* O; int ldc; const float* bias; float* kp; long dv, ds;
    __device__ __forceinline__ void operator()(const f32x4 (&acc)[2][2][4][2], const Unit& u, int wr, int wc, int fr, int fq) const {
        const int row0 = u.pm * BM + wr * 64 + fr, col0 = u.pn * BM + wc * 32 + 8 * fq;
        f32x4 bv[2][2];
#pragma unroll
        for (int bj = 0; bj < 2; ++bj)
#pragma unroll
            for (int n = 0; n < 2; ++n) bv[bj][n] = *(const f32x4*)(bias + col0 + bj * HALF + 4 * n);
        const int sect = (u.pn * BM) >> 11;
        const bool keep = (u.pm >= 62) && sect > 0;
        float* kvbase = kp + (sect == 2 ? dv : 0l) + (u.pm >= 64 ? ds : 0l);
        const int rbase = (u.pm < 64) ? 62 * BM : 64 * BM;
#pragma unroll
        for (int ai = 0; ai < 2; ++ai)
#pragma unroll
            for (int m = 0; m < 4; ++m) { const int row = row0 + ai * HALF + m * 16; bf16_t* rowp = O + (size_t)row * ldc + col0;
#pragma unroll
                for (int bj = 0; bj < 2; ++bj) { const f32x4 v0 = acc[ai][bj][m][0] + bv[bj][0], v1 = acc[ai][bj][m][1] + bv[bj][1];
                    u32x4 w; w.x = cvt_pk_bf16(v0[0], v0[1]); w.y = cvt_pk_bf16(v0[2], v0[3]); w.z = cvt_pk_bf16(v1[0], v1[1]); w.w = cvt_pk_bf16(v1[2], v1[3]);
                    *(u32x4*)(rowp + bj * HALF) = w;
                    if (keep) { float* fp = kvbase + (size_t)(row - rbase) * 2048 + (col0 + bj * HALF - sect * 2048); *(f32x4*)(fp) = v0; *(f32x4*)(fp + 4) = v1; } } }
    }
};
struct EpiSwiglu {
    static constexpr bool PERM = true, AFTER_DRAIN = false;
    bf16_t* O; int ldc;
    __device__ __forceinline__ void operator()(const f32x4 (&acc)[2][2][4][2], const Unit& u, int wr, int wc, int fr, int fq) const {
        const int row0 = u.pm * BM + wr * 64 + fr, col0 = u.pn * HALF + wc * 32 + 8 * fq;
#pragma unroll
        for (int ai = 0; ai < 2; ++ai)
#pragma unroll
            for (int m = 0; m < 4; ++m) { bf16_t* rowp = O + (size_t)(row0 + ai * HALF + m * 16) * ldc + col0;
                const f32x4 g0 = acc[ai][0][m][0], g1 = acc[ai][0][m][1], u0 = acc[ai][1][m][0], u1 = acc[ai][1][m][1];
                u32x4 w; w.x = cvt_pk_bf16(silu_f(g0[0]) * u0[0], silu_f(g0[1]) * u0[1]); w.y = cvt_pk_bf16(silu_f(g0[2]) * u0[2], silu_f(g0[3]) * u0[3]);
                w.z = cvt_pk_bf16(silu_f(g1[0]) * u1[0], silu_f(g1[1]) * u1[1]); w.w = cvt_pk_bf16(silu_f(g1[2]) * u1[2], silu_f(g1[3]) * u1[3]);
                *(u32x4*)(rowp) = w; }
    }
};

typedef __bf16 bf16v2_pg8 __attribute__((ext_vector_type(2)));
constexpr int RMS_LDS = STAGE_BYTES;
template <class Epi, class Sched, bool ALIGN_EPI = false, bool SP2 = false, bool RMS = false>
__device__ __forceinline__ void gemm_phase(PG8_LAS unsigned char* lds, const Gemm g, const Sched& S, const Epi& E) {
    const int tid = tid_opaque(), wid = __builtin_amdgcn_readfirstlane(tid >> 6), lane = tid & 63, wr = wid >> 2, wc = wid & 3, fr = lane & 15, fq = lane >> 4;
    const int K = g.ld, nt = g.K / BK;
    unsigned voffA[2], voffB[2];
#pragma unroll
    for (int i = 0; i < 2; ++i) { int R, C; stage_rc(tid * 16 + i * 8192, R, C); const int Rb = Epi::PERM ? ((R & ~31) + perm32(R & 31)) : R;
        voffA[i] = (unsigned)(R * K + C) * 2u; voffB[i] = (unsigned)(Rb * K + C) * 2u; }
    const size_t kstep = (size_t)(BK * 2);
    const size_t hstep = (size_t)HALF * K * 2;
    const size_t tstep = 2 * hstep;
    const unsigned ldsw = (unsigned)wid * 1024u;
    const int aoff = lds_byte(wr * 64 + fr, fq * 8), boff = lds_byte(wc * 32 + fr, fq * 8);
#define PG8_SA(b, h) (((b) * 2 + (h)) * HTB)
#define PG8_SB(b, h) ((4 + (b) * 2 + (h)) * HTB)
#define PG8_STAGE(bufoff, gbase, voff) do { _Pragma("unroll") for (int _i = 0; _i < 2; ++_i) \
        __builtin_amdgcn_global_load_lds((const unsigned*)((const char*)(gbase) + (voff)[_i]), (PG8_LAS unsigned*)(lds + (bufoff) + ldsw + _i * 8192), 16, 0, 0); } while (0)
#define PG8_LDA(dst, b, h) do { _Pragma("unroll") for (int m = 0; m < 4; ++m) _Pragma("unroll") for (int k = 0; k < 2; ++k) dst[m][k] = *(const PG8_LAS bf16x8*)(lds + PG8_SA(b, h) + aoff + m * 2048 + k * 1024); } while (0)
#define PG8_LDB(dst, b, h) do { _Pragma("unroll") for (int n = 0; n < 2; ++n) _Pragma("unroll") for (int k = 0; k < 2; ++k) dst[n][k] = *(const PG8_LAS bf16x8*)(lds + PG8_SB(b, h) + boff + n * 2048 + k * 1024); } while (0)
#define PG8_MMA(ai, bj, At, Bt) do { __builtin_amdgcn_s_setprio(1); _Pragma("unroll") for (int m = 0; m < 4; ++m) _Pragma("unroll") for (int n = 0; n < 2; ++n) _Pragma("unroll") for (int k = 0; k < 2; ++k) { \
        acc[ai][bj][m][n] = __builtin_amdgcn_mfma_f32_16x16x32_bf16(Bt[n][k], At[m][k], acc[ai][bj][m][n], 0, 0, 0); } \
        __builtin_amdgcn_s_setprio(0); } while (0)
#define PG8_WAIT_V(n) asm volatile("s_waitcnt vmcnt(" #n ")" ::: "memory")
#define PG8_WAIT_L(n) asm volatile("s_waitcnt lgkmcnt(" #n ")" ::: "memory")
#define PG8_BAR __builtin_amdgcn_s_barrier()
#define PG8_SCHED __builtin_amdgcn_sched_barrier(0)
    Unit cur, nxt; int ui = 0;
    if (!S.next(0, cur)) return;
    f32x4 acc[2][2][4][2];
#pragma unroll
    for (int a = 0; a < 2; ++a)
#pragma unroll
        for (int b = 0; b < 2; ++b)
#pragma unroll
            for (int m = 0; m < 4; ++m)
#pragma unroll
                for (int n = 0; n < 2; ++n) acc[a][b][m][n] = (f32x4){0.f, 0.f, 0.f, 0.f};
    bf16x8 At[4][2], B0[2][2], B1[2][2];
#define PG8_RFETCH(pm_, par_) do { if constexpr (RMS) { if (wid < 4) __builtin_amdgcn_global_load_lds((const unsigned*)(g.R + (size_t)(pm_) * BM + wid * 64 + lane), (PG8_LAS unsigned*)(lds + RMS_LDS + (par_) * 1024 + wid * 256), 4, 0, 0); } } while (0)
#define PG8_ABASE(pm_) ((pm_) < g.msplit ? (const char*)g.A + (size_t)(pm_) * tstep : (const char*)g.A2 + (size_t)((pm_) - g.msplit) * tstep)
    const char* cA = PG8_ABASE(cur.pm); const char* cB = (const char*)g.Bt + (size_t)cur.pn * tstep;
    S.a_ready(cur);
    PG8_RFETCH(cur.pm, 0);
    if constexpr (SP2) {
        PG8_STAGE(PG8_SB(0, 0), cB, voffB); PG8_STAGE(PG8_SB(0, 1), cB + hstep, voffB); PG8_STAGE(PG8_SA(0, 0), cA, voffA); PG8_STAGE(PG8_SA(0, 1), cA + hstep, voffA);
        if (wr == 1) PG8_BAR;
        PG8_WAIT_V(2); PG8_BAR;
        PG8_STAGE(PG8_SB(1, 0), cB + kstep, voffB); PG8_STAGE(PG8_SA(1, 0), cA + kstep, voffA); PG8_STAGE(PG8_SB(1, 1), cB + hstep + kstep, voffB);
        PG8_WAIT_V(6); PG8_BAR;
    } else {
        PG8_STAGE(PG8_SB(0, 0), cB, voffB); PG8_STAGE(PG8_SA(0, 0), cA, voffA); PG8_STAGE(PG8_SB(0, 1), cB + hstep, voffB); PG8_STAGE(PG8_SA(0, 1), cA + hstep, voffA);
        if (wr == 1) PG8_BAR;
        PG8_WAIT_V(4); PG8_BAR;
        PG8_STAGE(PG8_SB(1, 0), cB + kstep, voffB); PG8_STAGE(PG8_SA(1, 0), cA + kstep, voffA); PG8_STAGE(PG8_SB(1, 1), cB + hstep + kstep, voffB);
        PG8_WAIT_V(6); PG8_BAR;
    }
    for (;;) {
        const bool has_next = S.next(ui + 1, nxt);
        const char* nA = has_next ? PG8_ABASE(nxt.pm) : cA; const char* nB = has_next ? (const char*)g.Bt + (size_t)nxt.pn * tstep : cB;
        for (int t = 0; t < nt; t += 2) {
            const bool last = (t == nt - 2);
            const char* a1 = cA + (size_t)(t + 1) * kstep;
            const char* a2 = last ? nA : cA + (size_t)(t + 2) * kstep; const char* b2 = last ? nB : cB + (size_t)(t + 2) * kstep;
            const char* a3 = a2 + kstep; const char* b3 = b2 + kstep;
            if (last && has_next) S.a_ready(nxt);
            if constexpr (SP2) {
            PG8_LDB(B0, 0, 0); PG8_LDB(B1, 0, 1); PG8_SCHED; PG8_LDA(At, 0, 0); PG8_STAGE(PG8_SA(1, 1), a1 + hstep, voffA);
            PG8_WAIT_V(8); PG8_WAIT_L(0); PG8_BAR; PG8_MMA(0, 0, At, B0); PG8_MMA(0, 1, At, B1); PG8_BAR; PG8_SCHED;
            PG8_LDA(At, 0, 1); PG8_STAGE(PG8_SB(0, 0), b2, voffB); PG8_STAGE(PG8_SB(0, 1), b2 + hstep, voffB); PG8_STAGE(PG8_SA(0, 0), a2, voffA);
            PG8_WAIT_V(8); PG8_WAIT_L(0); PG8_BAR; PG8_MMA(1, 0, At, B0); PG8_MMA(1, 1, At, B1); PG8_BAR; PG8_SCHED;
            PG8_LDB(B0, 1, 0); PG8_LDB(B1, 1, 1); PG8_SCHED; PG8_LDA(At, 1, 0); PG8_STAGE(PG8_SA(0, 1), a2 + hstep, voffA);
            PG8_WAIT_V(8); PG8_WAIT_L(0); PG8_BAR; PG8_MMA(0, 0, At, B0); PG8_MMA(0, 1, At, B1); PG8_BAR; PG8_SCHED;
            PG8_LDA(At, 1, 1); PG8_STAGE(PG8_SB(1, 0), b3, voffB); PG8_STAGE(PG8_SB(1, 1), b3 + hstep, voffB); PG8_STAGE(PG8_SA(1, 0), a3, voffA);
            PG8_WAIT_V(8); PG8_WAIT_L(0); PG8_BAR; PG8_MMA(1, 0, At, B0); PG8_MMA(1, 1, At, B1); PG8_BAR; PG8_SCHED;
            } else {
            PG8_LDB(B0, 0, 0); PG8_SCHED; PG8_LDA(At, 0, 0); PG8_STAGE(PG8_SA(1, 1), a1 + hstep, voffA);
            PG8_WAIT_L(8); PG8_BAR; PG8_WAIT_L(0); PG8_MMA(0, 0, At, B0); PG8_BAR; PG8_SCHED;
            PG8_LDB(B1, 0, 1); PG8_STAGE(PG8_SB(0, 0), b2, voffB);
            PG8_BAR; PG8_WAIT_L(0); PG8_MMA(0, 1, At, B1); PG8_BAR;
            PG8_LDA(At, 0, 1); PG8_STAGE(PG8_SA(0, 0), a2, voffA);
            PG8_BAR; PG8_WAIT_L(0); PG8_MMA(1, 0, At, B0); PG8_BAR; PG8_SCHED;
            PG8_STAGE(PG8_SB(0, 1), b2 + hstep, voffB);
            PG8_WAIT_V(6); PG8_BAR; PG8_MMA(1, 1, At, B1); PG8_BAR;
            PG8_LDB(B0, 1, 0); PG8_SCHED; PG8_LDA(At, 1, 0); PG8_STAGE(PG8_SA(0, 1), a2 + hstep, voffA);
            PG8_WAIT_L(8); PG8_BAR; PG8_WAIT_L(0); PG8_MMA(0, 0, At, B0); PG8_BAR; PG8_SCHED;
            PG8_LDB(B1, 1, 1); PG8_STAGE(PG8_SB(1, 0), b3, voffB);
            PG8_BAR; PG8_WAIT_L(0); PG8_MMA(0, 1, At, B1); PG8_BAR;
            PG8_LDA(At, 1, 1); PG8_STAGE(PG8_SA(1, 0), a3, voffA);
            PG8_BAR; PG8_WAIT_L(0); PG8_MMA(1, 0, At, B0); PG8_BAR; PG8_SCHED;
            PG8_STAGE(PG8_SB(1, 1), b3 + hstep, voffB);
            PG8_WAIT_V(6); PG8_BAR; PG8_MMA(1, 1, At, B1); PG8_BAR;
            }
        }
        if constexpr (ALIGN_EPI) { if (wr == 0) PG8_BAR; }
        if constexpr (RMS) {
            const PG8_LAS float* rl = (const PG8_LAS float*)(lds + RMS_LDS + (ui & 1) * 1024) + wr * 64 + fr;
#pragma unroll
            for (int a = 0; a < 2; ++a)
#pragma unroll
                for (int m = 0; m < 4; ++m) { const float r = rl[a * HALF + m * 16];
#pragma unroll
                    for (int b = 0; b < 2; ++b)
#pragma unroll
                        for (int n = 0; n < 2; ++n) acc[a][b][m][n] = acc[a][b][m][n] * r; }
        }
        if constexpr (!Epi::AFTER_DRAIN) { E(acc, cur, wr, wc, fr, fq); S.done(cur); }
        if (!has_next) break;
#pragma unroll
        for (int a = 0; a < 2; ++a)
#pragma unroll
            for (int b = 0; b < 2; ++b)
#pragma unroll
                for (int m = 0; m < 4; ++m)
#pragma unroll
                    for (int n = 0; n < 2; ++n) acc[a][b][m][n] = (f32x4){0.f, 0.f, 0.f, 0.f};
        cur = nxt; cA = nA; cB = nB; ++ui;
        PG8_RFETCH(cur.pm, ui & 1);
        if constexpr (ALIGN_EPI) { if (wr == 1) PG8_BAR; }
    }
    PG8_WAIT_V(0);
    if constexpr (!ALIGN_EPI) { if (wr == 0) PG8_BAR; }
    PG8_BAR;
    if constexpr (Epi::AFTER_DRAIN) { E.fused(acc, cur, wr, wc, fr, fq, lds, wid, lane); S.done(cur); }
#undef PG8_SA
#undef PG8_ABASE
#undef PG8_RFETCH
#undef PG8_SB
#undef PG8_STAGE
#undef PG8_LDA
#undef PG8_LDB
#undef PG8_MMA
#undef PG8_WAIT_V
#undef PG8_WAIT_L
#undef PG8_BAR
#undef PG8_SCHED
}
}
#endif
#ifndef EMU
#define XB_TMO      128
#define XB_XCNT(j)  (256  + 64 * (j))
#define XB_XSUB(j)  (1280 + 64 * (j))
#define XB_XGEN(j)  (2304 + 64 * (j))
#define XB_TOP      3328
#define XB_TOPGEN   3392
#define XCD_BAR_WORDS 3456
#define XB_SPIN_CAP (1u << 18)

__device__ __forceinline__ unsigned xb_ld(unsigned* p)              { return __hip_atomic_load(p, __ATOMIC_RELAXED, __HIP_MEMORY_SCOPE_AGENT); }
__device__ __forceinline__ unsigned xb_add(unsigned* p, unsigned v) { return __hip_atomic_fetch_add(p, v, __ATOMIC_RELAXED, __HIP_MEMORY_SCOPE_AGENT); }
__device__ __forceinline__ unsigned xb_xcc_id() { return (unsigned)__builtin_amdgcn_s_getreg((3 << 11) | 20) & 0xFu; }
#define XB_SPIN(cond, bar) do { unsigned _sp = 0; while (cond) { __builtin_amdgcn_s_sleep(1); \
    if ((++_sp & 255u) == 0u) { if (xb_ld(&(bar)[XB_TMO])) break; if (_sp > XB_SPIN_CAP) { atomicAdd(&(bar)[XB_TMO], 1u); break; } } } } while (0)

struct XcdBarrier {
    unsigned* bar; unsigned x;
    volatile LAS unsigned* st;
};

__device__ __forceinline__ XcdBarrier xcd_barrier_post(unsigned* bar, volatile LAS unsigned* st) {
    XcdBarrier b; b.bar = bar; b.x = xb_xcc_id(); b.st = st;
    if (threadIdx.x == 0) (void)xb_add(&bar[XB_XCNT(b.x)], 1u);
    return b;
}
__device__ __forceinline__ void xcd_barrier_complete(unsigned* bar, unsigned x, unsigned& nloc, unsigned& nx) {
    const unsigned G = gridDim.x * gridDim.y * gridDim.z;
    unsigned sum, cnt, mine, sp = 0u;
    for (;;) {
        sum = 0u; cnt = 0u; mine = 0u;
#pragma unroll
        for (unsigned j = 0; j < 16; ++j) { const unsigned c = xb_ld(&bar[XB_XCNT(j)]); sum += c; cnt += (c > 0u) ? 1u : 0u; mine = (j == x) ? c : mine; }
        if (sum == G) break;
        __builtin_amdgcn_s_sleep(1);
        if ((++sp & 255u) == 0u) { if (xb_ld(&bar[XB_TMO])) break; if (sp > XB_SPIN_CAP) { atomicAdd(&bar[XB_TMO], 1u); break; } }
    }
    nloc = mine > 0u ? mine : 1u; nx = cnt > 0u ? cnt : 1u;
}

__device__ __forceinline__ void xcd_barrier(const XcdBarrier& b) {
    asm volatile("s_waitcnt vmcnt(0)" ::: "memory");
    __syncthreads();
    if (threadIdx.x == 0) {
        unsigned* bar = b.bar;
        __builtin_amdgcn_s_waitcnt(0);
        unsigned nloc = b.st[0], nx = b.st[1];
        if (nloc == 0u) { xcd_barrier_complete(bar, b.x, nloc, nx); b.st[0] = nloc; b.st[1] = nx; }
        const unsigned old = xb_add(&bar[XB_XSUB(b.x)], 1u);
        const unsigned gen = old / nloc;
        if (old + 1u == (gen + 1u) * nloc) {
            __builtin_amdgcn_fence(__ATOMIC_RELEASE, "agent");
            asm volatile("s_waitcnt vmcnt(0)" ::: "memory");
            const unsigned og = xb_add(&bar[XB_TOP], 1u);
            const unsigned tg = og / nx;
            if (og + 1u == (tg + 1u) * nx) xb_add(&bar[XB_TOPGEN], 1u);
            else XB_SPIN(xb_ld(&bar[XB_TOPGEN]) == tg, bar);
            __builtin_amdgcn_fence(__ATOMIC_ACQUIRE, "agent");
            xb_add(&bar[XB_XGEN(b.x)], 1u);
            asm volatile("s_waitcnt vmcnt(0)" ::: "memory");
        } else {
            XB_SPIN(xb_ld(&bar[XB_XGEN(b.x)]) == gen, bar);
            __builtin_amdgcn_fence(__ATOMIC_ACQUIRE, "agent");
            asm volatile("s_waitcnt vmcnt(0)" ::: "memory");
        }
    }
    __syncthreads();
}
#endif
__device__ __forceinline__ void wt_item(const float* W, int K, int N, bf16* WT, int k0, int n0, int orow0, LAS float* scr, int lane) {
#pragma unroll 8
    for (int i = 0; i < 32; ++i) { const int kk = 2 * i + (lane >> 5); scr[kk * 33 + (lane & 31)] = W[(size_t)(k0 + kk) * N + n0 + (lane & 31)]; }
    WG_BARRIER_WAVE();
    const int c = lane & 7;
#pragma unroll
    for (int j = 0; j < 4; ++j) { const int n = (lane >> 3) + 8 * j; const LAS float* s = scr + (8 * c) * 33 + n;
        u32x4 o; o.x = pk2(s[0 * 33], s[1 * 33]); o.y = pk2(s[2 * 33], s[3 * 33]); o.z = pk2(s[4 * 33], s[5 * 33]); o.w = pk2(s[6 * 33], s[7 * 33]);
        *(u32x4*)(WT + (size_t)(orow0 + n) * K + k0 + 8 * c) = o; }
    WG_BARRIER_WAVE();
}
constexpr int WT_SCR = 64 * 65 * 4;
struct WtItem { const float* W; bf16* WT; int K, N, k0, n0, orow0; const float* scale; };
__device__ __forceinline__ void wt_load(const WtItem& it, f32x4 (&v)[16], float& scl, int lane) {
    const float* src = it.W + (size_t)(it.k0 + (lane >> 4)) * it.N + it.n0 + 4 * (lane & 15);
#pragma unroll
    for (int i = 0; i < 16; ++i) v[i] = *(const f32x4*)(src + (size_t)(4 * i) * it.N);
    scl = it.scale ? it.scale[it.k0 + lane] : 1.0f;
}
__device__ __forceinline__ void wt_store(const WtItem& it, const f32x4 (&v)[16], float scl, LAS float* scr, int lane) {
#pragma unroll
    for (int i = 0; i < 16; ++i) { LAS float* d = scr + (4 * i + (lane >> 4)) * 65 + 4 * (lane & 15); const float s = __shfl(scl, 4 * i + (lane >> 4)); d[0] = v[i].x * s; d[1] = v[i].y * s; d[2] = v[i].z * s; d[3] = v[i].w * s; }
    WG_BARRIER_WAVE();
    const int c = lane & 7;
#pragma unroll
    for (int j = 0; j < 8; ++j) { const int n = (lane >> 3) + 8 * j; const LAS float* s = scr + (8 * c) * 65 + n;
        u32x4 o; o.x = pk2(s[0 * 65], s[1 * 65]); o.y = pk2(s[2 * 65], s[3 * 65]); o.z = pk2(s[4 * 65], s[5 * 65]); o.w = pk2(s[6 * 65], s[7 * 65]);
        *(u32x4*)(it.WT + (size_t)(it.orow0 + n) * it.K + it.k0 + 8 * c) = o; }
    WG_BARRIER_WAVE();
}
struct WtJob { const float* W; bf16* WT; int K, N, mode; const float* scale; };
__device__ __forceinline__ int wt_items(const WtJob& j) { return (j.K / 64) * (j.N / 64); }
__device__ __forceinline__ WtItem wt_item_of(const WtJob& j, int item) {
    const int nblk = j.N / 64, kb = item / nblk, nb = item - kb * nblk, n0 = 64 * nb;
    const int orow0 = j.mode == 0 ? n0 : ((n0 >> 7) * 256 + (j.mode == 2 ? 128 : 0) + (n0 & 127));
    return WtItem{j.W, j.WT, j.K, j.N, 64 * kb, n0, orow0, j.scale};
}
__device__ __forceinline__ void wt_run(const WtJob& j, int item, LAS float* scr, int lane) {
    const WtItem it = wt_item_of(j, item); f32x4 v[16]; float scl; wt_load(it, v, scl, lane); wt_store(it, v, scl, scr, lane);
}
__device__ __forceinline__ void rms_row(const float* xrow, const float* w, float* xcopy, bf16* obf, float* of32, int lane) {
    const f32x4* xr = (const f32x4*)xrow + lane; const f32x4* wr = (const f32x4*)w + lane;
    f32x4 v[8]; float ss = 0.f;
#pragma unroll
    for (int j = 0; j < 8; ++j) { v[j] = xr[64 * j]; ss += (v[j].x * v[j].x + v[j].y * v[j].y) + (v[j].z * v[j].z + v[j].w * v[j].w); }
    if (xcopy) {
#pragma unroll
        for (int j = 0; j < 8; ++j) ((f32x4*)xcopy + lane)[64 * j] = v[j]; }
    const float r = 1.0f / sqrtf(wave_sum(ss) * (1.0f / DM) + EPS);
#pragma unroll
    for (int j = 0; j < 8; ++j) { const f32x4 ww = wr[64 * j]; f32x4 y; y.x = v[j].x * r * ww.x; y.y = v[j].y * r * ww.y; y.z = v[j].z * r * ww.z; y.w = v[j].w * r * ww.w;
        if (obf) { u32x2 o; o.x = pk2(y.x, y.y); o.y = pk2(y.z, y.w); ((u32x2*)obf + lane)[64 * j] = o; }
        if (of32) ((f32x4*)of32 + lane)[64 * j] = y; }
}

__device__ __forceinline__ void rms_rows(const float* x, const float* w, float* xcopy, bf16* obf, float* of32, int nrows, int gw, int NGW, int lane) {
    const f32x4* wr = (const f32x4*)w + lane;
    f32x4 v[8], vn[8];
    int m = gw;
    if (m < nrows) { const f32x4* xr = (const f32x4*)(x + (size_t)m * DM) + lane;
#pragma unroll
        for (int j = 0; j < 8; ++j) v[j] = xr[64 * j]; }
#pragma unroll 1
    while (m < nrows) {
        const int mn = m + NGW;
        if (mn < nrows) { const f32x4* xr = (const f32x4*)(x + (size_t)mn * DM) + lane;
#pragma unroll
            for (int j = 0; j < 8; ++j) vn[j] = xr[64 * j]; }
        float ss = 0.f;
#pragma unroll
        for (int j = 0; j < 8; ++j) ss += (v[j].x * v[j].x + v[j].y * v[j].y) + (v[j].z * v[j].z + v[j].w * v[j].w);
        if (xcopy) {
#pragma unroll
            for (int j = 0; j < 8; ++j) ((f32x4*)(xcopy + (size_t)m * DM) + lane)[64 * j] = v[j]; }
        const float r = FAST_RSQ(wave_sum(ss) * (1.0f / DM) + EPS);
#pragma unroll
        for (int j = 0; j < 8; ++j) { const f32x4 ww = wr[64 * j]; f32x4 y; y.x = v[j].x * r * ww.x; y.y = v[j].y * r * ww.y; y.z = v[j].z * r * ww.z; y.w = v[j].w * r * ww.w;
            if (obf) { u32x2 o; o.x = pk2(y.x, y.y); o.y = pk2(y.z, y.w); ((u32x2*)(obf + (size_t)m * DM) + lane)[64 * j] = o; }
            if (of32) ((f32x4*)(of32 + (size_t)m * DM) + lane)[64 * j] = y; }
#pragma unroll
        for (int j = 0; j < 8; ++j) v[j] = vn[j];
        m = mn;
    }
}
__device__ __forceinline__ void rms_h_load(const bf16* xh, int m, u32x4 (&v)[4], int lane) {
    const u32x4* xr = (const u32x4*)(xh + (size_t)m * DM) + lane;
#pragma unroll
    for (int j = 0; j < 4; ++j) v[j] = xr[64 * j];
}
__device__ __forceinline__ void rms_h_finish(const u32x4 (&v)[4], const float* w, bf16* obf, float* of32, int m, int lane) {
    const f32x4* wr = (const f32x4*)w + 2 * lane;
    float ss = 0.f;
#pragma unroll
    for (int j = 0; j < 4; ++j) { const float a0 = bflo(v[j].x), a1 = bfhi(v[j].x), a2 = bflo(v[j].y), a3 = bfhi(v[j].y), a4 = bflo(v[j].z), a5 = bfhi(v[j].z), a6 = bflo(v[j].w), a7 = bfhi(v[j].w);
        ss += ((a0 * a0 + a1 * a1) + (a2 * a2 + a3 * a3)) + ((a4 * a4 + a5 * a5) + (a6 * a6 + a7 * a7)); }
    const float r = FAST_RSQ(wave_sum(ss) * (1.0f / DM) + EPS);
#pragma unroll
    for (int j = 0; j < 4; ++j) { const f32x4 w0 = wr[128 * j], w1 = wr[128 * j + 1];
        f32x4 y0, y1; y0.x = bflo(v[j].x) * r * w0.x; y0.y = bfhi(v[j].x) * r * w0.y; y0.z = bflo(v[j].y) * r * w0.z; y0.w = bfhi(v[j].y) * r * w0.w;
        y1.x = bflo(v[j].z) * r * w1.x; y1.y = bfhi(v[j].z) * r * w1.y; y1.z = bflo(v[j].w) * r * w1.z; y1.w = bfhi(v[j].w) * r * w1.w;
        if (obf) { u32x4 o; o.x = pk2(y0.x, y0.y); o.y = pk2(y0.z, y0.w); o.z = pk2(y1.x, y1.y); o.w = pk2(y1.z, y1.w); ((u32x4*)(obf + (size_t)m * DM) + lane)[64 * j] = o; }
        if (of32) { f32x4* op = (f32x4*)(of32 + (size_t)m * DM) + 2 * lane; op[128 * j] = y0; op[128 * j + 1] = y1; } }
}
__device__ __forceinline__ void rms_rows_h(const bf16* xh, const float* w, bf16* obf, float* of32, int nrows, int gw, int NGW, int lane) {
    u32x4 v[4], vn[4];
    int m = gw;
    if (m < nrows) rms_h_load(xh, m, v, lane);
#pragma unroll 1
    while (m < nrows) {
        const int mn = m + NGW;
        if (mn < nrows) rms_h_load(xh, mn, vn, lane);
        rms_h_finish(v, w, obf, of32, m, lane);
#pragma unroll
        for (int j = 0; j < 4; ++j) v[j] = vn[j];
        m = mn;
    }
}
__device__ __forceinline__ void cvt_rows(const float* x, float* xcopy, bf16* obf, float* rout, int nrows, int gw, int NGW, int lane) {
#pragma unroll 1
    for (int m = gw; m < nrows; m += NGW) { const f32x4* xr = (const f32x4*)(x + (size_t)m * DM) + 2 * lane;
        f32x4 a[4], b[4]; float ss = 0.f;
#pragma unroll
        for (int j = 0; j < 4; ++j) { a[j] = xr[128 * j]; b[j] = xr[128 * j + 1]; }
#pragma unroll
        for (int j = 0; j < 4; ++j) { u32x4 o; o.x = pk2(a[j].x, a[j].y); o.y = pk2(a[j].z, a[j].w); o.z = pk2(b[j].x, b[j].y); o.w = pk2(b[j].z, b[j].w); ((u32x4*)(obf + (size_t)m * DM) + lane)[64 * j] = o;
            ss += ((a[j].x * a[j].x + a[j].y * a[j].y) + (a[j].z * a[j].z + a[j].w * a[j].w)) + ((b[j].x * b[j].x + b[j].y * b[j].y) + (b[j].z * b[j].z + b[j].w * b[j].w));
            if (xcopy) { f32x4* xc = (f32x4*)(xcopy + (size_t)m * DM) + 2 * lane; xc[128 * j] = a[j]; xc[128 * j + 1] = b[j]; } }
        const float r = FAST_RSQ(wave_sum(ss) * (1.0f / DM) + EPS);
        if (lane == 0) rout[m] = r;
    }
}
__device__ __forceinline__ void slots_to_r(const float* sl, float* rout, int nrows, int tlin, int ntlin) {
#pragma unroll 1
    for (int i = tlin; i < nrows * 8; i += ntlin) { const f32x4 v = ((const f32x4*)sl)[i]; float s = (v.x + v.y) + (v.z + v.w);
        s += __shfl_xor(s, 1); s += __shfl_xor(s, 2); s += __shfl_xor(s, 4);
        if ((i & 7) == 0) rout[i >> 3] = FAST_RSQ(s * (1.0f / DM) + EPS); }
}
struct GdnP {
    const bf16* proj;
    const float* ba;
    const float* wconv;
    const float* a_log;
    const float* dt_bias;
    const float* conv_state;
    const float* rec_state;
    float* out_pconv;
    float* out_sconv;
    float* out_prec;
    float* out_srec;
    bf16 *U, *WN, *QG, *KG, *QK;
    float* DEC;
    bf16* o;
};


__device__ __forceinline__ void store_frag16(bf16* fragbase, size_t subtile_stride, const f32x16& v, int lane) {
    const int h = lane >> 5, l31 = lane & 31;
    bf16* fb = fragbase + (size_t)(l31 >> 4) * subtile_stride;
#pragma unroll
    for (int g = 0; g < 4; ++g) { const int lanep = (l31 & 15) + 16 * (2 * (g & 1) + h);
        u32x2 w; w.x = pk2(v[4 * g], v[4 * g + 1]); w.y = pk2(v[4 * g + 2], v[4 * g + 3]);
        *(u32x2*)(fb + lanep * 8 + 4 * (g >> 1)) = w; }
}
__device__ __forceinline__ int perm16(int q, int j) { return 16 * (j >> 2) + 4 * q + (j & 3); }
constexpr int PL_QN = 0, PL_KN = 17408, PL_KT = 34816, PL_VT = 53248, PL_LT = 90112, PL_TB = 126976, PL_END = 129536;

template <int C> struct PrepIn { float s0_b, s0_a; float w0[2], w1[2], w2[2], w3[2]; unsigned hw[3]; f32x2 hs[3]; unsigned xr[C / 2]; };
template <int C>
__device__ __forceinline__ void gdn_prep_fetch(const GdnP& p, int cidx, int hk, PrepIn<C>& in, int lane, int wid) {
    constexpr bool SAMPLE = (C == 32); constexpr int NT = C / 2;
    const int bsm = cidx - NCH;
    const int row0 = SAMPLE ? SEQ + 32 * bsm : 64 * cidx;
    in.s0_b = 0.f; in.s0_a = 0.f;
    if (wid < 2 && lane < C) { const float* bar = p.ba + (size_t)(row0 + lane) * 64; in.s0_b = bar[2 * hk + wid]; in.s0_a = bar[32 + 2 * hk + wid]; }
    const int arr = wid & 3, half = wid >> 2;
    const int chbase = arr == 0 ? hk * 128 : (arr == 1 ? 2048 + hk * 128 : 4096 + (2 * hk + (arr - 2)) * 128);
    const int ch = chbase + 2 * lane;
#pragma unroll
    for (int e = 0; e < 2; ++e) { in.w0[e] = p.wconv[0 * 8192 + ch + e]; in.w1[e] = p.wconv[1 * 8192 + ch + e]; in.w2[e] = p.wconv[2 * 8192 + ch + e]; in.w3[e] = p.wconv[3 * 8192 + ch + e]; }
    const int t0 = half * (C / 2);
#pragma unroll
    for (int q = 0; q < 3; ++q) { const int t = t0 - 3 + q; const int rr = row0 + t; const int rc = SAMPLE ? row0 + (t < 0 ? 0 : t) : (rr < 0 ? 0 : rr);
        in.hw[q] = *(const unsigned*)(p.proj + (size_t)rc * PPITCH + ch);
        if (SAMPLE) { const int si = (3 + t) < 0 ? 0 : ((3 + t) > 2 ? 2 : (3 + t)); in.hs[q] = *(const f32x2*)(p.conv_state + ((size_t)bsm * 3 + si) * 8192 + ch); } else in.hs[q] = (f32x2){0.f, 0.f}; }
#pragma unroll
    for (int tt = 0; tt < NT; ++tt) in.xr[tt] = *(const unsigned*)(p.proj + (size_t)(row0 + t0 + tt) * PPITCH + ch);
}
template <int C>
__device__ __forceinline__ void gdn_prep_unit(const GdnP& p, LAS unsigned char* lds, int cidx, int hk, PrepIn<C>& in, int nx_cidx, int nx_hk) {
    constexpr int NM = C / 32, NKS = C / 16;
    constexpr bool SAMPLE = (C == 32);
    const int tid = tid_opaque(), lane = tid & 63, wid = RFL(tid >> 6), h = lane >> 5, l31 = lane & 31;
    const int bsm = cidx - NCH;
    const int row0 = SAMPLE ? SEQ + 32 * bsm : 64 * cidx;
    LAS bf16* QN = (LAS bf16*)(lds + PL_QN);
    LAS bf16* KN = (LAS bf16*)(lds + PL_KN);
    LAS bf16* KT = (LAS bf16*)(lds + PL_KT);
    LAS bf16* VT = (LAS bf16*)(lds + PL_VT);
    LAS float* LT = (LAS float*)(lds + PL_LT);
    LAS float* TB = (LAS float*)(lds + PL_TB);
    const float s0_b = in.s0_b, s0_a = in.s0_a;
    {
        const int arr = wid & 3, half = wid >> 2;
        const int chbase = arr == 0 ? hk * 128 : (arr == 1 ? 2048 + hk * 128 : 4096 + (2 * hk + (arr - 2)) * 128);
        const int ch = chbase + 2 * lane;
        float w0[2], w1[2], w2[2], w3[2];
#pragma unroll
        for (int e = 0; e < 2; ++e) { w0[e] = in.w0[e]; w1[e] = in.w1[e]; w2[e] = in.w2[e]; w3[e] = in.w3[e]; }
        const int t0 = half * (C / 2);
        float xw[3][2];
#pragma unroll
        for (int q = 0; q < 3; ++q) { const int t = t0 - 3 + q; const int rr = row0 + t; float a = bflo(in.hw[q]), b = bfhi(in.hw[q]);
            if (SAMPLE) { if (t < 0) { a = in.hs[q].x; b = in.hs[q].y; } } else if (rr < 0) { a = 0.f; b = 0.f; }
            xw[q][0] = a; xw[q][1] = b; }
        const bool lastchunk = SAMPLE || (cidx == NCH - 1);
        constexpr int NT = C / 2;
        unsigned xr[NT];
#pragma unroll
        for (int tt = 0; tt < NT; ++tt) xr[tt] = in.xr[tt];
        float ya[NT], yb[NT];
#pragma unroll
        for (int tt = 0; tt < NT; ++tt) {
            const int c = t0 + tt;
            const float x0 = bflo(xr[tt]), x1 = bfhi(xr[tt]);
            const float y0 = w0[0] * xw[0][0] + w1[0] * xw[1][0] + w2[0] * xw[2][0] + w3[0] * x0;
            const float y1 = w0[1] * xw[0][1] + w1[1] * xw[1][1] + w2[1] * xw[2][1] + w3[1] * x1;
            xw[0][0] = xw[1][0]; xw[0][1] = xw[1][1]; xw[1][0] = xw[2][0]; xw[1][1] = xw[2][1]; xw[2][0] = x0; xw[2][1] = x1;
            ya[tt] = siluf_(y0); yb[tt] = siluf_(y1);
        }
        if (lastchunk && half == 1) {
#pragma unroll
            for (int q = 0; q < 3; ++q) { const unsigned w = xr[NT - 3 + q]; float* dst = SAMPLE ? p.out_sconv + ((size_t)bsm * 3 + q) * 8192 + ch : p.out_pconv + (size_t)q * 8192 + ch; dst[0] = bflo(w); dst[1] = bfhi(w); } }
        if (arr < 2) {
            LAS float* scr = (LAS float*)(lds + PL_LT) + (arr + 2 * half) * 2304;
            LAS float* PS = scr + 64 * (NT + 1); LAS float* SC = PS + 64;
#pragma unroll
            for (int tt = 0; tt < NT; ++tt) scr[lane * (NT + 1) + tt] = ya[tt] * ya[tt] + yb[tt] * yb[tt];
            WG_BARRIER_WAVE();
            { const int tq = lane & (NT - 1), part = lane / NT; float s = 0.f;
#pragma unroll
              for (int r = 0; r < NT; ++r) s += scr[(part * NT + r) * (NT + 1) + tq];
              PS[lane] = s; }
            WG_BARRIER_WAVE();
            if (lane < NT) { float s = 0.f;
#pragma unroll
                for (int q = 0; q < 64 / NT; ++q) s += PS[q * NT + lane];
                SC[lane] = FAST_RSQ(s + EPS) * (arr == 0 ? 0.08838834764831845f : 1.0f); }
            WG_BARRIER_WAVE();
#pragma unroll
            for (int tt = 0; tt < NT; ++tt) { const int c = t0 + tt; const float r = SC[tt]; const float y0 = ya[tt] * r, y1 = yb[tt] * r;
                if (arr == 0) *(LAS unsigned*)(QN + c * 136 + 2 * lane) = pk2(y0, y1);
                else { const unsigned w = pk2(y0, y1); *(LAS unsigned*)(KN + c * 136 + 2 * lane) = w; KT[(2 * lane) * 72 + c] = (bf16)(w & 0xffffu); KT[(2 * lane + 1) * 72 + c] = (bf16)(w >> 16); } }
        } else {
#pragma unroll
            for (int tt = 0; tt < NT; ++tt) { const int c = t0 + tt; const unsigned w = pk2(ya[tt], yb[tt]); LAS bf16* vt = VT + ((arr - 2) * 128 + 2 * lane) * 72 + c; vt[0] = (bf16)(w & 0xffffu); vt[72] = (bf16)(w >> 16); }
        }
    }
    if (wid < 2) {
        const int hvl = wid, hv = 2 * hk + hvl, c = lane;
        float g = 0.f, beta = 0.f;
        if (c < C) { beta = sigmoidf_(s0_b); g = -__expf(p.a_log[hv]) * softplusf_(s0_a + p.dt_bias[hv]); }
        float gc = g;
#pragma unroll
        for (int d = 1; d < 64; d <<= 1) { const float t = __shfl_up(gc, d); if (lane >= d) gc += t; }
        const float glast = __shfl(gc, C - 1);
        if (c < C) { const float eg = __expf(gc);
            TB[(0 * 2 + hvl) * 64 + c] = beta; TB[(1 * 2 + hvl) * 64 + c] = gc; TB[(2 * 2 + hvl) * 64 + c] = beta * eg;
            TB[(3 * 2 + hvl) * 64 + c] = eg; TB[(4 * 2 + hvl) * 64 + c] = __expf(glast - gc); }
        if (lane == 0) p.DEC[cidx * 32 + hv] = __expf(glast);
    }
    if (nx_cidx >= 0) gdn_prep_fetch<C>(p, nx_cidx, nx_hk, in, lane, wid);
    WG_BARRIER();
    {
        const int kind = wid >> 2, mr = (wid >> 1) & 1, mc = wid & 1;
        const bool act = (mr < NM) && (mc < NM) && !(kind == 1 && mr > mc);
        if (act) {
            f32x16 acc;
#pragma unroll
            for (int r = 0; r < 16; ++r) acc[r] = 0.f;
            const LAS bf16* Arow = KN + (32 * mr + l31) * 136 + 8 * h;
            const LAS bf16* Brow = (kind == 0 ? KN : QN) + (32 * mc + l31) * 136 + 8 * h;
#pragma unroll
            for (int s = 0; s < 8; ++s) acc = MFMA32(*(const LAS bf16x8*)(Arow + 16 * s), *(const LAS bf16x8*)(Brow + 16 * s), acc);
            const int colx = 32 * mc + l31;
#pragma unroll
            for (int hvl = 0; hvl < 2; ++hvl) {
                const LAS float* beta = TB + (0 * 2 + hvl) * 64; const LAS float* gcv = TB + (1 * 2 + hvl) * 64;
                const float gcol = gcv[colx];
                f32x4 gr[4], br[4];
#pragma unroll
                for (int gq = 0; gq < 4; ++gq) { gr[gq] = *(const LAS f32x4*)(gcv + 32 * mr + 8 * gq + 4 * h); if (kind == 0) br[gq] = *(const LAS f32x4*)(beta + 32 * mr + 8 * gq + 4 * h); }
                if (kind == 0) {
#pragma unroll
                    for (int r = 0; r < 16; ++r) { const int c = 32 * mr + accrow(r, h); const float gcr = gr[r >> 2][r & 3], bcr = br[r >> 2][r & 3];
                        const float e = __expf(fminf(gcr - gcol, 0.f));
                        LT[(hvl * 64 + c) * 72 + colx] = (c > colx) ? bcr * acc[r] * e : 0.f; }
                } else {
                    float v[16];
#pragma unroll
                    for (int r = 0; r < 16; ++r) { const int cp = 32 * mr + accrow(r, h); const float e = __expf(fminf(gcol - gr[r >> 2][r & 3], 0.f)); v[r] = (colx >= cp) ? acc[r] * e : 0.f; }
                    f32x16 vv;
#pragma unroll
                    for (int r = 0; r < 16; ++r) vv[r] = v[r];
                    store_frag16(p.QK + (size_t)(cidx * 32 + 2 * hk + hvl) * 4096 + (size_t)((2 * mc) * NM + mr) * 512, (size_t)NM * 512, vv, lane);
                }
            }
        }
    }
    WG_BARRIER();
    if (wid < 2) {
        const int hvl = wid; LAS float* L = LT + hvl * 64 * 72;
        const int blk = (C == 64) ? h : 0;
        const bool lact = (C == 64) || lane < 32;
        const LAS float* Lb = L + (32 * blk) * 72 + 32 * blk;
        float T[32];
#pragma unroll
        for (int i = 0; i < 32; ++i) {
            float s0 = (i == l31) ? 1.f : 0.f, s1 = 0.f, s2 = 0.f, s3 = 0.f;
#pragma unroll
            for (int j = 0; j < i; ++j) { const float pr = Lb[i * 72 + j] * T[j]; if ((j & 3) == 0) s0 -= pr; else if ((j & 3) == 1) s1 -= pr; else if ((j & 3) == 2) s2 -= pr; else s3 -= pr; }
            float s = (s0 + s1) + (s2 + s3);
            PIN_F(s);
            T[i] = s;
        }
        f32x16 X;
        if (C == 64) {
            LAS bf16* scrA = (LAS bf16*)(L + l31 * 72 + 32);
            if (h == 0) {
#pragma unroll
                for (int q = 0; q < 4; ++q) *(LAS u32x4*)(scrA + 8 * q) = (u32x4){pk2(T[8 * q], T[8 * q + 1]), pk2(T[8 * q + 2], T[8 * q + 3]), pk2(T[8 * q + 4], T[8 * q + 5]), pk2(T[8 * q + 6], T[8 * q + 7])};
            } else {
#pragma unroll
                for (int i = 0; i < 32; ++i) ((LAS bf16*)(L + i * 72 + 32))[32 + l31] = (bf16)f2bf(T[i]);
            }
            WG_BARRIER_WAVE();
            f32x16 Pm;
#pragma unroll
            for (int r = 0; r < 16; ++r) Pm[r] = 0.f;
#pragma unroll
            for (int s = 0; s < 2; ++s) { const LAS float* ar = L + (32 + l31) * 72 + 16 * s + 8 * h; const f32x4 a0 = *(const LAS f32x4*)ar, a1 = *(const LAS f32x4*)(ar + 4);
                const bf16x8 af = pack8(a0.x, a0.y, a0.z, a0.w, a1.x, a1.y, a1.z, a1.w);
                const bf16x8 bfr = *(const LAS bf16x8*)(scrA + 16 * s + 8 * h);
                Pm = MFMA32(af, bfr, Pm); }
#pragma unroll
            for (int r = 0; r < 16; ++r) X[r] = 0.f;
#pragma unroll
            for (int s = 0; s < 2; ++s) { const LAS bf16* tb = scrA + 32 + 16 * s + 4 * h; const u32x2 x0 = *(const LAS u32x2*)tb, x1 = *(const LAS u32x2*)(tb + 8);
                X = MFMA32(__builtin_bit_cast(bf16x8, (u32x4){x0.x, x0.y, x1.x, x1.y}), acc_frag(Pm, s), X); }
        }
        WG_BARRIER_WAVE();
        LAS bf16* TU = (LAS bf16*)L; LAS bf16* TW = TU + 64 * 72;
        if (lact) {
            const int col = 32 * blk + l31;
            const float bcol = TB[(0 * 2 + hvl) * 64 + col], bbcol = TB[(2 * 2 + hvl) * 64 + col];
#pragma unroll
            for (int i = 0; i < 32; ++i) { TU[(32 * blk + i) * 72 + col] = (bf16)f2bf(T[i] * bcol); TW[(32 * blk + i) * 72 + col] = (bf16)f2bf(T[i] * bbcol); }
        }
        if (C == 64) {
            const float bc0 = TB[(0 * 2 + hvl) * 64 + l31], bbc0 = TB[(2 * 2 + hvl) * 64 + l31];
#pragma unroll
            for (int r = 0; r < 16; ++r) { const int i = accrow(r, h);
                TU[(32 + i) * 72 + l31] = (bf16)f2bf(-X[r] * bc0); TW[(32 + i) * 72 + l31] = (bf16)f2bf(-X[r] * bbc0);
                TU[i * 72 + 32 + l31] = (bf16)0; TW[i * 72 + 32 + l31] = (bf16)0; }
        }
    } else {
        constexpr int NCT = C / 16, NKC = C / 32;
    #pragma unroll 1
        for (int it = tid - 128; it < 2 * NCT * 4 * 64; it += 384) {
            const int ln = it & 63, ks = (it >> 6) & 3, ct = (it >> 8) % NCT, hvl = (it >> 8) / NCT, q = ln >> 4;
            const int c = 16 * ct + (ln & 15); const float sc = TB[(3 * 2 + hvl) * 64 + c];
            const LAS bf16* src = QN + c * 136 + 32 * ks + 4 * q;
            const u32x2 a = *(const LAS u32x2*)(src), b = *(const LAS u32x2*)(src + 16);
            *(bf16x8*)(p.QG + (size_t)(cidx * 32 + 2 * hk + hvl) * 8192 + ((ct * 4 + ks) * 64 + ln) * 8) =
                pack8(bflo(a.x) * sc, bfhi(a.x) * sc, bflo(a.y) * sc, bfhi(a.y) * sc, bflo(b.x) * sc, bfhi(b.x) * sc, bflo(b.y) * sc, bfhi(b.y) * sc);
        }
    #pragma unroll 1
        for (int it = tid - 128; it < 2 * 8 * NKC * 64; it += 384) {
            const int ln = it & 63, ks = (it >> 6) % NKC, t = ((it >> 6) / NKC) & 7, hvl = (it >> 6) / (NKC * 8), q = ln >> 4;
            const int dkr = 16 * t + (ln & 15); const int c0 = 32 * ks + 4 * q;
            const LAS bf16* src = KT + dkr * 72 + c0; const LAS float* ek = TB + (4 * 2 + hvl) * 64 + c0;
            const u32x2 a = *(const LAS u32x2*)(src), b = *(const LAS u32x2*)(src + 16);
            *(bf16x8*)(p.KG + (size_t)(cidx * 32 + 2 * hk + hvl) * 8192 + ((t * NKC + ks) * 64 + ln) * 8) =
                pack8(bflo(a.x) * ek[0], bfhi(a.x) * ek[1], bflo(a.y) * ek[2], bfhi(a.y) * ek[3], bflo(b.x) * ek[16], bfhi(b.x) * ek[17], bflo(b.y) * ek[18], bfhi(b.y) * ek[19]);
        }

    }
    WG_BARRIER();
#pragma unroll 1
    for (int t = 0; t < 4; ++t) {
        const int id = wid * 4 + t, hvl = id >> 4, kind = (id >> 3) & 1, idx = id & 7, hv = 2 * hk + hvl;
        const LAS bf16* TU = (const LAS bf16*)(LT + hvl * 64 * 72); const LAS bf16* TW = TU + 64 * 72;
        const int m = kind == 0 ? (idx >> 2) : (idx & 1);
        if (m >= NM) continue;
        f32x16 acc;
#pragma unroll
        for (int r = 0; r < 16; ++r) acc[r] = 0.f;
        const LAS bf16* Arow; const LAS bf16* Brow;
        if (kind == 0) { const int vt = idx & 3; Arow = TU + (32 * m + l31) * 72 + 8 * h; Brow = VT + (hvl * 128 + 32 * vt + l31) * 72 + 8 * h; }
        else { const int i = idx >> 1; Arow = KT + (32 * i + l31) * 72 + 8 * h; Brow = TW + (32 * m + l31) * 72 + 8 * h; }
#pragma unroll
        for (int s = 0; s < NKS; ++s) acc = MFMA32(*(const LAS bf16x8*)(Arow + 16 * s), *(const LAS bf16x8*)(Brow + 16 * s), acc);
        if (kind == 0) {
            const int vt = idx & 3; bf16* ub = p.U + (size_t)(cidx * 32 + hv) * 8192;
#pragma unroll
            for (int gq = 0; gq < 4; ++gq) { const int ct = 2 * m + (gq >> 1), vs = 2 * vt + (l31 >> 4), lanep = (l31 & 15) + 16 * (2 * (gq & 1) + h);
                u32x2 w; w.x = pk2(acc[4 * gq], acc[4 * gq + 1]); w.y = pk2(acc[4 * gq + 2], acc[4 * gq + 3]);
                *(u32x2*)(ub + ((ct * 8 + vs) * 64 + lanep) * 4) = w; } }
        else {
            const int i = idx >> 1;
#pragma unroll
            for (int r = 0; r < 16; ++r) acc[r] = -acc[r];
            store_frag16(p.WN + (size_t)(cidx * 32 + hv) * 8192 + (size_t)((2 * m) * 4 + i) * 512, (size_t)4 * 512, acc, lane); }
    }
    WG_BARRIER();
}

template <int C>
__device__ __forceinline__ void gdn_prep_unit(const GdnP& p, LAS unsigned char* lds, int cidx, int hk) {
    const int tid = tid_opaque(); PrepIn<C> in; gdn_prep_fetch<C>(p, cidx, hk, in, tid & 63, RFL(tid >> 6)); gdn_prep_unit<C>(p, lds, cidx, hk, in, -1, 0);
}
constexpr int SCAN_BUF = 61440;
typedef f32x4 acc4;
__device__ __forceinline__ bf16x8 pack_2tiles(const acc4& a, const acc4& b) { return pack8(a[0], a[1], a[2], a[3], b[0], b[1], b[2], b[3]); }
__device__ __forceinline__ void scan_fetch(u32x4 (&v)[15], const GdnP& p, int cidx, int hv, int vt, int tl) {
    const size_t ub = (size_t)(cidx * 32 + hv);
    const u32x4* s0 = (const u32x4*)(p.WN + ub * 8192); const u32x4* s1 = (const u32x4*)(p.QG + ub * 8192);
    const u32x4* s2 = (const u32x4*)(p.KG + ub * 8192); const u32x4* s3 = (const u32x4*)(p.QK + ub * 4096);
#pragma unroll
    for (int i = 0; i < 4; ++i) { v[i] = s0[i * 256 + tl]; v[4 + i] = s1[i * 256 + tl]; v[8 + i] = s2[i * 256 + tl]; }
    v[12] = s3[tl]; v[13] = s3[256 + tl];
    v[14] = ((const u32x4*)(p.U + ub * 8192))[((tl >> 6) * 8 + 2 * vt + ((tl >> 5) & 1)) * 32 + (tl & 31)];
}
__device__ __forceinline__ void scan_put(const u32x4 (&v)[15], LAS unsigned char* buf, int tl) {
#pragma unroll
    for (int i = 0; i < 15; ++i) { *(LAS u32x4*)(buf + (i * 256 + tl) * 16) = v[i]; LOADER_PACE(); }
}
template <int NCT>
__device__ __forceinline__ void scan16_step(acc4 (&S)[8], const LAS unsigned char* buf, int w, float dec, bf16* orow, int lane) {
    constexpr int NKC = NCT / 2;
    const int q = lane >> 4, l15 = lane & 15;
    const LAS bf16x8* WNf = (const LAS bf16x8*)(buf) + lane;
    const LAS bf16x8* QGf = (const LAS bf16x8*)(buf + 16384) + lane;
    const LAS bf16x8* KGf = (const LAS bf16x8*)(buf + 32768) + lane;
    const LAS bf16x8* QKf = (const LAS bf16x8*)(buf + 49152) + lane;
    bf16x8 Sb[4];
#pragma unroll
    for (int ks = 0; ks < 4; ++ks) Sb[ks] = pack_2tiles(S[2 * ks], S[2 * ks + 1]);
    acc4 V[NCT];
#pragma unroll
    for (int ct = 0; ct < NCT; ++ct) { const u32x2 u = *(const LAS u32x2*)(buf + 57344 + (ct * 2 + w) * 512 + lane * 8);
        V[ct][0] = bflo(u.x); V[ct][1] = bfhi(u.x); V[ct][2] = bflo(u.y); V[ct][3] = bfhi(u.y);
#pragma unroll
        for (int ks = 0; ks < 4; ++ks) V[ct] = MFMA16(WNf[(ct * 4 + ks) * 64], Sb[ks], V[ct]); }
    bf16x8 Vb[NKC];
#pragma unroll
    for (int ks = 0; ks < NKC; ++ks) Vb[ks] = pack_2tiles(V[2 * ks], V[2 * ks + 1]);
#pragma unroll
    for (int ct = 0; ct < NCT; ++ct) { acc4 O = (acc4){0.f, 0.f, 0.f, 0.f};
#pragma unroll
        for (int ks = 0; ks < 4; ++ks) O = MFMA16(Sb[ks], QGf[(ct * 4 + ks) * 64], O);
#pragma unroll
        for (int ks = 0; ks <= (ct >> 1); ++ks) O = MFMA16(Vb[ks], QKf[(ct * NKC + ks) * 64], O);
        u32x2 o2; o2.x = pk2(O[0], O[1]); o2.y = pk2(O[2], O[3]);
        *(u32x2*)(orow + (size_t)(16 * ct + l15) * PPITCH + 4 * q) = o2; }
#pragma unroll
    for (int t = 0; t < 8; ++t) { S[t] = S[t] * dec;
#pragma unroll
        for (int ks = 0; ks < NKC; ++ks) S[t] = MFMA16(KGf[(t * NKC + ks) * 64], Vb[ks], S[t]); }
}
#define SCAN_LD4(dst, p0, p1, p2, p3) do { SCHED_FENCE(); dst[0] = (p0); dst[1] = (p1); dst[2] = (p2); dst[3] = (p3); SCHED_FENCE(); } while (0)
#define SCAN_LD(dst, ...) SCAN_LD4(dst, __VA_ARGS__)
__device__ __forceinline__ void scan16_step2(acc4 (&S)[8], const LAS unsigned char* buf, int w, float dec, bf16* orow, int lane) {
    const int q = lane >> 4, l15 = lane & 15;
    const LAS bf16x8* WNf = (const LAS bf16x8*)(buf) + lane;
    const LAS bf16x8* QGf = (const LAS bf16x8*)(buf + 16384) + lane;
    const LAS bf16x8* KGf = (const LAS bf16x8*)(buf + 32768) + lane;
    const LAS bf16x8* QKf = (const LAS bf16x8*)(buf + 49152) + lane;
#define WN_(ct, ks) WNf[((ct) * 4 + (ks)) * 64]
#define QG_(ct, ks) QGf[((ct) * 4 + (ks)) * 64]
#define KG_(t, ks) KGf[((t) * 2 + (ks)) * 64]
#define QK_(ct, ks) QKf[((ct) * 2 + (ks)) * 64]
#define V_GRP(Fc, ks) do { _Pragma("unroll") for (int ct = 0; ct < 4; ++ct) V[ct] = MFMA16(Fc[ct], Sb[ks], V[ct]); } while (0)
#define Q_GRP(Fc, ks) do { _Pragma("unroll") for (int ct = 0; ct < 4; ++ct) O[ct] = MFMA16(Sb[ks], Fc[ct], O[ct]); } while (0)
    bf16x8 F[6][4];
    u32x2 uu[4];
#pragma unroll
    for (int ct = 0; ct < 4; ++ct) uu[ct] = *(const LAS u32x2*)(buf + 57344 + (ct * 2 + w) * 512 + lane * 8);
    SCAN_LD(F[0], WN_(0, 0), WN_(1, 0), WN_(2, 0), WN_(3, 0));
    SCAN_LD(F[1], WN_(0, 1), WN_(1, 1), WN_(2, 1), WN_(3, 1));
    SCAN_LD(F[2], WN_(0, 2), WN_(1, 2), WN_(2, 2), WN_(3, 2));
    SCAN_LD(F[3], WN_(0, 3), WN_(1, 3), WN_(2, 3), WN_(3, 3));
    SCAN_LD(F[4], QG_(0, 0), QG_(1, 0), QG_(2, 0), QG_(3, 0));
    bf16x8 Sb[4];
    Sb[0] = pack_2tiles(S[0], S[1]); Sb[1] = pack_2tiles(S[2], S[3]); Sb[2] = pack_2tiles(S[4], S[5]); Sb[3] = pack_2tiles(S[6], S[7]);
    acc4 V[4], O[4];
#pragma unroll
    for (int ct = 0; ct < 4; ++ct) { V[ct][0] = bflo(uu[ct].x); V[ct][1] = bfhi(uu[ct].x); V[ct][2] = bflo(uu[ct].y); V[ct][3] = bfhi(uu[ct].y); O[ct] = (acc4){0.f, 0.f, 0.f, 0.f}; }
    bf16x8 Vb0, Vb1;
    SCAN_LD(F[5], QG_(0, 1), QG_(1, 1), QG_(2, 1), QG_(3, 1));
    V_GRP(F[0], 0);
    SCAN_LD(F[0], QG_(0, 2), QG_(1, 2), QG_(2, 2), QG_(3, 2));
    V_GRP(F[1], 1);
    SCAN_LD(F[1], QG_(0, 3), QG_(1, 3), QG_(2, 3), QG_(3, 3));
    V_GRP(F[2], 2);
    SCAN_LD(F[2], QK_(0, 0), QK_(1, 0), QK_(2, 0), QK_(3, 0));
    V_GRP(F[3], 3);
    SCAN_LD(F[3], QK_(2, 1), QK_(3, 1), KG_(0, 0), KG_(1, 0));
    Q_GRP(F[4], 0);
    Vb0 = pack_2tiles(V[0], V[1]); Vb1 = pack_2tiles(V[2], V[3]);
    SCAN_LD(F[4], KG_(2, 0), KG_(3, 0), KG_(4, 0), KG_(5, 0));
    Q_GRP(F[5], 1);
    SCAN_LD(F[5], KG_(6, 0), KG_(7, 0), KG_(0, 1), KG_(1, 1));
    Q_GRP(F[0], 2);
    SCAN_LD(F[0], KG_(2, 1), KG_(3, 1), KG_(4, 1), KG_(5, 1));
    Q_GRP(F[1], 3);
    SCAN_LD(F[1], KG_(6, 1), KG_(7, 1), KG_(6, 1), KG_(7, 1));
    _Pragma("unroll") for (int ct = 0; ct < 4; ++ct) O[ct] = MFMA16(Vb0, F[2][ct], O[ct]);
    _Pragma("unroll") for (int t = 0; t < 8; ++t) S[t] = S[t] * dec;
    O[2] = MFMA16(Vb1, F[3][0], O[2]); O[3] = MFMA16(Vb1, F[3][1], O[3]); S[0] = MFMA16(F[3][2], Vb0, S[0]); S[1] = MFMA16(F[3][3], Vb0, S[1]);
    S[2] = MFMA16(F[4][0], Vb0, S[2]); S[3] = MFMA16(F[4][1], Vb0, S[3]); S[4] = MFMA16(F[4][2], Vb0, S[4]); S[5] = MFMA16(F[4][3], Vb0, S[5]);
    _Pragma("unroll") for (int ct = 0; ct < 4; ++ct) { u32x2 o2; o2.x = pk2(O[ct][0], O[ct][1]); o2.y = pk2(O[ct][2], O[ct][3]); *(u32x2*)(orow + (size_t)(16 * ct + l15) * PPITCH + 4 * q) = o2; }
    S[6] = MFMA16(F[5][0], Vb0, S[6]); S[7] = MFMA16(F[5][1], Vb0, S[7]); S[0] = MFMA16(F[5][2], Vb1, S[0]); S[1] = MFMA16(F[5][3], Vb1, S[1]);
    S[2] = MFMA16(F[0][0], Vb1, S[2]); S[3] = MFMA16(F[0][1], Vb1, S[3]); S[4] = MFMA16(F[0][2], Vb1, S[4]); S[5] = MFMA16(F[0][3], Vb1, S[5]);
    S[6] = MFMA16(F[1][0], Vb1, S[6]); S[7] = MFMA16(F[1][1], Vb1, S[7]);
#undef WN_
#undef QG_
#undef KG_
#undef QK_
#undef V_GRP
#undef Q_GRP
}
template <int NM>
__device__ __forceinline__ void gdn_scan_unit(const GdnP& p, LAS unsigned char* lds, int hv, int vt, int cidx0, int nsteps, const float* s_init, float* s_out, int row0) {
    const int tid = tid_opaque(), lane = tid & 63, wid = RFL(tid >> 6), q = lane >> 4, l15 = lane & 15;
    if (wid < 2) {
        const int vcol = 32 * vt + 16 * wid + l15;
        acc4 S[8];
#pragma unroll
        for (int t = 0; t < 8; ++t)
#pragma unroll
            for (int r = 0; r < 4; ++r) S[t][r] = s_init ? s_init[(size_t)(16 * t + 4 * q + r) * 128 + vcol] : 0.f;
        float dreg[4];
#pragma unroll
        for (int i = 0; i < 4; ++i) { const int ti = 64 * i + lane; dreg[i] = ti < nsteps ? p.DEC[(cidx0 + ti) * 32 + hv] : 0.f; }
        WG_BARRIER();
#pragma unroll 1
        for (int t = 0; t < nsteps; ++t) {
            const int tq = t >> 6; const float dsel = tq == 0 ? dreg[0] : (tq == 1 ? dreg[1] : (tq == 2 ? dreg[2] : dreg[3]));
            const float dec = READLANE_F(dsel, t & 63);
            bf16* orow = p.o + (size_t)(row0 + 32 * NM * t) * PPITCH + hv * 128 + 32 * vt + 16 * wid;
            if constexpr (NM == 2) scan16_step2(S, lds + (t & 1) * SCAN_BUF, wid, dec, orow, lane);
            else scan16_step<2 * NM>(S, lds + (t & 1) * SCAN_BUF, wid, dec, orow, lane);
            WG_BARRIER();
        }
#pragma unroll
        for (int t = 0; t < 8; ++t)
#pragma unroll
            for (int r = 0; r < 4; ++r) s_out[(size_t)(16 * t + 4 * q + r) * 128 + vcol] = S[t][r];
    } else if (wid < 4) {
        WG_BARRIER();
#pragma unroll 1
        for (int t = 0; t < nsteps; ++t) WG_BARRIER();
    } else {
        const int tl = tid - 256; u32x4 la[15], lb[15];
        const int clast = cidx0 + nsteps - 1;
        scan_fetch(la, p, cidx0, hv, vt, tl); scan_put(la, lds, tl);
        if (nsteps > 1) {
            scan_fetch(la, p, cidx0 + 1, hv, vt, tl);
            scan_fetch(lb, p, (cidx0 + 2 < clast ? cidx0 + 2 : clast), hv, vt, tl);
        }
        WG_BARRIER();
        if (nsteps > 1) {
#pragma unroll 1
            for (int t = 0; t < nsteps; t += 2) {
                scan_put(la, lds + SCAN_BUF, tl); { const int cn = cidx0 + t + 3; scan_fetch(la, p, cn < clast ? cn : clast, hv, vt, tl); }
                WG_BARRIER();
                scan_put(lb, lds, tl); { const int cn = cidx0 + t + 4; scan_fetch(lb, p, cn < clast ? cn : clast, hv, vt, tl); }
                WG_BARRIER();
            }
        } else WG_BARRIER();
    }
}

__device__ __forceinline__ void gdn_gate_row(const bf16* prow  , const float* wnorm, bf16* og  , int lane) {
    const u32x4* o4 = (const u32x4*)prow + lane; const u32x4* z4 = (const u32x4*)(prow + GQKV) + lane;
    const f32x4* w4 = (const f32x4*)(wnorm + 8 * (lane & 15));
    const f32x4 wa = w4[0], wb = w4[1];
    u32x4* d4 = (u32x4*)og + lane;
#pragma unroll 1
    for (int qh = 0; qh < 2; ++qh) {
        u32x4 ow[4], zw[4];
#pragma unroll
        for (int q = 0; q < 4; ++q) { ow[q] = o4[64 * (4 * qh + q)]; zw[q] = z4[64 * (4 * qh + q)]; }
#pragma unroll
        for (int q = 0; q < 4; ++q) {
            const u32x4 w = ow[q]; const float o0 = bflo(w.x), o1 = bfhi(w.x), o2 = bflo(w.y), o3 = bfhi(w.y), o5 = bfhi(w.z), o4v = bflo(w.z), o6 = bflo(w.w), o7 = bfhi(w.w);
            float ss = (o0 * o0 + o1 * o1) + (o2 * o2 + o3 * o3) + (o4v * o4v + o5 * o5) + (o6 * o6 + o7 * o7);
            ss += __shfl_xor(ss, 1); ss += __shfl_xor(ss, 2); ss += __shfl_xor(ss, 4); ss += __shfl_xor(ss, 8);
            const float r = FAST_RSQ(ss * (1.0f / 128.0f) + EPS);
            const u32x4 z = zw[q]; u32x4 d;
            d.x = pk2(o0 * r * wa.x * siluf_(bflo(z.x)), o1 * r * wa.y * siluf_(bfhi(z.x)));
            d.y = pk2(o2 * r * wa.z * siluf_(bflo(z.y)), o3 * r * wa.w * siluf_(bfhi(z.y)));
            d.z = pk2(o4v * r * wb.x * siluf_(bflo(z.z)), o5 * r * wb.y * siluf_(bfhi(z.z)));
            d.w = pk2(o6 * r * wb.z * siluf_(bflo(z.w)), o7 * r * wb.w * siluf_(bfhi(z.w)));
            d4[64 * (4 * qh + q)] = d; }
    }
}

__device__ __forceinline__ void gdn_gate_rows(const bf16* proj, const float* wnorm, bf16* og, int gw, int NGW, int lane) {
    const f32x4* w4 = (const f32x4*)(wnorm + 8 * (lane & 15)); const f32x4 wa = w4[0], wb = w4[1];
    u32x4 ow[4], zw[4], on[4], zn[4];
    int m = gw, qh = 0;
    if (m < MTOK) { const u32x4* o4 = (const u32x4*)(proj + (size_t)m * PPITCH) + lane; const u32x4* z4 = (const u32x4*)(proj + (size_t)m * PPITCH + GQKV) + lane;
#pragma unroll
        for (int q = 0; q < 4; ++q) { ow[q] = o4[64 * q]; zw[q] = z4[64 * q]; } }
#pragma unroll 1
    while (m < MTOK) {
        const int mn = qh ? m + NGW : m, qn = qh ^ 1;
        if (mn < MTOK) { const u32x4* o4 = (const u32x4*)(proj + (size_t)mn * PPITCH) + lane; const u32x4* z4 = (const u32x4*)(proj + (size_t)mn * PPITCH + GQKV) + lane;
#pragma unroll
            for (int q = 0; q < 4; ++q) { on[q] = o4[64 * (4 * qn + q)]; zn[q] = z4[64 * (4 * qn + q)]; } }
        u32x4* d4 = (u32x4*)(og + (size_t)m * GZ) + lane;
#pragma unroll
        for (int q = 0; q < 4; ++q) {
            const u32x4 w = ow[q]; const float o0 = bflo(w.x), o1 = bfhi(w.x), o2 = bflo(w.y), o3 = bfhi(w.y), o5 = bfhi(w.z), o4v = bflo(w.z), o6 = bflo(w.w), o7 = bfhi(w.w);
            float ss = (o0 * o0 + o1 * o1) + (o2 * o2 + o3 * o3) + (o4v * o4v + o5 * o5) + (o6 * o6 + o7 * o7);
            ss += __shfl_xor(ss, 1); ss += __shfl_xor(ss, 2); ss += __shfl_xor(ss, 4); ss += __shfl_xor(ss, 8);
            const float r = FAST_RSQ(ss * (1.0f / 128.0f) + EPS);
            const u32x4 z = zw[q]; u32x4 d;
            d.x = pk2(o0 * r * wa.x * siluf_(bflo(z.x)), o1 * r * wa.y * siluf_(bfhi(z.x)));
            d.y = pk2(o2 * r * wa.z * siluf_(bflo(z.y)), o3 * r * wa.w * siluf_(bfhi(z.y)));
            d.z = pk2(o4v * r * wb.x * siluf_(bflo(z.z)), o5 * r * wb.y * siluf_(bfhi(z.z)));
            d.w = pk2(o6 * r * wb.z * siluf_(bflo(z.w)), o7 * r * wb.w * siluf_(bfhi(z.w)));
            d4[64 * (4 * qh + q)] = d; }
#pragma unroll
        for (int q = 0; q < 4; ++q) { ow[q] = on[q]; zw[q] = zn[q]; }
        m = mn; qh = qn;
    }
}
struct AttP {
    const bf16* qkv;
    const float* cache_k;
    const float* cache_v;
    const float* relb;
    bf16* ao;
};
constexpr int AL_K = 0, AL_VT = 17408, AL_VP = 160, AL_TILE = AL_VT + 64 * AL_VP * 2, AL_BIAS = 2 * AL_TILE, AL_END = AL_BIAS + 2064;
constexpr int QKVP = 6144;
constexpr float ATT_SCALE = 0.08838834764831845f;

struct AttTileRegs { u32x4 k[2], v[2]; };
__device__ __forceinline__ void att_load_bf16(AttTileRegs& R, const bf16* krow0, const bf16* vrow0, size_t pitch, int nkeys, int tid) {
#pragma unroll
    for (int i = 0; i < 2; ++i) { const int id = tid + 512 * i, key = id >> 4, part = id & 15;
        R.k[i] = key < nkeys ? *(const u32x4*)(krow0 + (size_t)key * pitch + part * 8) : (u32x4){0u, 0u, 0u, 0u};
        R.v[i] = key < nkeys ? *(const u32x4*)(vrow0 + (size_t)key * pitch + part * 8) : (u32x4){0u, 0u, 0u, 0u}; }
}
__device__ __forceinline__ void att_load_f32(AttTileRegs& R, const float* krow0, const float* vrow0, size_t pitch, int tid) {
#pragma unroll
    for (int i = 0; i < 2; ++i) { const int id = tid + 512 * i, key = id >> 4, part = id & 15;
        const f32x4* ks = (const f32x4*)(krow0 + (size_t)key * pitch + part * 8); const f32x4* vs = (const f32x4*)(vrow0 + (size_t)key * pitch + part * 8);
        const f32x4 a = ks[0], b = ks[1], c = vs[0], d = vs[1];
        R.k[i] = (u32x4){pk2(a.x, a.y), pk2(a.z, a.w), pk2(b.x, b.y), pk2(b.z, b.w)};
        R.v[i] = (u32x4){pk2(c.x, c.y), pk2(c.z, c.w), pk2(d.x, d.y), pk2(d.z, d.w)}; }
}
__device__ __forceinline__ void att_store_tile(const AttTileRegs& R, LAS unsigned char* lds, int tid) {
    LAS bf16* K = (LAS bf16*)(lds + AL_K); LAS bf16* V = (LAS bf16*)(lds + AL_VT);
#pragma unroll
    for (int i = 0; i < 2; ++i) { const int id = tid + 512 * i, key = id >> 4, part = id & 15;
        *(LAS u32x4*)(K + key * 136 + part * 8) = R.k[i];
        *(LAS u32x4*)(V + key * AL_VP + part * 8) = R.v[i]; }
}
struct AttState { f32x16 OT[4]; float m, l; };
constexpr float ATT_C1 = ATT_SCALE * 1.4426950408889634f;
constexpr float ATT_DEFER = 8.0f;
template <int NSUB>
__device__ __forceinline__ void att_tile(AttState& st, const bf16x8 (&qf)[8], const LAS unsigned char* lds, const LAS unsigned char* ldsb, int rel0, int lane, int nvalid = 64) {
    const int h = lane >> 5, l31 = lane & 31;
    const LAS bf16* K = (const LAS bf16*)(lds + AL_K); const LAS bf16* V = (const LAS bf16*)(lds + AL_VT); const LAS float* bias = (const LAS float*)(ldsb + AL_BIAS);
    f32x16 sc[NSUB]; float mx = -1e30f;
#pragma unroll
    for (int sub = 0; sub < NSUB; ++sub) {
#pragma unroll
        for (int r = 0; r < 16; ++r) sc[sub][r] = 0.f;
        const LAS bf16* Arow = K + (32 * sub + l31) * 136 + 8 * h;
#pragma unroll
        for (int s = 0; s < 8; ++s) sc[sub] = MFMA32(*(const LAS bf16x8*)(Arow + 16 * s), qf[s], sc[sub]);
        if (rel0 - 63 >= MAXREL) {
            const float bc = bias[2 * MAXREL];
#pragma unroll
            for (int r = 0; r < 16; ++r) { const float x = sc[sub][r] * ATT_C1 + bc; sc[sub][r] = x; mx = fmaxf(mx, x); }
        } else {
#pragma unroll
            for (int r = 0; r < 16; ++r) { int rel = rel0 + l31 - (32 * sub + accrow(r, h)); rel = rel < -MAXREL ? -MAXREL : (rel > MAXREL ? MAXREL : rel);
                const float x = sc[sub][r] * ATT_C1 + bias[rel + MAXREL]; sc[sub][r] = x; mx = fmaxf(mx, x); }
        }
    }
    if (nvalid < 64) {
        mx = -1e30f;
#pragma unroll
        for (int sub = 0; sub < NSUB; ++sub)
#pragma unroll
            for (int r = 0; r < 16; ++r) { if (32 * sub + accrow(r, h) >= nvalid) sc[sub][r] = -1e30f; mx = fmaxf(mx, sc[sub][r]); }
    }
    mx = fmaxf(mx, __shfl_xor(mx, 32));
    if (ANY_LANE(mx > st.m + ATT_DEFER)) {
        const float mnew = fmaxf(st.m, mx), alpha = FAST_EXP2(st.m - mnew);
        st.m = mnew; st.l *= alpha;
#pragma unroll
        for (int dt = 0; dt < 4; ++dt)
#pragma unroll
            for (int r = 0; r < 16; ++r) st.OT[dt][r] *= alpha;
    }
    const float mcur = st.m; float ps = 0.f;
#pragma unroll
    for (int sub = 0; sub < NSUB; ++sub)
#pragma unroll
        for (int r = 0; r < 16; ++r) { const float pv = FAST_EXP2(sc[sub][r] - mcur); sc[sub][r] = pv; ps += pv; }
    st.l += ps;
#pragma unroll
    for (int sub = 0; sub < NSUB; ++sub) {
        const bf16x8 pf0 = acc_frag(sc[sub], 0), pf1 = acc_frag(sc[sub], 1);
        const LAS bf16* vblk = V + (32 * sub + 4 * h + ((lane & 15) >> 2)) * AL_VP + 16 * ((lane >> 4) & 1) + 4 * (lane & 3);
#pragma unroll
        for (int dt = 0; dt < 4; ++dt) {
            const LAS bf16* vb = vblk + 32 * dt;
            u32x4 a0, a1; { const u32x2 x = LDS_TR16(vb), y = LDS_TR16(vb + 8 * AL_VP); a0 = (u32x4){x.x, x.y, y.x, y.y}; }
            { const u32x2 x = LDS_TR16(vb + 16 * AL_VP), y = LDS_TR16(vb + 24 * AL_VP); a1 = (u32x4){x.x, x.y, y.x, y.y}; }
            st.OT[dt] = MFMA32(__builtin_bit_cast(bf16x8, a0), pf0, st.OT[dt]);
            st.OT[dt] = MFMA32(__builtin_bit_cast(bf16x8, a1), pf1, st.OT[dt]);
        }
    }
}
__device__ __forceinline__ void att_init(AttState& st) {
#pragma unroll
    for (int dt = 0; dt < 4; ++dt)
#pragma unroll
        for (int r = 0; r < 16; ++r) st.OT[dt][r] = 0.f;
    st.m = -1e30f; st.l = 0.f;
}
__device__ __forceinline__ void att_load_q(bf16x8 (&qf)[8], const bf16* qrow  , int h) {
#pragma unroll
    for (int s = 0; s < 8; ++s) qf[s] = *(const bf16x8*)(qrow + 16 * s + 8 * h);
}
__device__ __forceinline__ void att_finish(AttState& st, bf16* orow  , int h) {
    const float lt = st.l + __shfl_xor(st.l, 32); const float inv = 1.0f / lt;
#pragma unroll
    for (int dt = 0; dt < 4; ++dt)
#pragma unroll
        for (int g = 0; g < 4; ++g) { u32x2 w; w.x = pk2(st.OT[dt][4 * g] * inv, st.OT[dt][4 * g + 1] * inv); w.y = pk2(st.OT[dt][4 * g + 2] * inv, st.OT[dt][4 * g + 3] * inv);
            *(u32x2*)(orow + 32 * dt + 8 * g + 4 * h) = w; }
}
__device__ __forceinline__ void att_load_bias(const AttP& p, LAS unsigned char* lds, int head, int tid) {
    LAS float* bias = (LAS float*)(lds + AL_BIAS);
    for (int i = tid; i < 2 * MAXREL + 1; i += 512) bias[i] = p.relb[head * (2 * MAXREL + 1) + i] * 1.4426950408889634f;
}
__device__ __forceinline__ void att_prompt_unit(const AttP& p, LAS unsigned char* lds, int g4, int head) {
    const int tid = tid_opaque(), lane = tid & 63, wid = RFL(tid >> 6), h = lane >> 5, l31 = lane & 31;
    const int cq = 4 * g4 + (wid >> 1), q0 = 64 * cq + 32 * (wid & 1);
    att_load_bias(p, lds, head, tid);
    bf16x8 qf[8]; att_load_q(qf, p.qkv + (size_t)(q0 + l31) * QKVP + head * 128, h);
    AttState st; att_init(st);
    const int kc0 = (4 * g4 - 8) > 0 ? (4 * g4 - 8) : 0, kc1 = 4 * g4 + 3;
    AttTileRegs R;
    att_load_bf16(R, p.qkv + (size_t)(64 * kc0) * QKVP + 2048 + head * 128, p.qkv + (size_t)(64 * kc0) * QKVP + 4096 + head * 128, QKVP, 64, tid);
    att_store_tile(R, lds, tid);
    WG_BARRIER();
    for (int kc = kc0; kc <= kc1; ++kc) {
        const int cur = (kc - kc0) & 1;
        if (kc < kc1) att_load_bf16(R, p.qkv + (size_t)(64 * (kc + 1)) * QKVP + 2048 + head * 128, p.qkv + (size_t)(64 * (kc + 1)) * QKVP + 4096 + head * 128, QKVP, 64, tid);
        if (kc >= cq - 8 && kc <= cq) att_tile<2>(st, qf, lds + cur * AL_TILE, lds, q0 - 64 * kc, lane);
        if (kc < kc1) att_store_tile(R, lds + (cur ^ 1) * AL_TILE, tid);
        WG_BARRIER();
    }
    att_finish(st, p.ao + (size_t)(q0 + l31) * DM + head * 128, h);
}
__device__ __forceinline__ void att_sample_unit(const AttP& p, LAS unsigned char* lds, int b, int head) {
    const int tid = tid_opaque(), lane = tid & 63, wid = RFL(tid >> 6), h = lane >> 5, l31 = lane & 31;
    const int row0 = SEQ + 32 * b;
    att_load_bias(p, lds, head, tid);
    bf16x8 qf[8]; AttState st;
    if (wid == 0) { att_load_q(qf, p.qkv + (size_t)(row0 + l31) * QKVP + head * 128, h); att_init(st); }
    const float* ck = p.cache_k + ((size_t)b * 512 * 16 + head) * 128; const float* cv = p.cache_v + ((size_t)b * 512 * 16 + head) * 128;
    AttTileRegs R;
    att_load_f32(R, ck, cv, 2048, tid);
    att_store_tile(R, lds, tid);
    WG_BARRIER();
    for (int t = 0; t < 9; ++t) {
        const int cur = t & 1;
        if (t < 7) att_load_f32(R, ck + (size_t)(64 * (t + 1)) * 2048, cv + (size_t)(64 * (t + 1)) * 2048, 2048, tid);
        else if (t == 7) att_load_bf16(R, p.qkv + (size_t)row0 * QKVP + 2048 + head * 128, p.qkv + (size_t)row0 * QKVP + 4096 + head * 128, QKVP, 32, tid);
        if (wid == 0) att_tile<2>(st, qf, lds + cur * AL_TILE, lds, 512 - 64 * t, lane, t < 8 ? 64 : 32);
        if (t < 8) att_store_tile(R, lds + (cur ^ 1) * AL_TILE, tid);
        WG_BARRIER();
    }
    if (wid == 0) att_finish(st, p.ao + (size_t)(row0 + l31) * DM + head * 128, h);
}
#ifndef EMU
constexpr size_t MiB = 1u << 20;
constexpr size_t WS_CTL = 0, CTL_ZERO_BYTES = 1 * MiB;
constexpr size_t WS_BA = 1 * MiB;
constexpr size_t WS_DEC = 6 * MiB;
constexpr size_t WS_WIN = 7 * MiB;
constexpr size_t WS_WOUT = WS_WIN + 49 * MiB;
constexpr size_t WS_WGU = WS_WOUT + 16 * MiB;
constexpr size_t WS_WDN = WS_WGU + 44 * MiB;
constexpr size_t WS_XB = WS_WDN + 22 * MiB;
constexpr size_t WS_PROJ = WS_XB + 66 * MiB;
constexpr size_t WS_U = WS_PROJ + 396 * MiB;
constexpr size_t WS_WN = WS_U + 136 * MiB, WS_QG = WS_WN + 136 * MiB, WS_KG = WS_QG + 136 * MiB, WS_QK = WS_KG + 136 * MiB;
constexpr size_t WS_WIN_B = WS_QK + 68 * MiB;
constexpr size_t WS_WOUT_B = WS_WIN_B + 24 * MiB, WS_WGU_B = WS_WOUT_B + 8 * MiB, WS_WDN_B = WS_WGU_B + 44 * MiB;
constexpr size_t WS_SL = WS_WDN_B + 22 * MiB;
constexpr size_t WS_END = WS_SL + 2 * MiB;
constexpr size_t WS_R = WS_DEC + MiB / 2;
template <int layer> struct WB { static constexpr size_t WIN = (layer & 1) ? WS_WIN_B : WS_WIN, WOUT = (layer & 1) ? WS_WOUT_B : WS_WOUT, WGU = (layer & 1) ? WS_WGU_B : WS_WGU, WDN = (layer & 1) ? WS_WDN_B : WS_WDN; };
static_assert((size_t)GPROJ_PAD * DM * 2 <= 49 * MiB && (size_t)MTOK * DM * 2 <= 66 * MiB && (size_t)MTOK * PPITCH * 2 <= 396 * MiB && (size_t)NCIDX * 32 * 8192 * 2 <= 136 * MiB && (size_t)MTOK * 4096 * 2 <= 136 * MiB, "ws map");
constexpr int CW_BAR = 4096;
constexpr int LDS_MISC = 133120, LDS_ARGS = LDS_MISC + 64, LDS_BYTES = LDS_MISC + 512;
static_assert(PL_END <= LDS_MISC && 2 * SCAN_BUF <= LDS_MISC && AL_END <= LDS_MISC && 8 * WT_SCR <= LDS_MISC && pg8::STAGE_BYTES <= LDS_MISC, "LDS map");
constexpr size_t O_YP = 0, O_YS = 33554432, O_PREC = 34603008, O_PCONV = 35651584, O_PK = 35700736, O_PV = 37797888, O_SREC = 39895040, O_SCONV = 56672256, O_SK = 57458688, O_SV = 59555840, O_END = 61652992;

struct KArgs { const float* in[23]; float* out; unsigned char* ws; };
__device__ __forceinline__ unsigned long long ldarg_u64(LAS unsigned char* lds, int i) {
    volatile LAS unsigned* p = (volatile LAS unsigned*)(lds + LDS_ARGS) + 2 * i; const unsigned lo = RFL(p[0]), hi = RFL(p[1]); return ((unsigned long long)hi << 32) | lo; }
#define ARGF(i) ((const float*)ldarg_u64(lds, (i)))
#define ARGOUT() ((float*)ldarg_u64(lds, 23))
#define ARGWS() ((unsigned char*)ldarg_u64(lds, 24))
#define XHP() ((bf16*)(ARGOUT() + (size_t)SEQ * DM / 2))

#ifndef PROBE_REP_GEMM
#define PROBE_REP_GEMM 0
#endif
#ifndef PROBE_REP_GDN
#define PROBE_REP_GDN 0
#endif
#ifndef PROBE_REP_PREP
#define PROBE_REP_PREP PROBE_REP_GDN
#endif
#ifndef PROBE_REP_SCAN
#define PROBE_REP_SCAN PROBE_REP_GDN
#endif
#ifndef PROBE_REP_GATE
#define PROBE_REP_GATE PROBE_REP_GDN
#endif
#ifndef PROBE_REP_ATT
#define PROBE_REP_ATT 0
#endif
#ifndef PROBE_REP_THIN
#define PROBE_REP_THIN 0
#endif
#define PHASE_IDS() int G = G0, bid = bid0; LAS unsigned char* lds = lds0; asm volatile("" : "+s"(G), "+s"(bid), "+s"(lds)); const int tidp = tid_opaque(), lane = tidp & 63, wid = RFL(tidp >> 6), gw = bid * 8 + wid, NGW = G * 8; (void)lane; (void)gw; (void)NGW; (void)tidp
#define GRID_BAR() do { XcdBarrier b_ = bar; unsigned* bp_ = b_.bar; unsigned bx_ = b_.x; asm volatile("" : "+s"(bp_), "+s"(bx_)); b_.bar = bp_; b_.x = bx_; xcd_barrier(b_); } while (0)
#define WSP(T, off) ((T*)(ARGWS() + (off)))
#define PHASE_FN template <int layer> __device__ __forceinline__ void
#define PHASE_ARGS LAS unsigned char* const lds0, const int G0, const int bid0
template <int layer> __device__ __forceinline__ WtItem conv_item(LAS unsigned char* lds, int r) {
    constexpr int L_ = layer, J_ = layer >> 1;
#define WT_JOB(Wp, WTp, Kv, Nv, modev, scl) { const WtJob jb{(Wp), (WTp), (Kv), (Nv), (modev), (scl)}; const int nj = wt_items(jb); if (r < nj) return wt_item_of(jb, r); r -= nj; }
    if (L_ & 1) { WT_JOB(ARGF(15) + (size_t)J_ * DM * 3 * DM, WSP(bf16, WB<layer>::WIN), DM, 3 * DM, 0, ARGF(6) + (size_t)L_ * DM) WT_JOB(ARGF(18) + (size_t)J_ * DM * DM, WSP(bf16, WB<layer>::WOUT), DM, DM, 0, nullptr) }
    else { WT_JOB(ARGF(9) + (size_t)J_ * DM * GPROJ, WSP(bf16, WB<layer>::WIN), DM, GPROJ, 0, ARGF(6) + (size_t)L_ * DM) WT_JOB(ARGF(14) + (size_t)J_ * GZ * DM, WSP(bf16, WB<layer>::WOUT), GZ, DM, 0, nullptr) }
    WT_JOB(ARGF(20) + (size_t)L_ * DM * DFF, WSP(bf16, WB<layer>::WGU), DM, DFF, 1, ARGF(7) + (size_t)L_ * DM) WT_JOB(ARGF(21) + (size_t)L_ * DM * DFF, WSP(bf16, WB<layer>::WGU), DM, DFF, 2, ARGF(7) + (size_t)L_ * DM)
    { const WtJob jb{ARGF(22) + (size_t)L_ * DFF * DM, WSP(bf16, WB<layer>::WDN), DFF, DM, 0, nullptr}; return wt_item_of(jb, r); }
#undef WT_JOB
}
#ifndef CONV_PACE
#define CONV_PACE 64
#endif
template <int layer, int PART, bool PACED = false> __device__ __forceinline__ void convert_layer(LAS unsigned char* lds, int gwr, int nw, int wid, int lane, int tlin, int ntlin) {
    constexpr int nffn = 3 * (DM / 64) * (DFF / 64); constexpr int nmix = (layer & 1) ? (DM / 64) * (3 * DM / 64) + (DM / 64) * (DM / 64) : (DM / 64) * (GPROJ / 64) + (GZ / 64) * (DM / 64);
    constexpr int nfirst = (layer & 1) ? (DM / 64) * (3 * DM / 64) : (DM / 64) * (GPROJ / 64);
    constexpr int ibeg = PART == 1 ? nfirst : 0, iend = PART == 0 ? nfirst : nffn + nmix;
    LAS float* scr = (LAS float*)(lds + wid * WT_SCR);
    int it = ibeg + gwr; f32x4 va[16], vb[16]; float sa = 1.f, sb = 1.f;
    if (it < iend) { const WtItem I = conv_item<layer>(lds, it); wt_load(I, va, sa, lane); }
#pragma unroll 1
    while (it < iend) {
        const int nx = it + nw; const bool more = nx < iend;
        if (more) { const WtItem N = conv_item<layer>(lds, nx); wt_load(N, vb, sb, lane); }
        { const WtItem I = conv_item<layer>(lds, it); wt_store(I, va, sa, scr, lane); }
        if constexpr (PACED && CONV_PACE > 0) __builtin_amdgcn_s_sleep(CONV_PACE);
#pragma unroll
        for (int i = 0; i < 16; ++i) va[i] = vb[i];
        sa = sb;
        it = nx;
    }
    if (!(layer & 1) && PART != 1) { u32x4* z = (u32x4*)(WSP(bf16, WB<layer>::WIN) + (size_t)GPROJ * DM); const int nz = (GPROJ_PAD - GPROJ) * DM * 2 / 16; for (int i = tlin; i < nz; i += ntlin) z[i] = (u32x4){0u, 0u, 0u, 0u}; }
}
PHASE_FN ph_convert(PHASE_ARGS) { PHASE_IDS(); convert_layer<layer, 0>(lds, gw, NGW, wid, lane, bid * 512 + tidp, G * 512); }
PHASE_FN ph_rms_in(PHASE_ARGS) {
    PHASE_IDS(); const float* xp = ARGF(0); const float* xs = ARGF(1); float* xres = ARGOUT(); bf16* XB = WSP(bf16, WS_XB);
    cvt_rows(xp, nullptr, XHP(), WSP(float, WS_R), SEQ, gw, NGW, lane);
    cvt_rows(xs, xres + (size_t)SEQ * DM, XB + (size_t)SEQ * DM, WSP(float, WS_R) + SEQ, DECB * DECS, NGW - 1 - gw, NGW, lane);
}
PHASE_FN ph_smp(PHASE_ARGS) {
    PHASE_IDS(); const float* xres = ARGOUT(); bf16* XB = WSP(bf16, WS_XB);
    cvt_rows(xres + (size_t)SEQ * DM, nullptr, XB + (size_t)SEQ * DM, WSP(float, WS_R) + SEQ, DECB * DECS, NGW - 1 - gw, NGW, lane);
    slots_to_r(WSP(float, WS_SL), WSP(float, WS_R), SEQ, bid * 512 + tidp, G * 512);
}
__device__ __forceinline__ void ph_final(PHASE_ARGS, const XcdBarrier& bar) {
    PHASE_IDS(); float* xres = ARGOUT(); const float* nw = ARGF(8); const bf16* XH = XHP();
    u32x4 hold[4][4];
#pragma unroll
    for (int i = 0; i < 4; ++i) { const int m = SEQ / 2 + gw + NGW * i; if (m < SEQ) rms_h_load(XH, m, hold[i], lane); }
    rms_rows_h(XH, nw, nullptr, xres, SEQ / 2, gw, NGW, lane);
    rms_rows(xres + (size_t)SEQ * DM, nw, nullptr, nullptr, xres + (size_t)SEQ * DM, DECB * DECS, NGW - 1 - gw, NGW, lane);
    asm volatile("s_waitcnt vmcnt(0)" ::: "memory");
    GRID_BAR();
#pragma unroll
    for (int i = 0; i < 4; ++i) { const int m = SEQ / 2 + gw + NGW * i; if (m < SEQ) rms_h_finish(hold[i], nw, nullptr, xres, m, lane); }
}
PHASE_FN ph_g1(PHASE_ARGS) {
    PHASE_IDS(); pg8::Gemm g{XHP(), WSP(bf16, WB<layer>::WIN), MTOK, GPROJ_PAD, DM, DM, WSP(bf16, WS_XB) + (size_t)SEQ * DM, SEQ / 256, WSP(float, WS_R)}; pg8::StaticOrder S; S.init(MTOK, GPROJ_PAD, G, bid);
    pg8::EpiProj E{WSP(bf16, WS_PROJ), PPITCH, WSP(float, WS_BA), 12288};
    pg8::gemm_phase<pg8::EpiProj, pg8::StaticOrder, true, true, true>(lds, g, S, E);
}
#define MAKE_GDNP(gp) constexpr int j = layer >> 1; const float* in10_ = ARGF(10); const float* in11_ = ARGF(11); const float* in12_ = ARGF(12); const float* in3_ = ARGF(3); const float* in2_ = ARGF(2); float* out_ = ARGOUT(); unsigned char* ws_ = ARGWS(); \
        const GdnP gp{(const bf16*)(ws_ + WS_PROJ), (const float*)(ws_ + WS_BA), in10_ + (size_t)j * 4 * GQKV, in11_ + j * 32, in12_ + j * 32, in3_ + (size_t)j * DECB * 3 * GQKV, in2_ + (size_t)j * DECB * HV * 16384, \
                out_ + O_PCONV + (size_t)j * 3 * GQKV, out_ + O_SCONV + (size_t)j * DECB * 3 * GQKV, out_ + O_PREC + (size_t)j * HV * 16384, out_ + O_SREC + (size_t)j * DECB * HV * 16384, \
                (bf16*)(ws_ + WS_U), (bf16*)(ws_ + WS_WN), (bf16*)(ws_ + WS_QG), (bf16*)(ws_ + WS_KG), (bf16*)(ws_ + WS_QK), (float*)(ws_ + WS_DEC), (bf16*)(ws_ + WS_PROJ)}
PHASE_FN ph_prep(PHASE_ARGS) {
    PHASE_IDS(); MAKE_GDNP(gp);
    PrepIn<64> in; int u = bid;
    if (u < NCH * HK) gdn_prep_fetch<64>(gp, u >> 4, u & 15, in, lane, wid);
#pragma unroll 1
    for (; u < NCH * HK; u += G) { const int un = u + G; const bool more = un < NCH * HK;
        gdn_prep_unit<64>(gp, lds, u >> 4, u & 15, in, more ? (un >> 4) : -1, un & 15); }
#pragma unroll 1
    for (; u < NCH * HK + DECB * HK; u += G) gdn_prep_unit<32>(gp, lds, NCH + ((u - NCH * HK) >> 4), u & 15);
}
template <int layer, bool CONV> __device__ __forceinline__ void ph_scan_(PHASE_ARGS) {
    PHASE_IDS(); MAKE_GDNP(gp);
    if (bid < 4 * HV) { const int x = bid & 7, q = bid >> 3, hv = x + 8 * (q >> 2), vt = q & 3;
        gdn_scan_unit<2>(gp, lds, hv, vt, 0, NCH, nullptr, gp.out_prec + (size_t)hv * 16384, 0);
#ifdef PROBE_SCAN_TWICE
        gdn_scan_unit<2>(gp, lds, hv, vt, 0, NCH, nullptr, gp.out_prec + (size_t)hv * 16384, 0);
#endif
        }
    else {
#ifdef PROBE_OTHER_TWICE
#pragma unroll 1
      for (int rep_ = 0; rep_ < 2; ++rep_) {
#else
      {
#endif
#pragma unroll 1
        for (int u = bid - 4 * HV; u < DECB * HV * 4; u += G - 4 * HV) { const int b = u >> 7, hv = (u >> 2) & 31, vt = u & 3;
            gdn_scan_unit<1>(gp, lds, hv, vt, NCH + b, 1, gp.rec_state + ((size_t)b * HV + hv) * 16384, gp.out_srec + ((size_t)b * HV + hv) * 16384, SEQ + 32 * b); }
        if constexpr (CONV) {
            convert_layer<layer, 1, true>(lds, (bid - 4 * HV) * 8 + wid, (G - 4 * HV) * 8, wid, lane, (bid - 4 * HV) * 512 + tidp, (G - 4 * HV) * 512);
            if constexpr (layer + 1 < DEPTH) convert_layer<layer + 1, 2, true>(lds, (bid - 4 * HV) * 8 + wid, (G - 4 * HV) * 8, wid, lane, (bid - 4 * HV) * 512 + tidp, (G - 4 * HV) * 512); }
        __syncthreads();
      }
    }
}
PHASE_FN ph_scan(PHASE_ARGS) { ph_scan_<layer, true>(lds0, G0, bid0); }
PHASE_FN ph_scan_noconv(PHASE_ARGS) { ph_scan_<layer, false>(lds0, G0, bid0); }
PHASE_FN ph_gate(PHASE_ARGS) {
    PHASE_IDS(); constexpr int j = layer >> 1; const bf16* PROJ = WSP(bf16, WS_PROJ); bf16* OG = WSP(bf16, WS_U); const float* wn = ARGF(13) + j * 128;
    gdn_gate_rows(PROJ, wn, OG, gw, NGW, lane);
}
template <int KC, int SPL, bool DUMMY, bool FIRST = false> __device__ __forceinline__ void resid_gemm(PHASE_ARGS, size_t a_off, size_t b_off, int bias_arg, size_t bias_off) {
    PHASE_IDS(); pg8::Gemm g{WSP(bf16, a_off), WSP(bf16, b_off), SEQ, DM, KC, KC}; pg8::StaticOrder S; S.init(SEQ, DM, G, bid);
    float* X = DUMMY ? WSP(float, WS_END) : ARGOUT(); const float* bias = bias_arg >= 0 ? ARGF(bias_arg) + bias_off : nullptr;
    pg8::EpiResidH<FIRST> E{DUMMY ? WSP(bf16, WS_END) : XHP(), DM, bias, ARGF(0), WSP(float, WS_SL)};
    pg8::gemm_phase<pg8::EpiResidH<FIRST>, pg8::StaticOrder, true, true>(lds, g, S, E);
    __syncthreads();
    { constexpr int KS = KC / SPL; const int su = bid / SPL, ks = bid - su * SPL;
      pg8::Gemm g2{WSP(bf16, a_off) + ks * KS, WSP(bf16, b_off) + ks * KS, MTOK, DM, KS, KC}; const pg8::SingleUnit S2{64 + (su >> 3), su & 7, bid < 16 * SPL};
      pg8::EpiAtomic E2{X, DM, ks == 0 ? bias : nullptr};
      pg8::gemm_phase<pg8::EpiAtomic, pg8::SingleUnit, false, true>(lds, g2, S2, E2); }
}
template <int layer, bool DUMMY> __device__ __forceinline__ void ph_g5(PHASE_ARGS) { resid_gemm<GZ, 16, DUMMY, layer == 0>(lds0, G0, bid0, WS_U, WB<layer>::WOUT, -1, 0); }
PHASE_FN ph_a1(PHASE_ARGS) {
    PHASE_IDS(); constexpr int j = layer >> 1; pg8::Gemm g{XHP(), WSP(bf16, WB<layer>::WIN), MTOK, 3 * DM, DM, DM, WSP(bf16, WS_XB) + (size_t)SEQ * DM, SEQ / 256, WSP(float, WS_R)}; pg8::StaticOrder S; S.init(MTOK, 3 * DM, G, bid);
    static_assert(O_PV - O_PK == O_SV - O_SK, "k/v output spacing");
    pg8::EpiQkv E{WSP(bf16, WS_PROJ), QKVP, ARGF(16) + (size_t)j * 3 * DM, ARGOUT() + O_PK + (size_t)j * 512 * DM, (long)(O_PV - O_PK), (long)(O_SK - O_PK)};
    pg8::gemm_phase<pg8::EpiQkv, pg8::StaticOrder, true, true, true>(lds, g, S, E);
}
PHASE_FN ph_att(PHASE_ARGS) {
    PHASE_IDS(); constexpr int j = layer >> 1;
    const AttP ap{WSP(bf16, WS_PROJ), ARGF(4) + (size_t)j * DECB * 512 * DM, ARGF(5) + (size_t)j * DECB * 512 * DM, ARGF(17) + (size_t)j * AH * 513, WSP(bf16, WS_XB)};
#pragma unroll 1
    for (int u = bid; u < 64 * AH + DECB * AH; u += G) {
        if (u < 64 * AH) att_prompt_unit(ap, lds, u >> 4, u & 15);
        else att_sample_unit(ap, lds, (u - 64 * AH) >> 4, u & 15);
    }
}
template <int layer, bool DUMMY> __device__ __forceinline__ void ph_a3(PHASE_ARGS) { resid_gemm<DM, 8, DUMMY>(lds0, G0, bid0, WS_XB, WB<layer>::WOUT, 19, (size_t)(layer >> 1) * DM); }
PHASE_FN ph_f1(PHASE_ARGS) {
    PHASE_IDS(); pg8::Gemm g{XHP(), WSP(bf16, WB<layer>::WGU), MTOK, 2 * DFF, DM, DM, WSP(bf16, WS_XB) + (size_t)SEQ * DM, SEQ / 256, WSP(float, WS_R)}; pg8::StaticOrder S; S.init(MTOK, 2 * DFF, G, bid);
    pg8::EpiSwiglu E{WSP(bf16, WS_PROJ), DFF};
    pg8::gemm_phase<pg8::EpiSwiglu, pg8::StaticOrder, true, true, true>(lds, g, S, E);
}
template <int layer, bool DUMMY> __device__ __forceinline__ void ph_f2(PHASE_ARGS) { resid_gemm<DFF, 11, DUMMY>(lds0, G0, bid0, WS_PROJ, WB<layer>::WDN, -1, 0); }

#define PH(call, nrep) do { call(lds0, G0, bid0); GRID_BAR(); if constexpr ((nrep) >= 1) { call(lds0, G0, bid0); GRID_BAR(); } if constexpr ((nrep) >= 2) { call(lds0, G0, bid0); GRID_BAR(); } } while (0)
#define PH_RES(fn, nrep) do { fn<layer, false>(lds0, G0, bid0); GRID_BAR(); if constexpr ((nrep) >= 1) { fn<layer, true>(lds0, G0, bid0); GRID_BAR(); } if constexpr ((nrep) >= 2) { fn<layer, true>(lds0, G0, bid0); GRID_BAR(); } } while (0)
template <int layer>
__device__ __forceinline__ void layer_body(LAS unsigned char* const lds0, const int G0, const int bid0, const XcdBarrier& bar) {
    if constexpr ((layer & 1) == 0) {
        PH(ph_g1<layer>, PROBE_REP_GEMM);
        PH(ph_prep<layer>, PROBE_REP_PREP);
        PH(ph_scan<layer>, 0);
        if constexpr (PROBE_REP_SCAN >= 1) { ph_scan_noconv<layer>(lds0, G0, bid0); GRID_BAR(); }
        PH(ph_gate<layer>, PROBE_REP_GATE);
        PH_RES(ph_g5, PROBE_REP_GEMM);
    } else {
        PH(ph_a1<layer>, PROBE_REP_GEMM);
        PH(ph_att<layer>, PROBE_REP_ATT);
        PH_RES(ph_a3, PROBE_REP_GEMM);
    }
    { constexpr auto f0 = 0; (void)f0; }
    PH(ph_smp<layer>, PROBE_REP_THIN);
    PH(ph_f1<layer>, PROBE_REP_GEMM);
    PH_RES(ph_f2, PROBE_REP_GEMM);
    if constexpr (layer + 1 < DEPTH) {
        if constexpr (layer & 1) { ph_convert<layer + 1>(lds0, G0, bid0);
            if constexpr (PROBE_REP_THIN >= 1) ph_convert<layer + 1>(lds0, G0, bid0); }
        PH(ph_smp<layer>, PROBE_REP_THIN);
    } else {
        ph_final(lds0, G0, bid0, bar);
    }
}

__global__ void __launch_bounds__(512, 2) fwd_kernel(KArgs a) {
    extern __shared__ __attribute__((aligned(16))) unsigned char smem[];
    LAS unsigned char* const lds0 = (LAS unsigned char*)smem;
    const int tid = threadIdx.x;
    const int G0 = gridDim.x, bid0 = blockIdx.x;
    volatile LAS unsigned* MISC = (volatile LAS unsigned*)(lds0 + LDS_MISC);
    if (tid < 4) MISC[tid] = 0u;
    if (tid < 25) { const unsigned long long v = tid < 23 ? (unsigned long long)a.in[tid] : (tid == 23 ? (unsigned long long)a.out : (unsigned long long)a.ws);
        volatile LAS unsigned* p = (volatile LAS unsigned*)(lds0 + LDS_ARGS) + 2 * tid; p[0] = (unsigned)v; p[1] = (unsigned)(v >> 32); }
    __syncthreads();
    XcdBarrier bar = xcd_barrier_post((unsigned*)(a.ws + WS_CTL) + CW_BAR, MISC);
    ph_convert<0>(lds0, G0, bid0);
    if constexpr (PROBE_REP_THIN >= 1) ph_convert<0>(lds0, G0, bid0);
    PH(ph_rms_in<0>, PROBE_REP_THIN);
    layer_body<0>(lds0, G0, bid0, bar);
    layer_body<1>(lds0, G0, bid0, bar);
    layer_body<2>(lds0, G0, bid0, bar);
    layer_body<3>(lds0, G0, bid0, bar);
}

extern "C" void kernel_launch(void* const* d_in, const int* in_sizes, int n_in, void* d_out, int out_size, void* d_ws, size_t ws_size, hipStream_t stream) {
    static int grid = 0;
    if (grid == 0) {
        if (n_in != 23 || (size_t)out_size != O_END || ws_size < WS_END + ((PROBE_REP_GEMM > 0) ? (size_t)MTOK * DM * 4 : 0)) { fprintf(stderr, "kernel_launch: unexpected sizes (n_in %d out %d ws %zu, need ws %zu)\n", n_in, out_size, ws_size, (size_t)WS_END); grid = -1; return; }
        int dev = 0, cus = 0;
        if (hipGetDevice(&dev) != hipSuccess || hipDeviceGetAttribute(&cus, hipDeviceAttributeMultiprocessorCount, dev) != hipSuccess) { grid = -1; return; }
        if (hipFuncSetAttribute((const void*)fwd_kernel, hipFuncAttributeMaxDynamicSharedMemorySize, LDS_BYTES) != hipSuccess) { fprintf(stderr, "kernel_launch: hipFuncSetAttribute failed\n"); grid = -1; return; }
        int per_cu = 0;
        if (hipOccupancyMaxActiveBlocksPerMultiprocessor(&per_cu, (const void*)fwd_kernel, 512, LDS_BYTES) != hipSuccess || per_cu < 1) fprintf(stderr, "kernel_launch: occupancy query says %d\n", per_cu);
        (void)hipGetLastError();
        if (cus * 8 * 4 < SEQ / 2) { fprintf(stderr, "kernel_launch: %d CUs: the final norm holds 4 rows per wave\n", cus); grid = -1; return; }
        grid = cus;
    }
    if (grid < 0) return;
    if (hipMemsetAsync((char*)d_ws + WS_CTL, 0, CTL_ZERO_BYTES, stream) != hipSuccess) return;
    KArgs a{};
    for (int i = 0; i < 23; ++i) a.in[i] = (const float*)d_in[i];
    a.out = (float*)d_out; a.ws = (unsigned char*)d_ws;
    hipLaunchKernelGGL(fwd_kernel, dim3(grid), dim3(512), LDS_BYTES, stream, a);
}
#endif
```

```cpp
#ifndef EMU
#include <hip/hip_runtime.h>
#include <cstdio>
typedef short bf16x8 __attribute__((ext_vector_type(8)));
typedef short bf16x4 __attribute__((ext_vector_type(4)));
typedef float f32x16 __attribute__((ext_vector_type(16)));
typedef float f32x4 __attribute__((ext_vector_type(4)));
typedef float f32x2 __attribute__((ext_vector_type(2)));
typedef unsigned u32x4 __attribute__((ext_vector_type(4)));
typedef unsigned u32x2 __attribute__((ext_vector_type(2)));
#define LAS __attribute__((address_space(3)))
#define MFMA32(a, b, c) __builtin_amdgcn_mfma_f32_32x32x16_bf16((a), (b), (c), 0, 0, 0)
#define MFMA16(a, b, c) __builtin_amdgcn_mfma_f32_16x16x32_bf16((a), (b), (c), 0, 0, 0)
#define RFL(x) __builtin_amdgcn_readfirstlane(x)
#define WG_BARRIER() do { asm volatile("s_waitcnt lgkmcnt(0)" ::: "memory"); __builtin_amdgcn_s_barrier(); asm volatile("" ::: "memory"); } while (0)
#define WG_BARRIER_WAVE() asm volatile("s_waitcnt lgkmcnt(0)" ::: "memory")
#define FAST_RCP(x) __builtin_amdgcn_rcpf(x)
#define READLANE_F(v, l) __builtin_bit_cast(float, __builtin_amdgcn_readlane(__builtin_bit_cast(int, (float)(v)), (l)))
#define FAST_EXP2(x) __builtin_amdgcn_exp2f(x)
#define ANY_LANE(p) (__builtin_amdgcn_ballot_w64(p) != 0ull)
#define FAST_RSQ(x) __builtin_amdgcn_rsqf(x)
#define CFENCE() asm volatile("" ::: "memory")
#define SCHED_FENCE() __builtin_amdgcn_sched_barrier(0)
#define LOADER_PACE() do {} while (0)
#define PIN_F(x) asm volatile("" : "+v"(x) :: "memory")
typedef short s16x4_t __attribute__((ext_vector_type(4)));
#define LDS_TR16(p) __builtin_bit_cast(u32x2, __builtin_amdgcn_ds_read_tr16_b64_v4i16((LAS s16x4_t*)(p)))
#else
#define LAS
#define MFMA32(a, b, c) emu::mfma32((a), (b), (c))
#define MFMA16(a, b, c) emu::mfma16((a), (b), (c))
#define RFL(x) (x)
#define WG_BARRIER() __syncthreads()
#define WG_BARRIER_WAVE() emu::wave_sync()
#define FAST_RCP(x) (1.0f / (x))
#define READLANE_F(v, l) emu::shfl((float)(v), (l))
#define FAST_EXP2(x) exp2f(x)
#define ANY_LANE(p) (emu::shfl_any(p))
#define FAST_RSQ(x) (1.0f / sqrtf(x))
#define CFENCE() do {} while (0)
#define SCHED_FENCE() do {} while (0)
#define LOADER_PACE() do {} while (0)
#define PIN_F(x) do {} while (0)
static inline u32x2 emu_lds_tr16(const void* p) {
    const int l = emu::lane(); unsigned short e[4];
    for (int q = 0; q < 4; ++q) { const unsigned long long a = emu::shfl((unsigned long long)(size_t)p, (l & ~15) + 4 * q + ((l & 15) >> 2)); e[q] = *(const unsigned short*)((size_t)a + 2 * (l & 3)); }
    u32x2 r; r.x = e[0] | ((unsigned)e[1] << 16); r.y = e[2] | ((unsigned)e[3] << 16); return r;
}
#define LDS_TR16(p) emu_lds_tr16((const void*)(p))
#endif
typedef unsigned short bf16;
#ifndef EMU
__device__ __forceinline__ int tid_opaque() { int t = threadIdx.x; asm volatile("" : "+v"(t)); return t; }
#else
static inline int tid_opaque() { return threadIdx.x; }
#endif

constexpr int DM = 2048, SEQ = 16384, DEPTH = 4, DECB = 16, DECS = 32;
constexpr int MTOK = SEQ + DECB * DECS;
constexpr int NCH = SEQ / 64;
constexpr int NCIDX = NCH + DECB;
constexpr int GQKV = 8192, GZ = 4096, GPROJ = 12352, GPROJ_PAD = 12544, PPITCH = 12288;
constexpr int HV = 32, HK = 16, DK = 128;
constexpr int DFF = 5632;
constexpr int AH = 16, ADH = 128, MAXREL = 256;
constexpr float EPS = 1e-6f;

__device__ __forceinline__ unsigned f2bf(float f) { unsigned u = __builtin_bit_cast(unsigned, f); return (u + 0x7fffu + ((u >> 16) & 1u)) >> 16; }
#ifndef EMU
typedef __bf16 bf16v2_t __attribute__((ext_vector_type(2)));
__device__ __forceinline__ unsigned pk2(float lo, float hi) { f32x2 v; v.x = lo; v.y = hi; return __builtin_bit_cast(unsigned, __builtin_convertvector(v, bf16v2_t)); }
#else
__device__ __forceinline__ unsigned pk2(float lo, float hi) { return f2bf(lo) | (f2bf(hi) << 16); }
#endif
__device__ __forceinline__ float bf2f(unsigned short b) { return __builtin_bit_cast(float, ((unsigned)b) << 16); }
__device__ __forceinline__ float bflo(unsigned w) { return __builtin_bit_cast(float, w << 16); }
__device__ __forceinline__ float bfhi(unsigned w) { return __builtin_bit_cast(float, w & 0xffff0000u); }
__device__ __forceinline__ float wave_sum(float v) {
#pragma unroll
    for (int o = 1; o < 64; o <<= 1) v += __shfl_xor(v, o);
    return v;
}
__device__ __forceinline__ float sigmoidf_(float x) { return FAST_RCP(1.0f + __expf(-x)); }
__device__ __forceinline__ float siluf_(float x) { return x * FAST_RCP(1.0f + __expf(-x)); }
__device__ __forceinline__ float softplusf_(float x) { return x > 20.f ? x : log1pf(__expf(x)); }
__device__ __forceinline__ bf16x8 pack8(float a0, float a1, float a2, float a3, float a4, float a5, float a6, float a7) {
    u32x4 w; w.x = pk2(a0, a1); w.y = pk2(a2, a3); w.z = pk2(a4, a5); w.w = pk2(a6, a7); return __builtin_bit_cast(bf16x8, w);
}
__device__ __forceinline__ bf16x8 acc_frag(const f32x16& v, int s) {
    return s == 0 ? pack8(v[0], v[1], v[2], v[3], v[4], v[5], v[6], v[7]) : pack8(v[8], v[9], v[10], v[11], v[12], v[13], v[14], v[15]);
}
__device__ __forceinline__ int accrow(int r, int h) { return (r & 3) + 8 * (r >> 2) + 4 * h; }
__device__ __forceinline__ int permk(int h, int j) { return 8 * (j >> 2) + 4 * h + (j & 3); }
#ifndef EMU
namespace pg8 {
#define PG8_LAS __attribute__((address_space(3)))
typedef unsigned short bf16_t;
typedef short bf16x8 __attribute__((ext_vector_type(8)));
typedef float f32x4 __attribute__((ext_vector_type(4)));
typedef unsigned u32x4 __attribute__((ext_vector_type(4)));
constexpr int BM = 256, BK = 64, HALF = 128, HTB = HALF * BK * 2  , STAGE_BYTES = 8 * HTB, NXCD = 8, WGM = 4;

__host__ __device__ __forceinline__ int lds_byte(int r, int c) { const int st = (r >> 4) * 2 + (c >> 5), rr = r & 15, cc = c & 31, ob = rr * 64 + cc * 2; return st * 1024 + (ob ^ (((ob >> 9) & 1) << 5)); }
__host__ __device__ __forceinline__ void stage_rc(int b, int& R, int& C) { const int st = b / 1024, sb = b % 1024, swz = sb ^ (((sb >> 9) & 1) << 5); R = (st >> 1) * 16 + swz / 64; C = (st & 1) * 32 + (swz % 64) / 2; }
__host__ __device__ __forceinline__ int perm32(int rho) { const int n = rho >> 4, i = rho & 15; return 8 * (i >> 2) + 4 * n + (i & 3); }

struct Unit { int pm, pn; };
struct Gemm { const bf16_t* A; const bf16_t* Bt; int M, N, K, ld; const bf16_t* A2 = nullptr; int msplit = 1 << 30; const float* R = nullptr; };

struct StaticOrder {
    int nM, nN, nwg, G, c;
    __host__ __device__ void init(int M, int N, int G_, int c_) { nM = M / BM; nN = N / BM; nwg = nM * nN; G = G_; c = c_; }
    __host__ __device__ bool next(int i, Unit& u) const {
        const long L = (long)i * G + c; if (L >= nwg) return false;
        int wgid = (int)L; { const int q = nwg / NXCD, r = nwg % NXCD, xcd = wgid % NXCD, off = wgid / NXCD; wgid = (xcd < r ? xcd * (q + 1) : r * (q + 1) + (xcd - r) * q) + off; }
        const int nig = WGM * nN, gid = wgid / nig, fm = gid * WGM, gsz = (nM - fm) < WGM ? (nM - fm) : WGM;
        u.pm = fm + ((wgid % nig) % gsz); u.pn = (wgid % nig) / gsz; return true;
    }
    __device__ __forceinline__ void a_ready(const Unit&) const {}
    __device__ __forceinline__ void done(const Unit&) const {}
};
__device__ __forceinline__ unsigned cvt_pk_bf16(float lo, float hi) { unsigned r; asm volatile("v_cvt_pk_bf16_f32 %0, %1, %2" : "=v"(r) : "v"(lo), "v"(hi)); return r; }

__device__ __forceinline__ float silu_f(float x) { return x * __builtin_amdgcn_rcpf(1.0f + __expf(-x)); }
struct EpiProj {
    static constexpr bool PERM = true, AFTER_DRAIN = false;
    bf16_t* O; int ldc; float* BA; int n_main;
    __device__ __forceinline__ void operator()(const f32x4 (&acc)[2][2][4][2], const Unit& u, int wr, int wc, int fr, int fq) const {
        const int row0 = u.pm * BM + wr * 64 + fr, col0 = u.pn * BM + wc * 32 + 8 * fq;
        if (u.pn * BM < n_main) {
#pragma unroll
            for (int ai = 0; ai < 2; ++ai)
#pragma unroll
                for (int m = 0; m < 4; ++m) { bf16_t* rowp = O + (size_t)(row0 + ai * HALF + m * 16) * ldc + col0;
#pragma unroll
                    for (int bj = 0; bj < 2; ++bj) { const f32x4 v0 = acc[ai][bj][m][0], v1 = acc[ai][bj][m][1];
                        u32x4 w; w.x = cvt_pk_bf16(v0[0], v0[1]); w.y = cvt_pk_bf16(v0[2], v0[3]); w.z = cvt_pk_bf16(v1[0], v1[1]); w.w = cvt_pk_bf16(v1[2], v1[3]);
                        *(u32x4*)(rowp + bj * HALF) = w; } }
        } else if (wc < 2) {
#pragma unroll
            for (int ai = 0; ai < 2; ++ai)
#pragma unroll
                for (int m = 0; m < 4; ++m) { float* rowp = BA + (size_t)(row0 + ai * HALF + m * 16) * 64 + wc * 32 + 8 * fq;
                    *(f32x4*)(rowp) = acc[ai][0][m][0]; *(f32x4*)(rowp + 4) = acc[ai][0][m][1]; }
        }
    }
};
struct EpiResid {
    static constexpr bool PERM = false, AFTER_DRAIN = false;
    float* X; int ldc; const float* bias; const float* Xin;
    __device__ __forceinline__ void operator()(const f32x4 (&acc)[2][2][4][2], const Unit& u, int wr, int wc, int fr, int fq) const {
        const int row0 = u.pm * BM + wr * 64 + fr, col0 = u.pn * BM + wc * 32 + 4 * fq;
        f32x4 bv[2][2];
#pragma unroll
        for (int bj = 0; bj < 2; ++bj)
#pragma unroll
            for (int n = 0; n < 2; ++n) bv[bj][n] = bias ? *(const f32x4*)(bias + col0 + bj * HALF + n * 16) : (f32x4){0.f, 0.f, 0.f, 0.f};
#pragma unroll
        for (int ai = 0; ai < 2; ++ai)
#pragma unroll
            for (int m = 0; m < 4; ++m) { float* rowp = X + (size_t)(row0 + ai * HALF + m * 16) * ldc + col0;
                f32x4 xv[2][2];
#pragma unroll
                for (int bj = 0; bj < 2; ++bj)
#pragma unroll
                    for (int n = 0; n < 2; ++n) xv[bj][n] = *(const f32x4*)(Xin + (size_t)(row0 + ai * HALF + m * 16) * ldc + col0 + bj * HALF + n * 16);
#pragma unroll
                for (int bj = 0; bj < 2; ++bj)
#pragma unroll
                    for (int n = 0; n < 2; ++n) *(f32x4*)(rowp + bj * HALF + n * 16) = xv[bj][n] + acc[ai][bj][m][n] + bv[bj][n]; }
    }
};
template <bool FIRST> struct EpiResidH {
    static constexpr bool PERM = true, AFTER_DRAIN = false;
    bf16_t* XH; int ldc; const float* bias; const float* Xf; float* SL;
    __device__ __forceinline__ void operator()(const f32x4 (&acc)[2][2][4][2], const Unit& u, int wr, int wc, int fr, int fq) const {
        const int row0 = u.pm * BM + wr * 64 + fr, col0 = u.pn * BM + wc * 32 + 8 * fq;
        f32x4 bv[2][2];
#pragma unroll
        for (int bj = 0; bj < 2; ++bj)
#pragma unroll
            for (int n = 0; n < 2; ++n) bv[bj][n] = bias ? *(const f32x4*)(bias + col0 + bj * HALF + 4 * n) : (f32x4){0.f, 0.f, 0.f, 0.f};
#pragma unroll
        for (int ai = 0; ai < 2; ++ai)
#pragma unroll
            for (int m = 0; m < 4; ++m) { const size_t ro = (size_t)(row0 + ai * HALF + m * 16) * ldc + col0;
                f32x4 x0[2], x1[2];
                if constexpr (FIRST) {
#pragma unroll
                    for (int bj = 0; bj < 2; ++bj) { x0[bj] = *(const f32x4*)(Xf + ro + bj * HALF); x1[bj] = *(const f32x4*)(Xf + ro + bj * HALF + 4); }
                } else {
                    u32x4 xw[2];
#pragma unroll
                    for (int bj = 0; bj < 2; ++bj) xw[bj] = *(const u32x4*)(XH + ro + bj * HALF);
#pragma unroll
                    for (int bj = 0; bj < 2; ++bj) { x0[bj] = (f32x4){bflo(xw[bj].x), bfhi(xw[bj].x), bflo(xw[bj].y), bfhi(xw[bj].y)}; x1[bj] = (f32x4){bflo(xw[bj].z), bfhi(xw[bj].z), bflo(xw[bj].w), bfhi(xw[bj].w)}; }
                }
                float ss = 0.f;
#pragma unroll
                for (int bj = 0; bj < 2; ++bj) { const f32x4 v0 = x0[bj] + acc[ai][bj][m][0] + bv[bj][0], v1 = x1[bj] + acc[ai][bj][m][1] + bv[bj][1];
                    u32x4 w; w.x = cvt_pk_bf16(v0[0], v0[1]); w.y = cvt_pk_bf16(v0[2], v0[3]); w.z = cvt_pk_bf16(v1[0], v1[1]); w.w = cvt_pk_bf16(v1[2], v1[3]);
                    *(u32x4*)(XH + ro + bj * HALF) = w;
                    ss += ((v0[0] * v0[0] + v0[1] * v0[1]) + (v0[2] * v0[2] + v0[3] * v0[3])) + ((v1[0] * v1[0] + v1[1] * v1[1]) + (v1[2] * v1[2] + v1[3] * v1[3])); }
                ss += __shfl_xor(ss, 16); ss += __shfl_xor(ss, 32);
                if (fq == 0) SL[(size_t)(row0 + ai * HALF + m * 16) * 32 + u.pn * 4 + wc] = ss; }
    }
};
struct SingleUnit {
    int pm, pn; bool valid;
    __device__ bool next(int i, Unit& u) const { if (i != 0 || !valid) return false; u.pm = pm; u.pn = pn; return true; }
    __device__ __forceinline__ void a_ready(const Unit&) const {}
    __device__ __forceinline__ void done(const Unit&) const {}
};
struct EpiAtomic {
    static constexpr bool PERM = false, AFTER_DRAIN = false;
    float* X; int ldc; const float* bias;
    __device__ __forceinline__ void operator()(const f32x4 (&acc)[2][2][4][2], const Unit& u, int wr, int wc, int fr, int fq) const {
        const int row0 = u.pm * BM + wr * 64 + fr, col0 = u.pn * BM + wc * 32 + 4 * fq;
#pragma unroll
        for (int ai = 0; ai < 2; ++ai)
#pragma unroll
            for (int m = 0; m < 4; ++m) { float* rowp = X + (size_t)(row0 + ai * HALF + m * 16) * ldc + col0;
#pragma unroll
                for (int bj = 0; bj < 2; ++bj)
#pragma unroll
                    for (int n = 0; n < 2; ++n) { f32x4 v = acc[ai][bj][m][n]; if (bias) v = v + *(const f32x4*)(bias + col0 + bj * HALF + n * 16);
                        float* q = rowp + bj * HALF + n * 16; unsafeAtomicAdd(q, v[0]); unsafeAtomicAdd(q + 1, v[1]); unsafeAtomicAdd(q + 2, v[2]); unsafeAtomicAdd(q + 3, v[3]); } }
    }
};
struct EpiQkv {
    static constexpr bool PERM = true, AFTER_DRAIN = false;
    bf16_t* O; int ldc; const float* bias; float* kp; long dv, ds;
    __device__ __forceinline__ void operator()(const f32x4 (&acc)[2][2][4][2], const Unit& u, int wr, int wc, int fr, int fq) const {
        const int row0 = u.pm * BM + wr * 64 + fr, col0 = u.pn * BM + wc * 32 + 8 * fq;
        f32x4 bv[2][2];
#pragma unroll
        for (int bj = 0; bj < 2; ++bj)
#pragma unroll
            for (int n = 0; n < 2; ++n) bv[bj][n] = *(const f32x4*)(bias + col0 + bj * HALF + 4 * n);
        const int sect = (u.pn * BM) >> 11;
        const bool keep = (u.pm >= 62) && sect > 0;
        float* kvbase = kp + (sect == 2 ? dv : 0l) + (u.pm >= 64 ? ds : 0l);
        const int rbase = (u.pm < 64) ? 62 * BM : 64 * BM;
#pragma unroll
        for (int ai = 0; ai < 2; ++ai)
#pragma unroll
            for (int m = 0; m < 4; ++m) { const int row = row0 + ai * HALF + m * 16; bf16_t* rowp = O + (size_t)row * ldc + col0;
#pragma unroll
                for (int bj = 0; bj < 2; ++bj) { const f32x4 v0 = acc[ai][bj][m][0] + bv[bj][0], v1 = acc[ai][bj][m][1] + bv[bj][1];
                    u32x4 w; w.x = cvt_pk_bf16(v0[0], v0[1]); w.y = cvt_pk_bf16(v0[2], v0[3]); w.z = cvt_pk_bf16(v1[0], v1[1]); w.w = cvt_pk_bf16(v1[2], v1[3]);
                    *(u32x4*)(rowp + bj * HALF) = w;
                    if (keep) { float* fp = kvbase + (size_t)(row - rbase) * 2048 + (col0 + bj * HALF - sect * 2048); *(f32x4*)(fp) = v0; *(f32x4*)(fp + 4) = v1; } } }
    }
};
struct EpiSwiglu {
    static constexpr bool PERM = true, AFTER_DRAIN = false;
    bf16_t* O; int ldc;
    __device__ __forceinline__ void operator()(const f32x4 (&acc)[2][2][4][2], const Unit& u, int wr, int wc, int fr, int fq) const {
        const int row0 = u.pm * BM + wr * 64 + fr, col0 = u.pn * HALF + wc * 32 + 8 * fq;
#pragma unroll
        for (int ai = 0; ai < 2; ++ai)
#pragma unroll
            for (int m = 0; m < 4; ++m) { bf16_t* rowp = O + (size_t)(row0 + ai * HALF + m * 16) * ldc + col0;
                const f32x4 g0 = acc[ai][0][m][0], g1 = acc[ai][0][m][1], u0 = acc[ai][1][m][0], u1 = acc[ai][1][m][1];
                u32x4 w; w.x = cvt_pk_bf16(silu_f(g0[0]) * u0[0], silu_f(g0[1]) * u0[1]); w.y = cvt_pk_bf16(silu_f(g0[2]) * u0[2], silu_f(g0[3]) * u0[3]);
                w.z = cvt_pk_bf16(silu_f(g1[0]) * u1[0], silu_f(g1[1]) * u1[1]); w.w = cvt_pk_bf16(silu_f(g1[2]) * u1[2], silu_f(g1[3]) * u1[3]);
                *(u32x4*)(rowp) = w; }
    }
};

typedef __bf16 bf16v2_pg8 __attribute__((ext_vector_type(2)));
constexpr int RMS_LDS = STAGE_BYTES;
template <class Epi, class Sched, bool ALIGN_EPI = false, bool SP2 = false, bool RMS = false>
__device__ __forceinline__ void gemm_phase(PG8_LAS unsigned char* lds, const Gemm g, const Sched& S, const Epi& E) {
    const int tid = tid_opaque(), wid = __builtin_amdgcn_readfirstlane(tid >> 6), lane = tid & 63, wr = wid >> 2, wc = wid & 3, fr = lane & 15, fq = lane >> 4;
    const int K = g.ld, nt = g.K / BK;
    unsigned voffA[2], voffB[2];
#pragma unroll
    for (int i = 0; i < 2; ++i) { int R, C; stage_rc(tid * 16 + i * 8192, R, C); const int Rb = Epi::PERM ? ((R & ~31) + perm32(R & 31)) : R;
        voffA[i] = (unsigned)(R * K + C) * 2u; voffB[i] = (unsigned)(Rb * K + C) * 2u; }
    const size_t kstep = (size_t)(BK * 2);
    const size_t hstep = (size_t)HALF * K * 2;
    const size_t tstep = 2 * hstep;
    const unsigned ldsw = (unsigned)wid * 1024u;
    const int aoff = lds_byte(wr * 64 + fr, fq * 8), boff = lds_byte(wc * 32 + fr, fq * 8);
#define PG8_SA(b, h) (((b) * 2 + (h)) * HTB)
#define PG8_SB(b, h) ((4 + (b) * 2 + (h)) * HTB)
#define PG8_STAGE(bufoff, gbase, voff) do { _Pragma("unroll") for (int _i = 0; _i < 2; ++_i) \
        __builtin_amdgcn_global_load_lds((const unsigned*)((const char*)(gbase) + (voff)[_i]), (PG8_LAS unsigned*)(lds + (bufoff) + ldsw + _i * 8192), 16, 0, 0); } while (0)
#define PG8_LDA(dst, b, h) do { _Pragma("unroll") for (int m = 0; m < 4; ++m) _Pragma("unroll") for (int k = 0; k < 2; ++k) dst[m][k] = *(const PG8_LAS bf16x8*)(lds + PG8_SA(b, h) + aoff + m * 2048 + k * 1024); } while (0)
#define PG8_LDB(dst, b, h) do { _Pragma("unroll") for (int n = 0; n < 2; ++n) _Pragma("unroll") for (int k = 0; k < 2; ++k) dst[n][k] = *(const PG8_LAS bf16x8*)(lds + PG8_SB(b, h) + boff + n * 2048 + k * 1024); } while (0)
#define PG8_MMA(ai, bj, At, Bt) do { __builtin_amdgcn_s_setprio(1); _Pragma("unroll") for (int m = 0; m < 4; ++m) _Pragma("unroll") for (int n = 0; n < 2; ++n) _Pragma("unroll") for (int k = 0; k < 2; ++k) { \
        acc[ai][bj][m][n] = __builtin_amdgcn_mfma_f32_16x16x32_bf16(Bt[n][k], At[m][k], acc[ai][bj][m][n], 0, 0, 0); } \
        __builtin_amdgcn_s_setprio(0); } while (0)
#define PG8_WAIT_V(n) asm volatile("s_waitcnt vmcnt(" #n ")" ::: "memory")
#define PG8_WAIT_L(n) asm volatile("s_waitcnt lgkmcnt(" #n ")" ::: "memory")
#define PG8_BAR __builtin_amdgcn_s_barrier()
#define PG8_SCHED __builtin_amdgcn_sched_barrier(0)
    Unit cur, nxt; int ui = 0;
    if (!S.next(0, cur)) return;
    f32x4 acc[2][2][4][2];
#pragma unroll
    for (int a = 0; a < 2; ++a)
#pragma unroll
        for (int b = 0; b < 2; ++b)
#pragma unroll
            for (int m = 0; m < 4; ++m)
#pragma unroll
                for (int n = 0; n < 2; ++n) acc[a][b][m][n] = (f32x4){0.f, 0.f, 0.f, 0.f};
    bf16x8 At[4][2], B0[2][2], B1[2][2];
#define PG8_RFETCH(pm_, par_) do { if constexpr (RMS) { if (wid < 4) __builtin_amdgcn_global_load_lds((const unsigned*)(g.R + (size_t)(pm_) * BM + wid * 64 + lane), (PG8_LAS unsigned*)(lds + RMS_LDS + (par_) * 1024 + wid * 256), 4, 0, 0); } } while (0)
#define PG8_ABASE(pm_) ((pm_) < g.msplit ? (const char*)g.A + (size_t)(pm_) * tstep : (const char*)g.A2 + (size_t)((pm_) - g.msplit) * tstep)
    const char* cA = PG8_ABASE(cur.pm); const char* cB = (const char*)g.Bt + (size_t)cur.pn * tstep;
    S.a_ready(cur);
    PG8_RFETCH(cur.pm, 0);
    if constexpr (SP2) {
        PG8_STAGE(PG8_SB(0, 0), cB, voffB); PG8_STAGE(PG8_SB(0, 1), cB + hstep, voffB); PG8_STAGE(PG8_SA(0, 0), cA, voffA); PG8_STAGE(PG8_SA(0, 1), cA + hstep, voffA);
        if (wr == 1) PG8_BAR;
        PG8_WAIT_V(2); PG8_BAR;
        PG8_STAGE(PG8_SB(1, 0), cB + kstep, voffB); PG8_STAGE(PG8_SA(1, 0), cA + kstep, voffA); PG8_STAGE(PG8_SB(1, 1), cB + hstep + kstep, voffB);
        PG8_WAIT_V(6); PG8_BAR;
    } else {
        PG8_STAGE(PG8_SB(0, 0), cB, voffB); PG8_STAGE(PG8_SA(0, 0), cA, voffA); PG8_STAGE(PG8_SB(0, 1), cB + hstep, voffB); PG8_STAGE(PG8_SA(0, 1), cA + hstep, voffA);
        if (wr == 1) PG8_BAR;
        PG8_WAIT_V(4); PG8_BAR;
        PG8_STAGE(PG8_SB(1, 0), cB + kstep, voffB); PG8_STAGE(PG8_SA(1, 0), cA + kstep, voffA); PG8_STAGE(PG8_SB(1, 1), cB + hstep + kstep, voffB);
        PG8_WAIT_V(6); PG8_BAR;
    }
    for (;;) {
        const bool has_next = S.next(ui + 1, nxt);
        const char* nA = has_next ? PG8_ABASE(nxt.pm) : cA; const char* nB = has_next ? (const char*)g.Bt + (size_t)nxt.pn * tstep : cB;
        for (int t = 0; t < nt; t += 2) {
            const bool last = (t == nt - 2);
            const char* a1 = cA + (size_t)(t + 1) * kstep;
            const char* a2 = last ? nA : cA + (size_t)(t + 2) * kstep; const char* b2 = last ? nB : cB + (size_t)(t + 2) * kstep;
            const char* a3 = a2 + kstep; const char* b3 = b2 + kstep;
            if (last && has_next) S.a_ready(nxt);
            if constexpr (SP2) {
            PG8_LDB(B0, 0, 0); PG8_LDB(B1, 0, 1); PG8_SCHED; PG8_LDA(At, 0, 0); PG8_STAGE(PG8_SA(1, 1), a1 + hstep, voffA);
            PG8_WAIT_V(8); PG8_WAIT_L(0); PG8_BAR; PG8_MMA(0, 0, At, B0); PG8_MMA(0, 1, At, B1); PG8_BAR; PG8_SCHED;
            PG8_LDA(At, 0, 1); PG8_STAGE(PG8_SB(0, 0), b2, voffB); PG8_STAGE(PG8_SB(0, 1), b2 + hstep, voffB); PG8_STAGE(PG8_SA(0, 0), a2, voffA);
            PG8_WAIT_V(8); PG8_WAIT_L(0); PG8_BAR; PG8_MMA(1, 0, At, B0); PG8_MMA(1, 1, At, B1); PG8_BAR; PG8_SCHED;
            PG8_LDB(B0, 1, 0); PG8_LDB(B1, 1, 1); PG8_SCHED; PG8_LDA(At, 1, 0); PG8_STAGE(PG8_SA(0, 1), a2 + hstep, voffA);
            PG8_WAIT_V(8); PG8_WAIT_L(0); PG8_BAR; PG8_MMA(0, 0, At, B0); PG8_MMA(0, 1, At, B1); PG8_BAR; PG8_SCHED;
            PG8_LDA(At, 1, 1); PG8_STAGE(PG8_SB(1, 0), b3, voffB); PG8_STAGE(PG8_SB(1, 1), b3 + hstep, voffB); PG8_STAGE(PG8_SA(1, 0), a3, voffA);
            PG8_WAIT_V(8); PG8_WAIT_L(0); PG8_BAR; PG8_MMA(1, 0, At, B0); PG8_MMA(1, 1, At, B1); PG8_BAR; PG8_SCHED;
            } else {
            PG8_LDB(B0, 0, 0); PG8_SCHED; PG8_LDA(At, 0, 0); PG8_STAGE(PG8_SA(1, 1), a1 + hstep, voffA);
            PG8_WAIT_L(8); PG8_BAR; PG8_WAIT_L(0); PG8_MMA(0, 0, At, B0); PG8_BAR; PG8_SCHED;
            PG8_LDB(B1, 0, 1); PG8_STAGE(PG8_SB(0, 0), b2, voffB);
            PG8_BAR; PG8_WAIT_L(0); PG8_MMA(0, 1, At, B1); PG8_BAR;
            PG8_LDA(At, 0, 1); PG8_STAGE(PG8_SA(0, 0), a2, voffA);
            PG8_BAR; PG8_WAIT_L(0); PG8_MMA(1, 0, At, B0); PG8_BAR; PG8_SCHED;
            PG8_STAGE(PG8_SB(0, 1), b2 + hstep, voffB);
            PG8_WAIT_V(6); PG8_BAR; PG8_MMA(1, 1, At, B1); PG8_BAR;
            PG8_LDB(B0, 1, 0); PG8_SCHED; PG8_LDA(At, 1, 0); PG8_STAGE(PG8_SA(0, 1), a2 + hstep, voffA);
            PG8_WAIT_L(8); PG8_BAR; PG8_WAIT_L(0); PG8_MMA(0, 0, At, B0); PG8_BAR; PG8_SCHED;
            PG8_LDB(B1, 1, 1); PG8_STAGE(PG8_SB(1, 0), b3, voffB);
            PG8_BAR; PG8_WAIT_L(0); PG8_MMA(0, 1, At, B1); PG8_BAR;
            PG8_LDA(At, 1, 1); PG8_STAGE(PG8_SA(1, 0), a3, voffA);
            PG8_BAR; PG8_WAIT_L(0); PG8_MMA(1, 0, At, B0); PG8_BAR; PG8_SCHED;
            PG8_STAGE(PG8_SB(1, 1), b3 + hstep, voffB);
            PG8_WAIT_V(6); PG8_BAR; PG8_MMA(1, 1, At, B1); PG8_BAR;
            }
        }
        if constexpr (ALIGN_EPI) { if (wr == 0) PG8_BAR; }
        if constexpr (RMS) {
            const PG8_LAS float* rl = (const PG8_LAS float*)(lds + RMS_LDS + (ui & 1) * 1024) + wr * 64 + fr;
#pragma unroll
            for (int a = 0; a < 2; ++a)
#pragma unroll
                for (int m = 0; m < 4; ++m) { const float r = rl[a * HALF + m * 16];
#pragma unroll
                    for (int b = 0; b < 2; ++b)
#pragma unroll
                        for (int n = 0; n < 2; ++n) acc[a][b][m][n] = acc[a][b][m][n] * r; }
        }
        if constexpr (!Epi::AFTER_DRAIN) { E(acc, cur, wr, wc, fr, fq); S.done(cur); }
        if (!has_next) break;
#pragma unroll
        for (int a = 0; a < 2; ++a)
#pragma unroll
            for (int b = 0; b < 2; ++b)
#pragma unroll
                for (int m = 0; m < 4; ++m)
#pragma unroll
                    for (int n = 0; n < 2; ++n) acc[a][b][m][n] = (f32x4){0.f, 0.f, 0.f, 0.f};
        cur = nxt; cA = nA; cB = nB; ++ui;
        PG8_RFETCH(cur.pm, ui & 1);
        if constexpr (ALIGN_EPI) { if (wr == 1) PG8_BAR; }
    }
    PG8_WAIT_V(0);
    if constexpr (!ALIGN_EPI) { if (wr == 0) PG8_BAR; }
    PG8_BAR;
    if constexpr (Epi::AFTER_DRAIN) { E.fused(acc, cur, wr, wc, fr, fq, lds, wid, lane); S.done(cur); }
#undef PG8_SA
#undef PG8_ABASE
#undef PG8_RFETCH
#undef PG8_SB
#undef PG8_STAGE
#undef PG8_LDA
#undef PG8_LDB
#undef PG8_MMA
#undef PG8_WAIT_V
#undef PG8_WAIT_L
#undef PG8_BAR
#undef PG8_SCHED
}
}
#endif
#ifndef EMU
#define XB_TMO      128
#define XB_XCNT(j)  (256  + 64 * (j))
#define XB_XSUB(j)  (1280 + 64 * (j))
#define XB_XGEN(j)  (2304 + 64 * (j))
#define XB_TOP      3328
#define XB_TOPGEN   3392
#define XCD_BAR_WORDS 3456
#define XB_SPIN_CAP (1u << 18)

__device__ __forceinline__ unsigned xb_ld(unsigned* p)              { return __hip_atomic_load(p, __ATOMIC_RELAXED, __HIP_MEMORY_SCOPE_AGENT); }
__device__ __forceinline__ unsigned xb_add(unsigned* p, unsigned v) { return __hip_atomic_fetch_add(p, v, __ATOMIC_RELAXED, __HIP_MEMORY_SCOPE_AGENT); }
__device__ __forceinline__ unsigned xb_xcc_id() { return (unsigned)__builtin_amdgcn_s_getreg((3 << 11) | 20) & 0xFu; }
#define XB_SPIN(cond, bar) do { unsigned _sp = 0; while (cond) { __builtin_amdgcn_s_sleep(1); \
    if ((++_sp & 255u) == 0u) { if (xb_ld(&(bar)[XB_TMO])) break; if (_sp > XB_SPIN_CAP) { atomicAdd(&(bar)[XB_TMO], 1u); break; } } } } while (0)

struct XcdBarrier {
    unsigned* bar; unsigned x;
    volatile LAS unsigned* st;
};

__device__ __forceinline__ XcdBarrier xcd_barrier_post(unsigned* bar, volatile LAS unsigned* st) {
    XcdBarrier b; b.bar = bar; b.x = xb_xcc_id(); b.st = st;
    if (threadIdx.x == 0) (void)xb_add(&bar[XB_XCNT(b.x)], 1u);
    return b;
}
__device__ __forceinline__ void xcd_barrier_complete(unsigned* bar, unsigned x, unsigned& nloc, unsigned& nx) {
    const unsigned G = gridDim.x * gridDim.y * gridDim.z;
    unsigned sum, cnt, mine, sp = 0u;
    for (;;) {
        sum = 0u; cnt = 0u; mine = 0u;
#pragma unroll
        for (unsigned j = 0; j < 16; ++j) { const unsigned c = xb_ld(&bar[XB_XCNT(j)]); sum += c; cnt += (c > 0u) ? 1u : 0u; mine = (j == x) ? c : mine; }
        if (sum == G) break;
        __builtin_amdgcn_s_sleep(1);
        if ((++sp & 255u) == 0u) { if (xb_ld(&bar[XB_TMO])) break; if (sp > XB_SPIN_CAP) { atomicAdd(&bar[XB_TMO], 1u); break; } }
    }
    nloc = mine > 0u ? mine : 1u; nx = cnt > 0u ? cnt : 1u;
}

__device__ __forceinline__ void xcd_barrier(const XcdBarrier& b) {
    asm volatile("s_waitcnt vmcnt(0)" ::: "memory");
    __syncthreads();
    if (threadIdx.x == 0) {
        unsigned* bar = b.bar;
        __builtin_amdgcn_s_waitcnt(0);
        unsigned nloc = b.st[0], nx = b.st[1];
        if (nloc == 0u) { xcd_barrier_complete(bar, b.x, nloc, nx); b.st[0] = nloc; b.st[1] = nx; }
        const unsigned old = xb_add(&bar[XB_XSUB(b.x)], 1u);
        const unsigned gen = old / nloc;
        if (old + 1u == (gen + 1u) * nloc) {
            __builtin_amdgcn_fence(__ATOMIC_RELEASE, "agent");
            asm volatile("s_waitcnt vmcnt(0)" ::: "memory");
            const unsigned og = xb_add(&bar[XB_TOP], 1u);
            const unsigned tg = og / nx;
            if (og + 1u == (tg + 1u) * nx) xb_add(&bar[XB_TOPGEN], 1u);
            else XB_SPIN(xb_ld(&bar[XB_TOPGEN]) == tg, bar);
            __builtin_amdgcn_fence(__ATOMIC_ACQUIRE, "agent");
            xb_add(&bar[XB_XGEN(b.x)], 1u);
            asm volatile("s_waitcnt vmcnt(0)" ::: "memory");
        } else {
            XB_SPIN(xb_ld(&bar[XB_XGEN(b.x)]) == gen, bar);
            __builtin_amdgcn_fence(__ATOMIC_ACQUIRE, "agent");
            asm volatile("s_waitcnt vmcnt(0)" ::: "memory");
        }
    }
    __syncthreads();
}
#endif
__device__ __forceinline__ void wt_item(const float* W, int K, int N, bf16* WT, int k0, int n0, int orow0, LAS float* scr, int lane) {
#pragma unroll 8
    for (int i = 0; i < 32; ++i) { const int kk = 2 * i + (lane >> 5); scr[kk * 33 + (lane & 31)] = W[(size_t)(k0 + kk) * N + n0 + (lane & 31)]; }
    WG_BARRIER_WAVE();
    const int c = lane & 7;
#pragma unroll
    for (int j = 0; j < 4; ++j) { const int n = (lane >> 3) + 8 * j; const LAS float* s = scr + (8 * c) * 33 + n;
        u32x4 o; o.x = pk2(s[0 * 33], s[1 * 33]); o.y = pk2(s[2 * 33], s[3 * 33]); o.z = pk2(s[4 * 33], s[5 * 33]); o.w = pk2(s[6 * 33], s[7 * 33]);
        *(u32x4*)(WT + (size_t)(orow0 + n) * K + k0 + 8 * c) = o; }
    WG_BARRIER_WAVE();
}
constexpr int WT_SCR = 64 * 65 * 4;
struct WtItem { const float* W; bf16* WT; int K, N, k0, n0, orow0; const float* scale; };
__device__ __forceinline__ void wt_load(const WtItem& it, f32x4 (&v)[16], float& scl, int lane) {
    const float* src = it.W + (size_t)(it.k0 + (lane >> 4)) * it.N + it.n0 + 4 * (lane & 15);
#pragma unroll
    for (int i = 0; i < 16; ++i) v[i] = *(const f32x4*)(src + (size_t)(4 * i) * it.N);
    scl = it.scale ? it.scale[it.k0 + lane] : 1.0f;
}
__device__ __forceinline__ void wt_store(const WtItem& it, const f32x4 (&v)[16], float scl, LAS float* scr, int lane) {
#pragma unroll
    for (int i = 0; i < 16; ++i) { LAS float* d = scr + (4 * i + (lane >> 4)) * 65 + 4 * (lane & 15); const float s = __shfl(scl, 4 * i + (lane >> 4)); d[0] = v[i].x * s; d[1] = v[i].y * s; d[2] = v[i].z * s; d[3] = v[i].w * s; }
    WG_BARRIER_WAVE();
    const int c = lane & 7;
#pragma unroll
    for (int j = 0; j < 8; ++j) { const int n = (lane >> 3) + 8 * j; const LAS float* s = scr + (8 * c) * 65 + n;
        u32x4 o; o.x = pk2(s[0 * 65], s[1 * 65]); o.y = pk2(s[2 * 65], s[3 * 65]); o.z = pk2(s[4 * 65], s[5 * 65]); o.w = pk2(s[6 * 65], s[7 * 65]);
        *(u32x4*)(it.WT + (size_t)(it.orow0 + n) * it.K + it.k0 + 8 * c) = o; }
    WG_BARRIER_WAVE();
}
struct WtJob { const float* W; bf16* WT; int K, N, mode; const float* scale; };
__device__ __forceinline__ int wt_items(const WtJob& j) { return (j.K / 64) * (j.N / 64); }
__device__ __forceinline__ WtItem wt_item_of(const WtJob& j, int item) {
    const int nblk = j.N / 64, kb = item / nblk, nb = item - kb * nblk, n0 = 64 * nb;
    const int orow0 = j.mode == 0 ? n0 : ((n0 >> 7) * 256 + (j.mode == 2 ? 128 : 0) + (n0 & 127));
    return WtItem{j.W, j.WT, j.K, j.N, 64 * kb, n0, orow0, j.scale};
}
__device__ __forceinline__ void wt_run(const WtJob& j, int item, LAS float* scr, int lane) {
    const WtItem it = wt_item_of(j, item); f32x4 v[16]; float scl; wt_load(it, v, scl, lane); wt_store(it, v, scl, scr, lane);
}
__device__ __forceinline__ void rms_row(const float* xrow, const float* w, float* xcopy, bf16* obf, float* of32, int lane) {
    const f32x4* xr = (const f32x4*)xrow + lane; const f32x4* wr = (const f32x4*)w + lane;
    f32x4 v[8]; float ss = 0.f;
#pragma unroll
    for (int j = 0; j < 8; ++j) { v[j] = xr[64 * j]; ss += (v[j].x * v[j].x + v[j].y * v[j].y) + (v[j].z * v[j].z + v[j].w * v[j].w); }
    if (xcopy) {
#pragma unroll
        for (int j = 0; j < 8; ++j) ((f32x4*)xcopy + lane)[64 * j] = v[j]; }
    const float r = 1.0f / sqrtf(wave_sum(ss) * (1.0f / DM) + EPS);
#pragma unroll
    for (int j = 0; j < 8; ++j) { const f32x4 ww = wr[64 * j]; f32x4 y; y.x = v[j].x * r * ww.x; y.y = v[j].y * r * ww.y; y.z = v[j].z * r * ww.z; y.w = v[j].w * r * ww.w;
        if (obf) { u32x2 o; o.x = pk2(y.x, y.y); o.y = pk2(y.z, y.w); ((u32x2*)obf + lane)[64 * j] = o; }
        if (of32) ((f32x4*)of32 + lane)[64 * j] = y; }
}

__device__ __forceinline__ void rms_rows(const float* x, const float* w, float* xcopy, bf16* obf, float* of32, int nrows, int gw, int NGW, int lane) {
    const f32x4* wr = (const f32x4*)w + lane;
    f32x4 v[8], vn[8];
    int m = gw;
    if (m < nrows) { const f32x4* xr = (const f32x4*)(x + (size_t)m * DM) + lane;
#pragma unroll
        for (int j = 0; j < 8; ++j) v[j] = xr[64 * j]; }
#pragma unroll 1
    while (m < nrows) {
        const int mn = m + NGW;
        if (mn < nrows) { const f32x4* xr = (const f32x4*)(x + (size_t)mn * DM) + lane;
#pragma unroll
            for (int j = 0; j < 8; ++j) vn[j] = xr[64 * j]; }
        float ss = 0.f;
#pragma unroll
        for (int j = 0; j < 8; ++j) ss += (v[j].x * v[j].x + v[j].y * v[j].y) + (v[j].z * v[j].z + v[j].w * v[j].w);
        if (xcopy) {
#pragma unroll
            for (int j = 0; j < 8; ++j) ((f32x4*)(xcopy + (size_t)m * DM) + lane)[64 * j] = v[j]; }
        const float r = FAST_RSQ(wave_sum(ss) * (1.0f / DM) + EPS);
#pragma unroll
        for (int j = 0; j < 8; ++j) { const f32x4 ww = wr[64 * j]; f32x4 y; y.x = v[j].x * r * ww.x; y.y = v[j].y * r * ww.y; y.z = v[j].z * r * ww.z; y.w = v[j].w * r * ww.w;
            if (obf) { u32x2 o; o.x = pk2(y.x, y.y); o.y = pk2(y.z, y.w); ((u32x2*)(obf + (size_t)m * DM) + lane)[64 * j] = o; }
            if (of32) ((f32x4*)(of32 + (size_t)m * DM) + lane)[64 * j] = y; }
#pragma unroll
        for (int j = 0; j < 8; ++j) v[j] = vn[j];
        m = mn;
    }
}
__device__ __forceinline__ void rms_h_load(const bf16* xh, int m, u32x4 (&v)[4], int lane) {
    const u32x4* xr = (const u32x4*)(xh + (size_t)m * DM) + lane;
#pragma unroll
    for (int j = 0; j < 4; ++j) v[j] = xr[64 * j];
}
__device__ __forceinline__ void rms_h_finish(const u32x4 (&v)[4], const float* w, bf16* obf, float* of32, int m, int lane) {
    const f32x4* wr = (const f32x4*)w + 2 * lane;
    float ss = 0.f;
#pragma unroll
    for (int j = 0; j < 4; ++j) { const float a0 = bflo(v[j].x), a1 = bfhi(v[j].x), a2 = bflo(v[j].y), a3 = bfhi(v[j].y), a4 = bflo(v[j].z), a5 = bfhi(v[j].z), a6 = bflo(v[j].w), a7 = bfhi(v[j].w);
        ss += ((a0 * a0 + a1 * a1) + (a2 * a2 + a3 * a3)) + ((a4 * a4 + a5 * a5) + (a6 * a6 + a7 * a7)); }
    const float r = FAST_RSQ(wave_sum(ss) * (1.0f / DM) + EPS);
#pragma unroll
    for (int j = 0; j < 4; ++j) { const f32x4 w0 = wr[128 * j], w1 = wr[128 * j + 1];
        f32x4 y0, y1; y0.x = bflo(v[j].x) * r * w0.x; y0.y = bfhi(v[j].x) * r * w0.y; y0.z = bflo(v[j].y) * r * w0.z; y0.w = bfhi(v[j].y) * r * w0.w;
        y1.x = bflo(v[j].z) * r * w1.x; y1.y = bfhi(v[j].z) * r * w1.y; y1.z = bflo(v[j].w) * r * w1.z; y1.w = bfhi(v[j].w) * r * w1.w;
        if (obf) { u32x4 o; o.x = pk2(y0.x, y0.y); o.y = pk2(y0.z, y0.w); o.z = pk2(y1.x, y1.y); o.w = pk2(y1.z, y1.w); ((u32x4*)(obf + (size_t)m * DM) + lane)[64 * j] = o; }
        if (of32) { f32x4* op = (f32x4*)(of32 + (size_t)m * DM) + 2 * lane; op[128 * j] = y0; op[128 * j + 1] = y1; } }
}
__device__ __forceinline__ void rms_rows_h(const bf16* xh, const float* w, bf16* obf, float* of32, int nrows, int gw, int NGW, int lane) {
    u32x4 v[4], vn[4];
    int m = gw;
    if (m < nrows) rms_h_load(xh, m, v, lane);
#pragma unroll 1
    while (m < nrows) {
        const int mn = m + NGW;
        if (mn < nrows) rms_h_load(xh, mn, vn, lane);
        rms_h_finish(v, w, obf, of32, m, lane);
#pragma unroll
        for (int j = 0; j < 4; ++j) v[j] = vn[j];
        m = mn;
    }
}
__device__ __forceinline__ void cvt_rows(const float* x, float* xcopy, bf16* obf, float* rout, int nrows, int gw, int NGW, int lane) {
#pragma unroll 1
    for (int m = gw; m < nrows; m += NGW) { const f32x4* xr = (const f32x4*)(x + (size_t)m * DM) + 2 * lane;
        f32x4 a[4], b[4]; float ss = 0.f;
#pragma unroll
        for (int j = 0; j < 4; ++j) { a[j] = xr[128 * j]; b[j] = xr[128 * j + 1]; }
#pragma unroll
        for (int j = 0; j < 4; ++j) { u32x4 o; o.x = pk2(a[j].x, a[j].y); o.y = pk2(a[j].z, a[j].w); o.z = pk2(b[j].x, b[j].y); o.w = pk2(b[j].z, b[j].w); ((u32x4*)(obf + (size_t)m * DM) + lane)[64 * j] = o;
            ss += ((a[j].x * a[j].x + a[j].y * a[j].y) + (a[j].z * a[j].z + a[j].w * a[j].w)) + ((b[j].x * b[j].x + b[j].y * b[j].y) + (b[j].z * b[j].z + b[j].w * b[j].w));
            if (xcopy) { f32x4* xc = (f32x4*)(xcopy + (size_t)m * DM) + 2 * lane; xc[128 * j] = a[j]; xc[128 * j + 1] = b[j]; } }
        const float r = FAST_RSQ(wave_sum(ss) * (1.0f / DM) + EPS);
        if (lane == 0) rout[m] = r;
    }
}
__device__ __forceinline__ void slots_to_r(const float* sl, float* rout, int nrows, int tlin, int ntlin) {
#pragma unroll 1
    for (int i = tlin; i < nrows * 8; i += ntlin) { const f32x4 v = ((const f32x4*)sl)[i]; float s = (v.x + v.y) + (v.z + v.w);
        s += __shfl_xor(s, 1); s += __shfl_xor(s, 2); s += __shfl_xor(s, 4);
        if ((i & 7) == 0) rout[i >> 3] = FAST_RSQ(s * (1.0f / DM) + EPS); }
}
struct GdnP {
    const bf16* proj;
    const float* ba;
    const float* wconv;
    const float* a_log;
    const float* dt_bias;
    const float* conv_state;
    const float* rec_state;
    float* out_pconv;
    float* out_sconv;
    float* out_prec;
    float* out_srec;
    bf16 *U, *WN, *QG, *KG, *QK;
    float* DEC;
    bf16* o;
};


__device__ __forceinline__ void store_frag16(bf16* fragbase, size_t subtile_stride, const f32x16& v, int lane) {
    const int h = lane >> 5, l31 = lane & 31;
    bf16* fb = fragbase + (size_t)(l31 >> 4) * subtile_stride;
#pragma unroll
    for (int g = 0; g < 4; ++g) { const int lanep = (l31 & 15) + 16 * (2 * (g & 1) + h);
        u32x2 w; w.x = pk2(v[4 * g], v[4 * g + 1]); w.y = pk2(v[4 * g + 2], v[4 * g + 3]);
        *(u32x2*)(fb + lanep * 8 + 4 * (g >> 1)) = w; }
}
__device__ __forceinline__ int perm16(int q, int j) { return 16 * (j >> 2) + 4 * q + (j & 3); }
constexpr int PL_QN = 0, PL_KN = 17408, PL_KT = 34816, PL_VT = 53248, PL_LT = 90112, PL_TB = 126976, PL_END = 129536;

template <int C> struct PrepIn { float s0_b, s0_a; float w0[2], w1[2], w2[2], w3[2]; unsigned hw[3]; f32x2 hs[3]; unsigned xr[C / 2]; };
template <int C>
__device__ __forceinline__ void gdn_prep_fetch(const GdnP& p, int cidx, int hk, PrepIn<C>& in, int lane, int wid) {
    constexpr bool SAMPLE = (C == 32); constexpr int NT = C / 2;
    const int bsm = cidx - NCH;
    const int row0 = SAMPLE ? SEQ + 32 * bsm : 64 * cidx;
    in.s0_b = 0.f; in.s0_a = 0.f;
    if (wid < 2 && lane < C) { const float* bar = p.ba + (size_t)(row0 + lane) * 64; in.s0_b = bar[2 * hk + wid]; in.s0_a = bar[32 + 2 * hk + wid]; }
    const int arr = wid & 3, half = wid >> 2;
    const int chbase = arr == 0 ? hk * 128 : (arr == 1 ? 2048 + hk * 128 : 4096 + (2 * hk + (arr - 2)) * 128);
    const int ch = chbase + 2 * lane;
#pragma unroll
    for (int e = 0; e < 2; ++e) { in.w0[e] = p.wconv[0 * 8192 + ch + e]; in.w1[e] = p.wconv[1 * 8192 + ch + e]; in.w2[e] = p.wconv[2 * 8192 + ch + e]; in.w3[e] = p.wconv[3 * 8192 + ch + e]; }
    const int t0 = half * (C / 2);
#pragma unroll
    for (int q = 0; q < 3; ++q) { const int t = t0 - 3 + q; const int rr = row0 + t; const int rc = SAMPLE ? row0 + (t < 0 ? 0 : t) : (rr < 0 ? 0 : rr);
        in.hw[q] = *(const unsigned*)(p.proj + (size_t)rc * PPITCH + ch);
        if (SAMPLE) { const int si = (3 + t) < 0 ? 0 : ((3 + t) > 2 ? 2 : (3 + t)); in.hs[q] = *(const f32x2*)(p.conv_state + ((size_t)bsm * 3 + si) * 8192 + ch); } else in.hs[q] = (f32x2){0.f, 0.f}; }
#pragma unroll
    for (int tt = 0; tt < NT; ++tt) in.xr[tt] = *(const unsigned*)(p.proj + (size_t)(row0 + t0 + tt) * PPITCH + ch);
}
template <int C>
__device__ __forceinline__ void gdn_prep_unit(const GdnP& p, LAS unsigned char* lds, int cidx, int hk, PrepIn<C>& in, int nx_cidx, int nx_hk) {
    constexpr int NM = C / 32, NKS = C / 16;
    constexpr bool SAMPLE = (C == 32);
    const int tid = tid_opaque(), lane = tid & 63, wid = RFL(tid >> 6), h = lane >> 5, l31 = lane & 31;
    const int bsm = cidx - NCH;
    const int row0 = SAMPLE ? SEQ + 32 * bsm : 64 * cidx;
    LAS bf16* QN = (LAS bf16*)(lds + PL_QN);
    LAS bf16* KN = (LAS bf16*)(lds + PL_KN);
    LAS bf16* KT = (LAS bf16*)(lds + PL_KT);
    LAS bf16* VT = (LAS bf16*)(lds + PL_VT);
    LAS float* LT = (LAS float*)(lds + PL_LT);
    LAS float* TB = (LAS float*)(lds + PL_TB);
    const float s0_b = in.s0_b, s0_a = in.s0_a;
    {
        const int arr = wid & 3, half = wid >> 2;
        const int chbase = arr == 0 ? hk * 128 : (arr == 1 ? 2048 + hk * 128 : 4096 + (2 * hk + (arr - 2)) * 128);
        const int ch = chbase + 2 * lane;
        float w0[2], w1[2], w2[2], w3[2];
#pragma unroll
        for (int e = 0; e < 2; ++e) { w0[e] = in.w0[e]; w1[e] = in.w1[e]; w2[e] = in.w2[e]; w3[e] = in.w3[e]; }
        const int t0 = half * (C / 2);
        float xw[3][2];
#pragma unroll
        for (int q = 0; q < 3; ++q) { const int t = t0 - 3 + q; const int rr = row0 + t; float a = bflo(in.hw[q]), b = bfhi(in.hw[q]);
            if (SAMPLE) { if (t < 0) { a = in.hs[q].x; b = in.hs[q].y; } } else if (rr < 0) { a = 0.f; b = 0.f; }
            xw[q][0] = a; xw[q][1] = b; }
        const bool lastchunk = SAMPLE || (cidx == NCH - 1);
        constexpr int NT = C / 2;
        unsigned xr[NT];
#pragma unroll
        for (int tt = 0; tt < NT; ++tt) xr[tt] = in.xr[tt];
        float ya[NT], yb[NT];
#pragma unroll
        for (int tt = 0; tt < NT; ++tt) {
            const int c = t0 + tt;
            const float x0 = bflo(xr[tt]), x1 = bfhi(xr[tt]);
            const float y0 = w0[0] * xw[0][0] + w1[0] * xw[1][0] + w2[0] * xw[2][0] + w3[0] * x0;
            const float y1 = w0[1] * xw[0][1] + w1[1] * xw[1][1] + w2[1] * xw[2][1] + w3[1] * x1;
            xw[0][0] = xw[1][0]; xw[0][1] = xw[1][1]; xw[1][0] = xw[2][0]; xw[1][1] = xw[2][1]; xw[2][0] = x0; xw[2][1] = x1;
            ya[tt] = siluf_(y0); yb[tt] = siluf_(y1);
        }
        if (lastchunk && half == 1) {
#pragma unroll
            for (int q = 0; q < 3; ++q) { const unsigned w = xr[NT - 3 + q]; float* dst = SAMPLE ? p.out_sconv + ((size_t)bsm * 3 + q) * 8192 + ch : p.out_pconv + (size_t)q * 8192 + ch; dst[0] = bflo(w); dst[1] = bfhi(w); } }
        if (arr < 2) {
            LAS float* scr = (LAS float*)(lds + PL_LT) + (arr + 2 * half) * 2304;
            LAS float* PS = scr + 64 * (NT + 1); LAS float* SC = PS + 64;
#pragma unroll
            for (int tt = 0; tt < NT; ++tt) scr[lane * (NT + 1) + tt] = ya[tt] * ya[tt] + yb[tt] * yb[tt];
            WG_BARRIER_WAVE();
            { const int tq = lane & (NT - 1), part = lane / NT; float s = 0.f;
#pragma unroll
              for (int r = 0; r < NT; ++r) s += scr[(part * NT + r) * (NT + 1) + tq];
              PS[lane] = s; }
            WG_BARRIER_WAVE();
            if (lane < NT) { float s = 0.f;
#pragma unroll
                for (int q = 0; q < 64 / NT; ++q) s += PS[q * NT + lane];
                SC[lane] = FAST_RSQ(s + EPS) * (arr == 0 ? 0.08838834764831845f : 1.0f); }
            WG_BARRIER_WAVE();
#pragma unroll
            for (int tt = 0; tt < NT; ++tt) { const int c = t0 + tt; const float r = SC[tt]; const float y0 = ya[tt] * r, y1 = yb[tt] * r;
                if (arr == 0) *(LAS unsigned*)(QN + c * 136 + 2 * lane) = pk2(y0, y1);
                else { const unsigned w = pk2(y0, y1); *(LAS unsigned*)(KN + c * 136 + 2 * lane) = w; KT[(2 * lane) * 72 + c] = (bf16)(w & 0xffffu); KT[(2 * lane + 1) * 72 + c] = (bf16)(w >> 16); } }
        } else {
#pragma unroll
            for (int tt = 0; tt < NT; ++tt) { const int c = t0 + tt; const unsigned w = pk2(ya[tt], yb[tt]); LAS bf16* vt = VT + ((arr - 2) * 128 + 2 * lane) * 72 + c; vt[0] = (bf16)(w & 0xffffu); vt[72] = (bf16)(w >> 16); }
        }
    }
    if (wid < 2) {
        const int hvl = wid, hv = 2 * hk + hvl, c = lane;
        float g = 0.f, beta = 0.f;
        if (c < C) { beta = sigmoidf_(s0_b); g = -__expf(p.a_log[hv]) * softplusf_(s0_a + p.dt_bias[hv]); }
        float gc = g;
#pragma unroll
        for (int d = 1; d < 64; d <<= 1) { const float t = __shfl_up(gc, d); if (lane >= d) gc += t; }
        const float glast = __shfl(gc, C - 1);
        if (c < C) { const float eg = __expf(gc);
            TB[(0 * 2 + hvl) * 64 + c] = beta; TB[(1 * 2 + hvl) * 64 + c] = gc; TB[(2 * 2 + hvl) * 64 + c] = beta * eg;
            TB[(3 * 2 + hvl) * 64 + c] = eg; TB[(4 * 2 + hvl) * 64 + c] = __expf(glast - gc); }
        if (lane == 0) p.DEC[cidx * 32 + hv] = __expf(glast);
    }
    if (nx_cidx >= 0) gdn_prep_fetch<C>(p, nx_cidx, nx_hk, in, lane, wid);
    WG_BARRIER();
    {
        const int kind = wid >> 2, mr = (wid >> 1) & 1, mc = wid & 1;
        const bool act = (mr < NM) && (mc < NM) && !(kind == 1 && mr > mc);
        if (act) {
            f32x16 acc;
#pragma unroll
            for (int r = 0; r < 16; ++r) acc[r] = 0.f;
            const LAS bf16* Arow = KN + (32 * mr + l31) * 136 + 8 * h;
            const LAS bf16* Brow = (kind == 0 ? KN : QN) + (32 * mc + l31) * 136 + 8 * h;
#pragma unroll
            for (int s = 0; s < 8; ++s) acc = MFMA32(*(const LAS bf16x8*)(Arow + 16 * s), *(const LAS bf16x8*)(Brow + 16 * s), acc);
            const int colx = 32 * mc + l31;
#pragma unroll
            for (int hvl = 0; hvl < 2; ++hvl) {
                const LAS float* beta = TB + (0 * 2 + hvl) * 64; const LAS float* gcv = TB + (1 * 2 + hvl) * 64;
                const float gcol = gcv[colx];
                f32x4 gr[4], br[4];
#pragma unroll
                for (int gq = 0; gq < 4; ++gq) { gr[gq] = *(const LAS f32x4*)(gcv + 32 * mr + 8 * gq + 4 * h); if (kind == 0) br[gq] = *(const LAS f32x4*)(beta + 32 * mr + 8 * gq + 4 * h); }
                if (kind == 0) {
#pragma unroll
                    for (int r = 0; r < 16; ++r) { const int c = 32 * mr + accrow(r, h); const float gcr = gr[r >> 2][r & 3], bcr = br[r >> 2][r & 3];
                        const float e = __expf(fminf(gcr - gcol, 0.f));
                        LT[(hvl * 64 + c) * 72 + colx] = (c > colx) ? bcr * acc[r] * e : 0.f; }
                } else {
                    float v[16];
#pragma unroll
                    for (int r = 0; r < 16; ++r) { const int cp = 32 * mr + accrow(r, h); const float e = __expf(fminf(gcol - gr[r >> 2][r & 3], 0.f)); v[r] = (colx >= cp) ? acc[r] * e : 0.f; }
                    f32x16 vv;
#pragma unroll
                    for (int r = 0; r < 16; ++r) vv[r] = v[r];
                    store_frag16(p.QK + (size_t)(cidx * 32 + 2 * hk + hvl) * 4096 + (size_t)((2 * mc) * NM + mr) * 512, (size_t)NM * 512, vv, lane);
                }
            }
        }
    }
    WG_BARRIER();
    if (wid < 2) {
        const int hvl = wid; LAS float* L = LT + hvl * 64 * 72;
        const int blk = (C == 64) ? h : 0;
        const bool lact = (C == 64) || lane < 32;
        const LAS float* Lb = L + (32 * blk) * 72 + 32 * blk;
        float T[32];
#pragma unroll
        for (int i = 0; i < 32; ++i) {
            float s0 = (i == l31) ? 1.f : 0.f, s1 = 0.f, s2 = 0.f, s3 = 0.f;
#pragma unroll
            for (int j4 = 0; j4 < i; j4 += 4) { const f32x4 lv = *(const LAS f32x4*)(Lb + i * 72 + j4);
                s0 -= lv.x * T[j4]; if (j4 + 1 < i) s1 -= lv.y * T[j4 + 1]; if (j4 + 2 < i) s2 -= lv.z * T[j4 + 2]; if (j4 + 3 < i) s3 -= lv.w * T[j4 + 3]; }
            float s = (s0 + s1) + (s2 + s3);
            PIN_F(s);
            T[i] = s;
        }
        f32x16 X;
        if (C == 64) {
            LAS bf16* scrA = (LAS bf16*)(L + l31 * 72 + 32);
            if (h == 0) {
#pragma unroll
                for (int q = 0; q < 4; ++q) *(LAS u32x4*)(scrA + 8 * q) = (u32x4){pk2(T[8 * q], T[8 * q + 1]), pk2(T[8 * q + 2], T[8 * q + 3]), pk2(T[8 * q + 4], T[8 * q + 5]), pk2(T[8 * q + 6], T[8 * q + 7])};
            } else {
#pragma unroll
                for (int i = 0; i < 32; ++i) ((LAS bf16*)(L + i * 72 + 32))[32 + l31] = (bf16)f2bf(T[i]);
            }
            WG_BARRIER_WAVE();
            f32x16 Pm;
#pragma unroll
            for (int r = 0; r < 16; ++r) Pm[r] = 0.f;
#pragma unroll
            for (int s = 0; s < 2; ++s) { const LAS float* ar = L + (32 + l31) * 72 + 16 * s + 8 * h; const f32x4 a0 = *(const LAS f32x4*)ar, a1 = *(const LAS f32x4*)(ar + 4);
                const bf16x8 af = pack8(a0.x, a0.y, a0.z, a0.w, a1.x, a1.y, a1.z, a1.w);
                const bf16x8 bfr = *(const LAS bf16x8*)(scrA + 16 * s + 8 * h);
                Pm = MFMA32(af, bfr, Pm); }
#pragma unroll
            for (int r = 0; r < 16; ++r) X[r] = 0.f;
#pragma unroll
            for (int s = 0; s < 2; ++s) { const LAS bf16* tb = scrA + 32 + 16 * s + 4 * h; const u32x2 x0 = *(const LAS u32x2*)tb, x1 = *(const LAS u32x2*)(tb + 8);
                X = MFMA32(__builtin_bit_cast(bf16x8, (u32x4){x0.x, x0.y, x1.x, x1.y}), acc_frag(Pm, s), X); }
        }
        WG_BARRIER_WAVE();
        LAS bf16* TU = (LAS bf16*)L; LAS bf16* TW = TU + 64 * 72;
        if (lact) {
            const int col = 32 * blk + l31;
            const float bcol = TB[(0 * 2 + hvl) * 64 + col], bbcol = TB[(2 * 2 + hvl) * 64 + col];
#pragma unroll
            for (int i = 0; i < 32; ++i) { TU[(32 * blk + i) * 72 + col] = (bf16)f2bf(T[i] * bcol); TW[(32 * blk + i) * 72 + col] = (bf16)f2bf(T[i] * bbcol); }
        }
        if (C == 64) {
            const float bc0 = TB[(0 * 2 + hvl) * 64 + l31], bbc0 = TB[(2 * 2 + hvl) * 64 + l31];
#pragma unroll
            for (int r = 0; r < 16; ++r) { const int i = accrow(r, h);
                TU[(32 + i) * 72 + l31] = (bf16)f2bf(-X[r] * bc0); TW[(32 + i) * 72 + l31] = (bf16)f2bf(-X[r] * bbc0);
                TU[i * 72 + 32 + l31] = (bf16)0; TW[i * 72 + 32 + l31] = (bf16)0; }
        }
    } else {
        constexpr int NCT = C / 16, NKC = C / 32;
    #pragma unroll 1
        for (int it = tid - 128; it < 2 * NCT * 4 * 64; it += 384) {
            const int ln = it & 63, ks = (it >> 6) & 3, ct = (it >> 8) % NCT, hvl = (it >> 8) / NCT, q = ln >> 4;
            const int c = 16 * ct + (ln & 15); const float sc = TB[(3 * 2 + hvl) * 64 + c];
            const LAS bf16* src = QN + c * 136 + 32 * ks + 4 * q;
            const u32x2 a = *(const LAS u32x2*)(src), b = *(const LAS u32x2*)(src + 16);
            *(bf16x8*)(p.QG + (size_t)(cidx * 32 + 2 * hk + hvl) * 8192 + ((ct * 4 + ks) * 64 + ln) * 8) =
                pack8(bflo(a.x) * sc, bfhi(a.x) * sc, bflo(a.y) * sc, bfhi(a.y) * sc, bflo(b.x) * sc, bfhi(b.x) * sc, bflo(b.y) * sc, bfhi(b.y) * sc);
        }
    #pragma unroll 1
        for (int it = tid - 128; it < 2 * 8 * NKC * 64; it += 384) {
            const int ln = it & 63, ks = (it >> 6) % NKC, t = ((it >> 6) / NKC) & 7, hvl = (it >> 6) / (NKC * 8), q = ln >> 4;
            const int dkr = 16 * t + (ln & 15); const int c0 = 32 * ks + 4 * q;
            const LAS bf16* src = KT + dkr * 72 + c0; const LAS float* ek = TB + (4 * 2 + hvl) * 64 + c0;
            const u32x2 a = *(const LAS u32x2*)(src), b = *(const LAS u32x2*)(src + 16);
            *(bf16x8*)(p.KG + (size_t)(cidx * 32 + 2 * hk + hvl) * 8192 + ((t * NKC + ks) * 64 + ln) * 8) =
                pack8(bflo(a.x) * ek[0], bfhi(a.x) * ek[1], bflo(a.y) * ek[2], bfhi(a.y) * ek[3], bflo(b.x) * ek[16], bfhi(b.x) * ek[17], bflo(b.y) * ek[18], bfhi(b.y) * ek[19]);
        }

    }
    WG_BARRIER();
#pragma unroll 1
    for (int t = 0; t < 4; ++t) {
        const int id = wid * 4 + t, hvl = id >> 4, kind = (id >> 3) & 1, idx = id & 7, hv = 2 * hk + hvl;
        const LAS bf16* TU = (const LAS bf16*)(LT + hvl * 64 * 72); const LAS bf16* TW = TU + 64 * 72;
        const int m = kind == 0 ? (idx >> 2) : (idx & 1);
        if (m >= NM) continue;
        f32x16 acc;
#pragma unroll
        for (int r = 0; r < 16; ++r) acc[r] = 0.f;
        const LAS bf16* Arow; const LAS bf16* Brow;
        if (kind == 0) { const int vt = idx & 3; Arow = TU + (32 * m + l31) * 72 + 8 * h; Brow = VT + (hvl * 128 + 32 * vt + l31) * 72 + 8 * h; }
        else { const int i = idx >> 1; Arow = KT + (32 * i + l31) * 72 + 8 * h; Brow = TW + (32 * m + l31) * 72 + 8 * h; }
#pragma unroll
        for (int s = 0; s < NKS; ++s) acc = MFMA32(*(const LAS bf16x8*)(Arow + 16 * s), *(const LAS bf16x8*)(Brow + 16 * s), acc);
        if (kind == 0) {
            const int vt = idx & 3; bf16* ub = p.U + (size_t)(cidx * 32 + hv) * 8192;
#pragma unroll
            for (int gq = 0; gq < 4; ++gq) { const int ct = 2 * m + (gq >> 1), vs = 2 * vt + (l31 >> 4), lanep = (l31 & 15) + 16 * (2 * (gq & 1) + h);
                u32x2 w; w.x = pk2(acc[4 * gq], acc[4 * gq + 1]); w.y = pk2(acc[4 * gq + 2], acc[4 * gq + 3]);
                *(u32x2*)(ub + ((ct * 8 + vs) * 64 + lanep) * 4) = w; } }
        else {
            const int i = idx >> 1;
#pragma unroll
            for (int r = 0; r < 16; ++r) acc[r] = -acc[r];
            store_frag16(p.WN + (size_t)(cidx * 32 + hv) * 8192 + (size_t)((2 * m) * 4 + i) * 512, (size_t)4 * 512, acc, lane); }
    }
    WG_BARRIER();
}

template <int C>
__device__ __forceinline__ void gdn_prep_unit(const GdnP& p, LAS unsigned char* lds, int cidx, int hk) {
    const int tid = tid_opaque(); PrepIn<C> in; gdn_prep_fetch<C>(p, cidx, hk, in, tid & 63, RFL(tid >> 6)); gdn_prep_unit<C>(p, lds, cidx, hk, in, -1, 0);
}
constexpr int SCAN_BUF = 61440;
typedef f32x4 acc4;
__device__ __forceinline__ bf16x8 pack_2tiles(const acc4& a, const acc4& b) { return pack8(a[0], a[1], a[2], a[3], b[0], b[1], b[2], b[3]); }
__device__ __forceinline__ void scan_fetch(u32x4 (&v)[15], const GdnP& p, int cidx, int hv, int vt, int tl) {
    const size_t ub = (size_t)(cidx * 32 + hv);
    const u32x4* s0 = (const u32x4*)(p.WN + ub * 8192); const u32x4* s1 = (const u32x4*)(p.QG + ub * 8192);
    const u32x4* s2 = (const u32x4*)(p.KG + ub * 8192); const u32x4* s3 = (const u32x4*)(p.QK + ub * 4096);
#pragma unroll
    for (int i = 0; i < 4; ++i) { v[i] = s0[i * 256 + tl]; v[4 + i] = s1[i * 256 + tl]; v[8 + i] = s2[i * 256 + tl]; }
    v[12] = s3[tl]; v[13] = s3[256 + tl];
    v[14] = ((const u32x4*)(p.U + ub * 8192))[((tl >> 6) * 8 + 2 * vt + ((tl >> 5) & 1)) * 32 + (tl & 31)];
}
__device__ __forceinline__ void scan_put(const u32x4 (&v)[15], LAS unsigned char* buf, int tl) {
#pragma unroll
    for (int i = 0; i < 15; ++i) { *(LAS u32x4*)(buf + (i * 256 + tl) * 16) = v[i]; LOADER_PACE(); }
}
template <int NCT>
__device__ __forceinline__ void scan16_step(acc4 (&S)[8], const LAS unsigned char* buf, int w, float dec, bf16* orow, int lane) {
    constexpr int NKC = NCT / 2;
    const int q = lane >> 4, l15 = lane & 15;
    const LAS bf16x8* WNf = (const LAS bf16x8*)(buf) + lane;
    const LAS bf16x8* QGf = (const LAS bf16x8*)(buf + 16384) + lane;
    const LAS bf16x8* KGf = (const LAS bf16x8*)(buf + 32768) + lane;
    const LAS bf16x8* QKf = (const LAS bf16x8*)(buf + 49152) + lane;
    bf16x8 Sb[4];
#pragma unroll
    for (int ks = 0; ks < 4; ++ks) Sb[ks] = pack_2tiles(S[2 * ks], S[2 * ks + 1]);
    acc4 V[NCT];
#pragma unroll
    for (int ct = 0; ct < NCT; ++ct) { const u32x2 u = *(const LAS u32x2*)(buf + 57344 + (ct * 2 + w) * 512 + lane * 8);
        V[ct][0] = bflo(u.x); V[ct][1] = bfhi(u.x); V[ct][2] = bflo(u.y); V[ct][3] = bfhi(u.y);
#pragma unroll
        for (int ks = 0; ks < 4; ++ks) V[ct] = MFMA16(WNf[(ct * 4 + ks) * 64], Sb[ks], V[ct]); }
    bf16x8 Vb[NKC];
#pragma unroll
    for (int ks = 0; ks < NKC; ++ks) Vb[ks] = pack_2tiles(V[2 * ks], V[2 * ks + 1]);
#pragma unroll
    for (int ct = 0; ct < NCT; ++ct) { acc4 O = (acc4){0.f, 0.f, 0.f, 0.f};
#pragma unroll
        for (int ks = 0; ks < 4; ++ks) O = MFMA16(Sb[ks], QGf[(ct * 4 + ks) * 64], O);
#pragma unroll
        for (int ks = 0; ks <= (ct >> 1); ++ks) O = MFMA16(Vb[ks], QKf[(ct * NKC + ks) * 64], O);
        u32x2 o2; o2.x = pk2(O[0], O[1]); o2.y = pk2(O[2], O[3]);
        *(u32x2*)(orow + (size_t)(16 * ct + l15) * PPITCH + 4 * q) = o2; }
#pragma unroll
    for (int t = 0; t < 8; ++t) { S[t] = S[t] * dec;
#pragma unroll
        for (int ks = 0; ks < NKC; ++ks) S[t] = MFMA16(KGf[(t * NKC + ks) * 64], Vb[ks], S[t]); }
}
#define SCAN_LD4(dst, p0, p1, p2, p3) do { SCHED_FENCE(); dst[0] = (p0); dst[1] = (p1); dst[2] = (p2); dst[3] = (p3); SCHED_FENCE(); } while (0)
#define SCAN_LD(dst, ...) SCAN_LD4(dst, __VA_ARGS__)
__device__ __forceinline__ void scan16_step2(acc4 (&S)[8], const LAS unsigned char* buf, int w, float dec, bf16* orow, int lane) {
    const int q = lane >> 4, l15 = lane & 15;
    const LAS bf16x8* WNf = (const LAS bf16x8*)(buf) + lane;
    const LAS bf16x8* QGf = (const LAS bf16x8*)(buf + 16384) + lane;
    const LAS bf16x8* KGf = (const LAS bf16x8*)(buf + 32768) + lane;
    const LAS bf16x8* QKf = (const LAS bf16x8*)(buf + 49152) + lane;
#define WN_(ct, ks) WNf[((ct) * 4 + (ks)) * 64]
#define QG_(ct, ks) QGf[((ct) * 4 + (ks)) * 64]
#define KG_(t, ks) KGf[((t) * 2 + (ks)) * 64]
#define QK_(ct, ks) QKf[((ct) * 2 + (ks)) * 64]
#define V_GRP(Fc, ks) do { _Pragma("unroll") for (int ct = 0; ct < 4; ++ct) V[ct] = MFMA16(Fc[ct], Sb[ks], V[ct]); } while (0)
#define Q_GRP(Fc, ks) do { _Pragma("unroll") for (int ct = 0; ct < 4; ++ct) O[ct] = MFMA16(Sb[ks], Fc[ct], O[ct]); } while (0)
    bf16x8 F[6][4];
    u32x2 uu[4];
#pragma unroll
    for (int ct = 0; ct < 4; ++ct) uu[ct] = *(const LAS u32x2*)(buf + 57344 + (ct * 2 + w) * 512 + lane * 8);
    SCAN_LD(F[0], WN_(0, 0), WN_(1, 0), WN_(2, 0), WN_(3, 0));
    SCAN_LD(F[1], WN_(0, 1), WN_(1, 1), WN_(2, 1), WN_(3, 1));
    SCAN_LD(F[2], WN_(0, 2), WN_(1, 2), WN_(2, 2), WN_(3, 2));
    SCAN_LD(F[3], WN_(0, 3), WN_(1, 3), WN_(2, 3), WN_(3, 3));
    SCAN_LD(F[4], QG_(0, 0), QG_(1, 0), QG_(2, 0), QG_(3, 0));
    bf16x8 Sb[4];
    Sb[0] = pack_2tiles(S[0], S[1]); Sb[1] = pack_2tiles(S[2], S[3]); Sb[2] = pack_2tiles(S[4], S[5]); Sb[3] = pack_2tiles(S[6], S[7]);
    acc4 V[4], O[4];
#pragma unroll
    for (int ct = 0; ct < 4; ++ct) { V[ct][0] = bflo(uu[ct].x); V[ct][1] = bfhi(uu[ct].x); V[ct][2] = bflo(uu[ct].y); V[ct][3] = bfhi(uu[ct].y); O[ct] = (acc4){0.f, 0.f, 0.f, 0.f}; }
    bf16x8 Vb0, Vb1;
    SCAN_LD(F[5], QG_(0, 1), QG_(1, 1), QG_(2, 1), QG_(3, 1));
    V_GRP(F[0], 0);
    SCAN_LD(F[0], QG_(0, 2), QG_(1, 2), QG_(2, 2), QG_(3, 2));
    V_GRP(F[1], 1);
    SCAN_LD(F[1], QG_(0, 3), QG_(1, 3), QG_(2, 3), QG_(3, 3));
    V_GRP(F[2], 2);
    SCAN_LD(F[2], QK_(0, 0), QK_(1, 0), QK_(2, 0), QK_(3, 0));
    V_GRP(F[3], 3);
    SCAN_LD(F[3], QK_(2, 1), QK_(3, 1), KG_(0, 0), KG_(1, 0));
    Q_GRP(F[4], 0);
    Vb0 = pack_2tiles(V[0], V[1]); Vb1 = pack_2tiles(V[2], V[3]);
    SCAN_LD(F[4], KG_(2, 0), KG_(3, 0), KG_(4, 0), KG_(5, 0));
    Q_GRP(F[5], 1);
    SCAN_LD(F[5], KG_(6, 0), KG_(7, 0), KG_(0, 1), KG_(1, 1));
    Q_GRP(F[0], 2);
    SCAN_LD(F[0], KG_(2, 1), KG_(3, 1), KG_(4, 1), KG_(5, 1));
    Q_GRP(F[1], 3);
    SCAN_LD(F[1], KG_(6, 1), KG_(7, 1), KG_(6, 1), KG_(7, 1));
    _Pragma("unroll") for (int ct = 0; ct < 4; ++ct) O[ct] = MFMA16(Vb0, F[2][ct], O[ct]);
    _Pragma("unroll") for (int t = 0; t < 8; ++t) S[t] = S[t] * dec;
    O[2] = MFMA16(Vb1, F[3][0], O[2]); O[3] = MFMA16(Vb1, F[3][1], O[3]); S[0] = MFMA16(F[3][2], Vb0, S[0]); S[1] = MFMA16(F[3][3], Vb0, S[1]);
    S[2] = MFMA16(F[4][0], Vb0, S[2]); S[3] = MFMA16(F[4][1], Vb0, S[3]); S[4] = MFMA16(F[4][2], Vb0, S[4]); S[5] = MFMA16(F[4][3], Vb0, S[5]);
    _Pragma("unroll") for (int ct = 0; ct < 4; ++ct) { u32x2 o2; o2.x = pk2(O[ct][0], O[ct][1]); o2.y = pk2(O[ct][2], O[ct][3]); *(u32x2*)(orow + (size_t)(16 * ct + l15) * PPITCH + 4 * q) = o2; }
    S[6] = MFMA16(F[5][0], Vb0, S[6]); S[7] = MFMA16(F[5][1], Vb0, S[7]); S[0] = MFMA16(F[5][2], Vb1, S[0]); S[1] = MFMA16(F[5][3], Vb1, S[1]);
    S[2] = MFMA16(F[0][0], Vb1, S[2]); S[3] = MFMA16(F[0][1], Vb1, S[3]); S[4] = MFMA16(F[0][2], Vb1, S[4]); S[5] = MFMA16(F[0][3], Vb1, S[5]);
    S[6] = MFMA16(F[1][0], Vb1, S[6]); S[7] = MFMA16(F[1][1], Vb1, S[7]);
#undef WN_
#undef QG_
#undef KG_
#undef QK_
#undef V_GRP
#undef Q_GRP
}
template <int NM>
__device__ __forceinline__ void gdn_scan_unit(const GdnP& p, LAS unsigned char* lds, int hv, int vt, int cidx0, int nsteps, const float* s_init, float* s_out, int row0) {
    const int tid = tid_opaque(), lane = tid & 63, wid = RFL(tid >> 6), q = lane >> 4, l15 = lane & 15;
    if (wid < 2) {
        const int vcol = 32 * vt + 16 * wid + l15;
        acc4 S[8];
#pragma unroll
        for (int t = 0; t < 8; ++t)
#pragma unroll
            for (int r = 0; r < 4; ++r) S[t][r] = s_init ? s_init[(size_t)(16 * t + 4 * q + r) * 128 + vcol] : 0.f;
        float dreg[4];
#pragma unroll
        for (int i = 0; i < 4; ++i) { const int ti = 64 * i + lane; dreg[i] = ti < nsteps ? p.DEC[(cidx0 + ti) * 32 + hv] : 0.f; }
        WG_BARRIER();
#pragma unroll 1
        for (int t = 0; t < nsteps; ++t) {
            const int tq = t >> 6; const float dsel = tq == 0 ? dreg[0] : (tq == 1 ? dreg[1] : (tq == 2 ? dreg[2] : dreg[3]));
            const float dec = READLANE_F(dsel, t & 63);
            bf16* orow = p.o + (size_t)(row0 + 32 * NM * t) * PPITCH + hv * 128 + 32 * vt + 16 * wid;
            if constexpr (NM == 2) scan16_step2(S, lds + (t & 1) * SCAN_BUF, wid, dec, orow, lane);
            else scan16_step<2 * NM>(S, lds + (t & 1) * SCAN_BUF, wid, dec, orow, lane);
            WG_BARRIER();
        }
#pragma unroll
        for (int t = 0; t < 8; ++t)
#pragma unroll
            for (int r = 0; r < 4; ++r) s_out[(size_t)(16 * t + 4 * q + r) * 128 + vcol] = S[t][r];
    } else if (wid < 4) {
        WG_BARRIER();
#pragma unroll 1
        for (int t = 0; t < nsteps; ++t) WG_BARRIER();
    } else {
        const int tl = tid - 256; u32x4 la[15], lb[15];
        const int clast = cidx0 + nsteps - 1;
        scan_fetch(la, p, cidx0, hv, vt, tl); scan_put(la, lds, tl);
        if (nsteps > 1) {
            scan_fetch(la, p, cidx0 + 1, hv, vt, tl);
            scan_fetch(lb, p, (cidx0 + 2 < clast ? cidx0 + 2 : clast), hv, vt, tl);
        }
        WG_BARRIER();
        if (nsteps > 1) {
#pragma unroll 1
            for (int t = 0; t < nsteps; t += 2) {
                scan_put(la, lds + SCAN_BUF, tl); { const int cn = cidx0 + t + 3; scan_fetch(la, p, cn < clast ? cn : clast, hv, vt, tl); }
                WG_BARRIER();
                scan_put(lb, lds, tl); { const int cn = cidx0 + t + 4; scan_fetch(lb, p, cn < clast ? cn : clast, hv, vt, tl); }
                WG_BARRIER();
            }
        } else WG_BARRIER();
    }
}

__device__ __forceinline__ void gdn_gate_row(const bf16* prow  , const float* wnorm, bf16* og  , int lane) {
    const u32x4* o4 = (const u32x4*)prow + lane; const u32x4* z4 = (const u32x4*)(prow + GQKV) + lane;
    const f32x4* w4 = (const f32x4*)(wnorm + 8 * (lane & 15));
    const f32x4 wa = w4[0], wb = w4[1];
    u32x4* d4 = (u32x4*)og + lane;
#pragma unroll 1
    for (int qh = 0; qh < 2; ++qh) {
        u32x4 ow[4], zw[4];
#pragma unroll
        for (int q = 0; q < 4; ++q) { ow[q] = o4[64 * (4 * qh + q)]; zw[q] = z4[64 * (4 * qh + q)]; }
#pragma unroll
        for (int q = 0; q < 4; ++q) {
            const u32x4 w = ow[q]; const float o0 = bflo(w.x), o1 = bfhi(w.x), o2 = bflo(w.y), o3 = bfhi(w.y), o5 = bfhi(w.z), o4v = bflo(w.z), o6 = bflo(w.w), o7 = bfhi(w.w);
            float ss = (o0 * o0 + o1 * o1) + (o2 * o2 + o3 * o3) + (o4v * o4v + o5 * o5) + (o6 * o6 + o7 * o7);
            ss += __shfl_xor(ss, 1); ss += __shfl_xor(ss, 2); ss += __shfl_xor(ss, 4); ss += __shfl_xor(ss, 8);
            const float r = FAST_RSQ(ss * (1.0f / 128.0f) + EPS);
            const u32x4 z = zw[q]; u32x4 d;
            d.x = pk2(o0 * r * wa.x * siluf_(bflo(z.x)), o1 * r * wa.y * siluf_(bfhi(z.x)));
            d.y = pk2(o2 * r * wa.z * siluf_(bflo(z.y)), o3 * r * wa.w * siluf_(bfhi(z.y)));
            d.z = pk2(o4v * r * wb.x * siluf_(bflo(z.z)), o5 * r * wb.y * siluf_(bfhi(z.z)));
            d.w = pk2(o6 * r * wb.z * siluf_(bflo(z.w)), o7 * r * wb.w * siluf_(bfhi(z.w)));
            d4[64 * (4 * qh + q)] = d; }
    }
}

__device__ __forceinline__ void gdn_gate_rows(const bf16* proj, const float* wnorm, bf16* og, int gw, int NGW, int lane) {
    const f32x4* w4 = (const f32x4*)(wnorm + 8 * (lane & 15)); const f32x4 wa = w4[0], wb = w4[1];
    u32x4 ow[4], zw[4], on[4], zn[4];
    int m = gw, qh = 0;
    if (m < MTOK) { const u32x4* o4 = (const u32x4*)(proj + (size_t)m * PPITCH) + lane; const u32x4* z4 = (const u32x4*)(proj + (size_t)m * PPITCH + GQKV) + lane;
#pragma unroll
        for (int q = 0; q < 4; ++q) { ow[q] = o4[64 * q]; zw[q] = z4[64 * q]; } }
#pragma unroll 1
    while (m < MTOK) {
        const int mn = qh ? m + NGW : m, qn = qh ^ 1;
        if (mn < MTOK) { const u32x4* o4 = (const u32x4*)(proj + (size_t)mn * PPITCH) + lane; const u32x4* z4 = (const u32x4*)(proj + (size_t)mn * PPITCH + GQKV) + lane;
#pragma unroll
            for (int q = 0; q < 4; ++q) { on[q] = o4[64 * (4 * qn + q)]; zn[q] = z4[64 * (4 * qn + q)]; } }
        u32x4* d4 = (u32x4*)(og + (size_t)m * GZ) + lane;
#pragma unroll
        for (int q = 0; q < 4; ++q) {
            const u32x4 w = ow[q]; const float o0 = bflo(w.x), o1 = bfhi(w.x), o2 = bflo(w.y), o3 = bfhi(w.y), o5 = bfhi(w.z), o4v = bflo(w.z), o6 = bflo(w.w), o7 = bfhi(w.w);
            float ss = (o0 * o0 + o1 * o1) + (o2 * o2 + o3 * o3) + (o4v * o4v + o5 * o5) + (o6 * o6 + o7 * o7);
            ss += __shfl_xor(ss, 1); ss += __shfl_xor(ss, 2); ss += __shfl_xor(ss, 4); ss += __shfl_xor(ss, 8);
            const float r = FAST_RSQ(ss * (1.0f / 128.0f) + EPS);
            const u32x4 z = zw[q]; u32x4 d;
            d.x = pk2(o0 * r * wa.x * siluf_(bflo(z.x)), o1 * r * wa.y * siluf_(bfhi(z.x)));
            d.y = pk2(o2 * r * wa.z * siluf_(bflo(z.y)), o3 * r * wa.w * siluf_(bfhi(z.y)));
            d.z = pk2(o4v * r * wb.x * siluf_(bflo(z.z)), o5 * r * wb.y * siluf_(bfhi(z.z)));
            d.w = pk2(o6 * r * wb.z * siluf_(bflo(z.w)), o7 * r * wb.w * siluf_(bfhi(z.w)));
            d4[64 * (4 * qh + q)] = d; }
#pragma unroll
        for (int q = 0; q < 4; ++q) { ow[q] = on[q]; zw[q] = zn[q]; }
        m = mn; qh = qn;
    }
}
struct AttP {
    const bf16* qkv;
    const float* cache_k;
    const float* cache_v;
    const float* relb;
    bf16* ao;
};
constexpr int AL_K = 0, AL_VT = 17408, AL_VP = 160, AL_TILE = AL_VT + 64 * AL_VP * 2, AL_BIAS = 2 * AL_TILE, AL_END = AL_BIAS + 2064;
constexpr int QKVP = 6144;
constexpr float ATT_SCALE = 0.08838834764831845f;

struct AttTileRegs { u32x4 k[2], v[2]; };
__device__ __forceinline__ void att_load_bf16(AttTileRegs& R, const bf16* krow0, const bf16* vrow0, size_t pitch, int nkeys, int tid) {
#pragma unroll
    for (int i = 0; i < 2; ++i) { const int id = tid + 512 * i, key = id >> 4, part = id & 15;
        R.k[i] = key < nkeys ? *(const u32x4*)(krow0 + (size_t)key * pitch + part * 8) : (u32x4){0u, 0u, 0u, 0u};
        R.v[i] = key < nkeys ? *(const u32x4*)(vrow0 + (size_t)key * pitch + part * 8) : (u32x4){0u, 0u, 0u, 0u}; }
}
__device__ __forceinline__ void att_load_f32(AttTileRegs& R, const float* krow0, const float* vrow0, size_t pitch, int tid) {
#pragma unroll
    for (int i = 0; i < 2; ++i) { const int id = tid + 512 * i, key = id >> 4, part = id & 15;
        const f32x4* ks = (const f32x4*)(krow0 + (size_t)key * pitch + part * 8); const f32x4* vs = (const f32x4*)(vrow0 + (size_t)key * pitch + part * 8);
        const f32x4 a = ks[0], b = ks[1], c = vs[0], d = vs[1];
        R.k[i] = (u32x4){pk2(a.x, a.y), pk2(a.z, a.w), pk2(b.x, b.y), pk2(b.z, b.w)};
        R.v[i] = (u32x4){pk2(c.x, c.y), pk2(c.z, c.w), pk2(d.x, d.y), pk2(d.z, d.w)}; }
}
__device__ __forceinline__ void att_store_tile(const AttTileRegs& R, LAS unsigned char* lds, int tid) {
    LAS bf16* K = (LAS bf16*)(lds + AL_K); LAS bf16* V = (LAS bf16*)(lds + AL_VT);
#pragma unroll
    for (int i = 0; i < 2; ++i) { const int id = tid + 512 * i, key = id >> 4, part = id & 15;
        *(LAS u32x4*)(K + key * 136 + part * 8) = R.k[i];
        *(LAS u32x4*)(V + key * AL_VP + part * 8) = R.v[i]; }
}
struct AttState { f32x16 OT[4]; float m, l; };
constexpr float ATT_C1 = ATT_SCALE * 1.4426950408889634f;
constexpr float ATT_DEFER = 8.0f;
template <int NSUB>
__device__ __forceinline__ void att_tile(AttState& st, const bf16x8 (&qf)[8], const LAS unsigned char* lds, const LAS unsigned char* ldsb, int rel0, int lane, int nvalid = 64) {
    const int h = lane >> 5, l31 = lane & 31;
    const LAS bf16* K = (const LAS bf16*)(lds + AL_K); const LAS bf16* V = (const LAS bf16*)(lds + AL_VT); const LAS float* bias = (const LAS float*)(ldsb + AL_BIAS);
    f32x16 sc[NSUB]; float mx = -1e30f;
#pragma unroll
    for (int sub = 0; sub < NSUB; ++sub) {
#pragma unroll
        for (int r = 0; r < 16; ++r) sc[sub][r] = 0.f;
        const LAS bf16* Arow = K + (32 * sub + l31) * 136 + 8 * h;
#pragma unroll
        for (int s = 0; s < 8; ++s) sc[sub] = MFMA32(*(const LAS bf16x8*)(Arow + 16 * s), qf[s], sc[sub]);
        if (rel0 - 63 >= MAXREL) {
            const float bc = bias[2 * MAXREL];
#pragma unroll
            for (int r = 0; r < 16; ++r) { const float x = sc[sub][r] * ATT_C1 + bc; sc[sub][r] = x; mx = fmaxf(mx, x); }
        } else {
#pragma unroll
            for (int r = 0; r < 16; ++r) { int rel = rel0 + l31 - (32 * sub + accrow(r, h)); rel = rel < -MAXREL ? -MAXREL : (rel > MAXREL ? MAXREL : rel);
                const float x = sc[sub][r] * ATT_C1 + bias[rel + MAXREL]; sc[sub][r] = x; mx = fmaxf(mx, x); }
        }
    }
    if (nvalid < 64) {
        mx = -1e30f;
#pragma unroll
        for (int sub = 0; sub < NSUB; ++sub)
#pragma unroll
            for (int r = 0; r < 16; ++r) { if (32 * sub + accrow(r, h) >= nvalid) sc[sub][r] = -1e30f; mx = fmaxf(mx, sc[sub][r]); }
    }
    mx = fmaxf(mx, __shfl_xor(mx, 32));
    if (ANY_LANE(mx > st.m + ATT_DEFER)) {
        const float mnew = fmaxf(st.m, mx), alpha = FAST_EXP2(st.m - mnew);
        st.m = mnew; st.l *= alpha;
#pragma unroll
        for (int dt = 0; dt < 4; ++dt)
#pragma unroll
            for (int r = 0; r < 16; ++r) st.OT[dt][r] *= alpha;
    }
    const float mcur = st.m; float ps = 0.f;
#pragma unroll
    for (int sub = 0; sub < NSUB; ++sub)
#pragma unroll
        for (int r = 0; r < 16; ++r) { const float pv = FAST_EXP2(sc[sub][r] - mcur); sc[sub][r] = pv; ps += pv; }
    st.l += ps;
#pragma unroll
    for (int sub = 0; sub < NSUB; ++sub) {
        const bf16x8 pf0 = acc_frag(sc[sub], 0), pf1 = acc_frag(sc[sub], 1);
        const LAS bf16* vblk = V + (32 * sub + 4 * h + ((lane & 15) >> 2)) * AL_VP + 16 * ((lane >> 4) & 1) + 4 * (lane & 3);
#pragma unroll
        for (int dt = 0; dt < 4; ++dt) {
            const LAS bf16* vb = vblk + 32 * dt;
            u32x4 a0, a1; { const u32x2 x = LDS_TR16(vb), y = LDS_TR16(vb + 8 * AL_VP); a0 = (u32x4){x.x, x.y, y.x, y.y}; }
            { const u32x2 x = LDS_TR16(vb + 16 * AL_VP), y = LDS_TR16(vb + 24 * AL_VP); a1 = (u32x4){x.x, x.y, y.x, y.y}; }
            st.OT[dt] = MFMA32(__builtin_bit_cast(bf16x8, a0), pf0, st.OT[dt]);
            st.OT[dt] = MFMA32(__builtin_bit_cast(bf16x8, a1), pf1, st.OT[dt]);
        }
    }
}
__device__ __forceinline__ void att_init(AttState& st) {
#pragma unroll
    for (int dt = 0; dt < 4; ++dt)
#pragma unroll
        for (int r = 0; r < 16; ++r) st.OT[dt][r] = 0.f;
    st.m = -1e30f; st.l = 0.f;
}
__device__ __forceinline__ void att_load_q(bf16x8 (&qf)[8], const bf16* qrow  , int h) {
#pragma unroll
    for (int s = 0; s < 8; ++s) qf[s] = *(const bf16x8*)(qrow + 16 * s + 8 * h);
}
__device__ __forceinline__ void att_finish(AttState& st, bf16* orow  , int h) {
    const float lt = st.l + __shfl_xor(st.l, 32); const float inv = 1.0f / lt;
#pragma unroll
    for (int dt = 0; dt < 4; ++dt)
#pragma unroll
        for (int g = 0; g < 4; ++g) { u32x2 w; w.x = pk2(st.OT[dt][4 * g] * inv, st.OT[dt][4 * g + 1] * inv); w.y = pk2(st.OT[dt][4 * g + 2] * inv, st.OT[dt][4 * g + 3] * inv);
            *(u32x2*)(orow + 32 * dt + 8 * g + 4 * h) = w; }
}
__device__ __forceinline__ void att_load_bias(const AttP& p, LAS unsigned char* lds, int head, int tid) {
    LAS float* bias = (LAS float*)(lds + AL_BIAS);
    for (int i = tid; i < 2 * MAXREL + 1; i += 512) bias[i] = p.relb[head * (2 * MAXREL + 1) + i] * 1.4426950408889634f;
}
__device__ __forceinline__ void att_prompt_unit(const AttP& p, LAS unsigned char* lds, int g4, int head) {
    const int tid = tid_opaque(), lane = tid & 63, wid = RFL(tid >> 6), h = lane >> 5, l31 = lane & 31;
    const int cq = 4 * g4 + (wid >> 1), q0 = 64 * cq + 32 * (wid & 1);
    att_load_bias(p, lds, head, tid);
    bf16x8 qf[8]; att_load_q(qf, p.qkv + (size_t)(q0 + l31) * QKVP + head * 128, h);
    AttState st; att_init(st);
    const int kc0 = (4 * g4 - 8) > 0 ? (4 * g4 - 8) : 0, kc1 = 4 * g4 + 3;
    AttTileRegs R;
    att_load_bf16(R, p.qkv + (size_t)(64 * kc0) * QKVP + 2048 + head * 128, p.qkv + (size_t)(64 * kc0) * QKVP + 4096 + head * 128, QKVP, 64, tid);
    att_store_tile(R, lds, tid);
    WG_BARRIER();
    for (int kc = kc0; kc <= kc1; ++kc) {
        const int cur = (kc - kc0) & 1;
        if (kc < kc1) att_load_bf16(R, p.qkv + (size_t)(64 * (kc + 1)) * QKVP + 2048 + head * 128, p.qkv + (size_t)(64 * (kc + 1)) * QKVP + 4096 + head * 128, QKVP, 64, tid);
        if (kc >= cq - 8 && kc <= cq) att_tile<2>(st, qf, lds + cur * AL_TILE, lds, q0 - 64 * kc, lane);
        if (kc < kc1) att_store_tile(R, lds + (cur ^ 1) * AL_TILE, tid);
        WG_BARRIER();
    }
    att_finish(st, p.ao + (size_t)(q0 + l31) * DM + head * 128, h);
}
__device__ __forceinline__ void att_sample_unit(const AttP& p, LAS unsigned char* lds, int b, int head) {
    const int tid = tid_opaque(), lane = tid & 63, wid = RFL(tid >> 6), h = lane >> 5, l31 = lane & 31;
    const int row0 = SEQ + 32 * b;
    att_load_bias(p, lds, head, tid);
    bf16x8 qf[8]; AttState st;
    if (wid == 0) { att_load_q(qf, p.qkv + (size_t)(row0 + l31) * QKVP + head * 128, h); att_init(st); }
    const float* ck = p.cache_k + ((size_t)b * 512 * 16 + head) * 128; const float* cv = p.cache_v + ((size_t)b * 512 * 16 + head) * 128;
    AttTileRegs R;
    att_load_f32(R, ck, cv, 2048, tid);
    att_store_tile(R, lds, tid);
    WG_BARRIER();
    for (int t = 0; t < 9; ++t) {
        const int cur = t & 1;
        if (t < 7) att_load_f32(R, ck + (size_t)(64 * (t + 1)) * 2048, cv + (size_t)(64 * (t + 1)) * 2048, 2048, tid);
        else if (t == 7) att_load_bf16(R, p.qkv + (size_t)row0 * QKVP + 2048 + head * 128, p.qkv + (size_t)row0 * QKVP + 4096 + head * 128, QKVP, 32, tid);
        if (wid == 0) att_tile<2>(st, qf, lds + cur * AL_TILE, lds, 512 - 64 * t, lane, t < 8 ? 64 : 32);
        if (t < 8) att_store_tile(R, lds + (cur ^ 1) * AL_TILE, tid);
        WG_BARRIER();
    }
    if (wid == 0) att_finish(st, p.ao + (size_t)(row0 + l31) * DM + head * 128, h);
}
#ifndef EMU
constexpr size_t MiB = 1u << 20;
constexpr size_t WS_CTL = 0, CTL_ZERO_BYTES = 1 * MiB;
constexpr size_t WS_BA = 1 * MiB;
constexpr size_t WS_DEC = 6 * MiB;
constexpr size_t WS_WIN = 7 * MiB;
constexpr size_t WS_WOUT = WS_WIN + 49 * MiB;
constexpr size_t WS_WGU = WS_WOUT + 16 * MiB;
constexpr size_t WS_WDN = WS_WGU + 44 * MiB;
constexpr size_t WS_XB = WS_WDN + 22 * MiB;
constexpr size_t WS_PROJ = WS_XB + 66 * MiB;
constexpr size_t WS_U = WS_PROJ + 396 * MiB;
constexpr size_t WS_WN = WS_U + 136 * MiB, WS_QG = WS_WN + 136 * MiB, WS_KG = WS_QG + 136 * MiB, WS_QK = WS_KG + 136 * MiB;
constexpr size_t WS_WIN_B = WS_QK + 68 * MiB;
constexpr size_t WS_WOUT_B = WS_WIN_B + 24 * MiB, WS_WGU_B = WS_WOUT_B + 8 * MiB, WS_WDN_B = WS_WGU_B + 44 * MiB;
constexpr size_t WS_SL = WS_WDN_B + 22 * MiB;
constexpr size_t WS_END = WS_SL + 2 * MiB;
constexpr size_t WS_R = WS_DEC + MiB / 2;
template <int layer> struct WB { static constexpr size_t WIN = (layer & 1) ? WS_WIN_B : WS_WIN, WOUT = (layer & 1) ? WS_WOUT_B : WS_WOUT, WGU = (layer & 1) ? WS_WGU_B : WS_WGU, WDN = (layer & 1) ? WS_WDN_B : WS_WDN; };
static_assert((size_t)GPROJ_PAD * DM * 2 <= 49 * MiB && (size_t)MTOK * DM * 2 <= 66 * MiB && (size_t)MTOK * PPITCH * 2 <= 396 * MiB && (size_t)NCIDX * 32 * 8192 * 2 <= 136 * MiB && (size_t)MTOK * 4096 * 2 <= 136 * MiB, "ws map");
constexpr int CW_BAR = 4096;
constexpr int LDS_MISC = 133120, LDS_ARGS = LDS_MISC + 64, LDS_BYTES = LDS_MISC + 512;
static_assert(PL_END <= LDS_MISC && 2 * SCAN_BUF <= LDS_MISC && AL_END <= LDS_MISC && 8 * WT_SCR <= LDS_MISC && pg8::STAGE_BYTES <= LDS_MISC, "LDS map");
constexpr size_t O_YP = 0, O_YS = 33554432, O_PREC = 34603008, O_PCONV = 35651584, O_PK = 35700736, O_PV = 37797888, O_SREC = 39895040, O_SCONV = 56672256, O_SK = 57458688, O_SV = 59555840, O_END = 61652992;

struct KArgs { const float* in[23]; float* out; unsigned char* ws; };
__device__ __forceinline__ unsigned long long ldarg_u64(LAS unsigned char* lds, int i) {
    volatile LAS unsigned* p = (volatile LAS unsigned*)(lds + LDS_ARGS) + 2 * i; const unsigned lo = RFL(p[0]), hi = RFL(p[1]); return ((unsigned long long)hi << 32) | lo; }
#define ARGF(i) ((const float*)ldarg_u64(lds, (i)))
#define ARGOUT() ((float*)ldarg_u64(lds, 23))
#define ARGWS() ((unsigned char*)ldarg_u64(lds, 24))
#define XHP() ((bf16*)(ARGOUT() + (size_t)SEQ * DM / 2))

#ifndef PROBE_REP_GEMM
#define PROBE_REP_GEMM 0
#endif
#ifndef PROBE_REP_GDN
#define PROBE_REP_GDN 0
#endif
#ifndef PROBE_REP_PREP
#define PROBE_REP_PREP PROBE_REP_GDN
#endif
#ifndef PROBE_REP_SCAN
#define PROBE_REP_SCAN PROBE_REP_GDN
#endif
#ifndef PROBE_REP_GATE
#define PROBE_REP_GATE PROBE_REP_GDN
#endif
#ifndef PROBE_REP_ATT
#define PROBE_REP_ATT 0
#endif
#ifndef PROBE_REP_THIN
#define PROBE_REP_THIN 0
#endif
#define PHASE_IDS() int G = G0, bid = bid0; LAS unsigned char* lds = lds0; asm volatile("" : "+s"(G), "+s"(bid), "+s"(lds)); const int tidp = tid_opaque(), lane = tidp & 63, wid = RFL(tidp >> 6), gw = bid * 8 + wid, NGW = G * 8; (void)lane; (void)gw; (void)NGW; (void)tidp
#define GRID_BAR() do { XcdBarrier b_ = bar; unsigned* bp_ = b_.bar; unsigned bx_ = b_.x; asm volatile("" : "+s"(bp_), "+s"(bx_)); b_.bar = bp_; b_.x = bx_; xcd_barrier(b_); } while (0)
#define WSP(T, off) ((T*)(ARGWS() + (off)))
#define PHASE_FN template <int layer> __device__ __forceinline__ void
#define PHASE_ARGS LAS unsigned char* const lds0, const int G0, const int bid0
template <int layer> __device__ __forceinline__ WtItem conv_item(LAS unsigned char* lds, int r) {
    constexpr int L_ = layer, J_ = layer >> 1;
#define WT_JOB(Wp, WTp, Kv, Nv, modev, scl) { const WtJob jb{(Wp), (WTp), (Kv), (Nv), (modev), (scl)}; const int nj = wt_items(jb); if (r < nj) return wt_item_of(jb, r); r -= nj; }
    if (L_ & 1) { WT_JOB(ARGF(15) + (size_t)J_ * DM * 3 * DM, WSP(bf16, WB<layer>::WIN), DM, 3 * DM, 0, ARGF(6) + (size_t)L_ * DM) WT_JOB(ARGF(18) + (size_t)J_ * DM * DM, WSP(bf16, WB<layer>::WOUT), DM, DM, 0, nullptr) }
    else { WT_JOB(ARGF(9) + (size_t)J_ * DM * GPROJ, WSP(bf16, WB<layer>::WIN), DM, GPROJ, 0, ARGF(6) + (size_t)L_ * DM) WT_JOB(ARGF(14) + (size_t)J_ * GZ * DM, WSP(bf16, WB<layer>::WOUT), GZ, DM, 0, nullptr) }
    WT_JOB(ARGF(20) + (size_t)L_ * DM * DFF, WSP(bf16, WB<layer>::WGU), DM, DFF, 1, ARGF(7) + (size_t)L_ * DM) WT_JOB(ARGF(21) + (size_t)L_ * DM * DFF, WSP(bf16, WB<layer>::WGU), DM, DFF, 2, ARGF(7) + (size_t)L_ * DM)
    { const WtJob jb{ARGF(22) + (size_t)L_ * DFF * DM, WSP(bf16, WB<layer>::WDN), DFF, DM, 0, nullptr}; return wt_item_of(jb, r); }
#undef WT_JOB
}
#ifndef CONV_PACE
#define CONV_PACE 64
#endif
template <int layer, int PART, bool PACED = false> __device__ __forceinline__ void convert_layer(LAS unsigned char* lds, int gwr, int nw, int wid, int lane, int tlin, int ntlin) {
    constexpr int nffn = 3 * (DM / 64) * (DFF / 64); constexpr int nmix = (layer & 1) ? (DM / 64) * (3 * DM / 64) + (DM / 64) * (DM / 64) : (DM / 64) * (GPROJ / 64) + (GZ / 64) * (DM / 64);
    constexpr int nfirst = (layer & 1) ? (DM / 64) * (3 * DM / 64) : (DM / 64) * (GPROJ / 64);
    constexpr int ibeg = PART == 1 ? nfirst : 0, iend = PART == 0 ? nfirst : nffn + nmix;
    LAS float* scr = (LAS float*)(lds + wid * WT_SCR);
    int it = ibeg + gwr; f32x4 va[16], vb[16]; float sa = 1.f, sb = 1.f;
    if (it < iend) { const WtItem I = conv_item<layer>(lds, it); wt_load(I, va, sa, lane); }
#pragma unroll 1
    while (it < iend) {
        const int nx = it + nw; const bool more = nx < iend;
        if (more) { const WtItem N = conv_item<layer>(lds, nx); wt_load(N, vb, sb, lane); }
        { const WtItem I = conv_item<layer>(lds, it); wt_store(I, va, sa, scr, lane); }
        if constexpr (PACED && CONV_PACE > 0) __builtin_amdgcn_s_sleep(CONV_PACE);
#pragma unroll
        for (int i = 0; i < 16; ++i) va[i] = vb[i];
        sa = sb;
        it = nx;
    }
    if (!(layer & 1) && PART != 1) { u32x4* z = (u32x4*)(WSP(bf16, WB<layer>::WIN) + (size_t)GPROJ * DM); const int nz = (GPROJ_PAD - GPROJ) * DM * 2 / 16; for (int i = tlin; i < nz; i += ntlin) z[i] = (u32x4){0u, 0u, 0u, 0u}; }
}
PHASE_FN ph_convert(PHASE_ARGS) { PHASE_IDS(); convert_layer<layer, 0>(lds, gw, NGW, wid, lane, bid * 512 + tidp, G * 512); }
PHASE_FN ph_rms_in(PHASE_ARGS) {
    PHASE_IDS(); const float* xp = ARGF(0); const float* xs = ARGF(1); float* xres = ARGOUT(); bf16* XB = WSP(bf16, WS_XB);
    cvt_rows(xp, nullptr, XHP(), WSP(float, WS_R), SEQ, gw, NGW, lane);
    cvt_rows(xs, xres + (size_t)SEQ * DM, XB + (size_t)SEQ * DM, WSP(float, WS_R) + SEQ, DECB * DECS, NGW - 1 - gw, NGW, lane);
}
PHASE_FN ph_smp(PHASE_ARGS) {
    PHASE_IDS(); const float* xres = ARGOUT(); bf16* XB = WSP(bf16, WS_XB);
    cvt_rows(xres + (size_t)SEQ * DM, nullptr, XB + (size_t)SEQ * DM, WSP(float, WS_R) + SEQ, DECB * DECS, NGW - 1 - gw, NGW, lane);
    slots_to_r(WSP(float, WS_SL), WSP(float, WS_R), SEQ, bid * 512 + tidp, G * 512);
}
__device__ __forceinline__ void ph_final(PHASE_ARGS, const XcdBarrier& bar) {
    PHASE_IDS(); float* xres = ARGOUT(); const float* nw = ARGF(8); const bf16* XH = XHP();
    u32x4 hold[4][4];
#pragma unroll
    for (int i = 0; i < 4; ++i) { const int m = SEQ / 2 + gw + NGW * i; if (m < SEQ) rms_h_load(XH, m, hold[i], lane); }
    rms_rows_h(XH, nw, nullptr, xres, SEQ / 2, gw, NGW, lane);
    rms_rows(xres + (size_t)SEQ * DM, nw, nullptr, nullptr, xres + (size_t)SEQ * DM, DECB * DECS, NGW - 1 - gw, NGW, lane);
    asm volatile("s_waitcnt vmcnt(0)" ::: "memory");
    GRID_BAR();
#pragma unroll
    for (int i = 0; i < 4; ++i) { const int m = SEQ / 2 + gw + NGW * i; if (m < SEQ) rms_h_finish(hold[i], nw, nullptr, xres, m, lane); }
}
PHASE_FN ph_g1(PHASE_ARGS) {
    PHASE_IDS(); pg8::Gemm g{XHP(), WSP(bf16, WB<layer>::WIN), MTOK, GPROJ_PAD, DM, DM, WSP(bf16, WS_XB) + (size_t)SEQ * DM, SEQ / 256, WSP(float, WS_R)}; pg8::StaticOrder S; S.init(MTOK, GPROJ_PAD, G, bid);
    pg8::EpiProj E{WSP(bf16, WS_PROJ), PPITCH, WSP(float, WS_BA), 12288};
    pg8::gemm_phase<pg8::EpiProj, pg8::StaticOrder, true, true, true>(lds, g, S, E);
}
#define MAKE_GDNP(gp) constexpr int j = layer >> 1; const float* in10_ = ARGF(10); const float* in11_ = ARGF(11); const float* in12_ = ARGF(12); const float* in3_ = ARGF(3); const float* in2_ = ARGF(2); float* out_ = ARGOUT(); unsigned char* ws_ = ARGWS(); \
        const GdnP gp{(const bf16*)(ws_ + WS_PROJ), (const float*)(ws_ + WS_BA), in10_ + (size_t)j * 4 * GQKV, in11_ + j * 32, in12_ + j * 32, in3_ + (size_t)j * DECB * 3 * GQKV, in2_ + (size_t)j * DECB * HV * 16384, \
                out_ + O_PCONV + (size_t)j * 3 * GQKV, out_ + O_SCONV + (size_t)j * DECB * 3 * GQKV, out_ + O_PREC + (size_t)j * HV * 16384, out_ + O_SREC + (size_t)j * DECB * HV * 16384, \
                (bf16*)(ws_ + WS_U), (bf16*)(ws_ + WS_WN), (bf16*)(ws_ + WS_QG), (bf16*)(ws_ + WS_KG), (bf16*)(ws_ + WS_QK), (float*)(ws_ + WS_DEC), (bf16*)(ws_ + WS_PROJ)}
PHASE_FN ph_prep(PHASE_ARGS) {
    PHASE_IDS(); MAKE_GDNP(gp);
    PrepIn<64> in; int u = bid;
    if (u < NCH * HK) gdn_prep_fetch<64>(gp, u >> 4, u & 15, in, lane, wid);
#pragma unroll 1
    for (; u < NCH * HK; u += G) { const int un = u + G; const bool more = un < NCH * HK;
        gdn_prep_unit<64>(gp, lds, u >> 4, u & 15, in, more ? (un >> 4) : -1, un & 15); }
#pragma unroll 1
    for (; u < NCH * HK + DECB * HK; u += G) gdn_prep_unit<32>(gp, lds, NCH + ((u - NCH * HK) >> 4), u & 15);
}
template <int layer, bool CONV> __device__ __forceinline__ void ph_scan_(PHASE_ARGS) {
    PHASE_IDS(); MAKE_GDNP(gp);
    if (bid < 4 * HV) { const int x = bid & 7, q = bid >> 3, hv = x + 8 * (q >> 2), vt = q & 3;
        gdn_scan_unit<2>(gp, lds, hv, vt, 0, NCH, nullptr, gp.out_prec + (size_t)hv * 16384, 0);
#ifdef PROBE_SCAN_TWICE
        gdn_scan_unit<2>(gp, lds, hv, vt, 0, NCH, nullptr, gp.out_prec + (size_t)hv * 16384, 0);
#endif
        }
    else {
#ifdef PROBE_OTHER_TWICE
#pragma unroll 1
      for (int rep_ = 0; rep_ < 2; ++rep_) {
#else
      {
#endif
#pragma unroll 1
        for (int u = bid - 4 * HV; u < DECB * HV * 4; u += G - 4 * HV) { const int b = u >> 7, hv = (u >> 2) & 31, vt = u & 3;
            gdn_scan_unit<1>(gp, lds, hv, vt, NCH + b, 1, gp.rec_state + ((size_t)b * HV + hv) * 16384, gp.out_srec + ((size_t)b * HV + hv) * 16384, SEQ + 32 * b); }
        if constexpr (CONV) {
            convert_layer<layer, 1, true>(lds, (bid - 4 * HV) * 8 + wid, (G - 4 * HV) * 8, wid, lane, (bid - 4 * HV) * 512 + tidp, (G - 4 * HV) * 512);
            if constexpr (layer + 1 < DEPTH) convert_layer<layer + 1, 2, true>(lds, (bid - 4 * HV) * 8 + wid, (G - 4 * HV) * 8, wid, lane, (bid - 4 * HV) * 512 + tidp, (G - 4 * HV) * 512); }
        __syncthreads();
      }
    }
}
PHASE_FN ph_scan(PHASE_ARGS) { ph_scan_<layer, true>(lds0, G0, bid0); }
PHASE_FN ph_scan_noconv(PHASE_ARGS) { ph_scan_<layer, false>(lds0, G0, bid0); }
PHASE_FN ph_gate(PHASE_ARGS) {
    PHASE_IDS(); constexpr int j = layer >> 1; const bf16* PROJ = WSP(bf16, WS_PROJ); bf16* OG = WSP(bf16, WS_U); const float* wn = ARGF(13) + j * 128;
    gdn_gate_rows(PROJ, wn, OG, gw, NGW, lane);
}
template <int KC, int SPL, bool DUMMY, bool FIRST = false> __device__ __forceinline__ void resid_gemm(PHASE_ARGS, size_t a_off, size_t b_off, int bias_arg, size_t bias_off) {
    PHASE_IDS(); pg8::Gemm g{WSP(bf16, a_off), WSP(bf16, b_off), SEQ, DM, KC, KC}; pg8::StaticOrder S; S.init(SEQ, DM, G, bid);
    float* X = DUMMY ? WSP(float, WS_END) : ARGOUT(); const float* bias = bias_arg >= 0 ? ARGF(bias_arg) + bias_off : nullptr;
    pg8::EpiResidH<FIRST> E{DUMMY ? WSP(bf16, WS_END) : XHP(), DM, bias, ARGF(0), WSP(float, WS_SL)};
    pg8::gemm_phase<pg8::EpiResidH<FIRST>, pg8::StaticOrder, true, true>(lds, g, S, E);
    __syncthreads();
    { constexpr int KS = KC / SPL; const int su = bid / SPL, ks = bid - su * SPL;
      pg8::Gemm g2{WSP(bf16, a_off) + ks * KS, WSP(bf16, b_off) + ks * KS, MTOK, DM, KS, KC}; const pg8::SingleUnit S2{64 + (su >> 3), su & 7, bid < 16 * SPL};
      pg8::EpiAtomic E2{X, DM, ks == 0 ? bias : nullptr};
      pg8::gemm_phase<pg8::EpiAtomic, pg8::SingleUnit, false, true>(lds, g2, S2, E2); }
}
template <int layer, bool DUMMY> __device__ __forceinline__ void ph_g5(PHASE_ARGS) { resid_gemm<GZ, 16, DUMMY, layer == 0>(lds0, G0, bid0, WS_U, WB<layer>::WOUT, -1, 0); }
PHASE_FN ph_a1(PHASE_ARGS) {
    PHASE_IDS(); constexpr int j = layer >> 1; pg8::Gemm g{XHP(), WSP(bf16, WB<layer>::WIN), MTOK, 3 * DM, DM, DM, WSP(bf16, WS_XB) + (size_t)SEQ * DM, SEQ / 256, WSP(float, WS_R)}; pg8::StaticOrder S; S.init(MTOK, 3 * DM, G, bid);
    static_assert(O_PV - O_PK == O_SV - O_SK, "k/v output spacing");
    pg8::EpiQkv E{WSP(bf16, WS_PROJ), QKVP, ARGF(16) + (size_t)j * 3 * DM, ARGOUT() + O_PK + (size_t)j * 512 * DM, (long)(O_PV - O_PK), (long)(O_SK - O_PK)};
    pg8::gemm_phase<pg8::EpiQkv, pg8::StaticOrder, true, true, true>(lds, g, S, E);
}
PHASE_FN ph_att(PHASE_ARGS) {
    PHASE_IDS(); constexpr int j = layer >> 1;
    const AttP ap{WSP(bf16, WS_PROJ), ARGF(4) + (size_t)j * DECB * 512 * DM, ARGF(5) + (size_t)j * DECB * 512 * DM, ARGF(17) + (size_t)j * AH * 513, WSP(bf16, WS_XB)};
#pragma unroll 1
    for (int u = bid; u < 64 * AH + DECB * AH; u += G) {
        if (u < 64 * AH) att_prompt_unit(ap, lds, u >> 4, u & 15);
        else att_sample_unit(ap, lds, (u - 64 * AH) >> 4, u & 15);
    }
}
template <int layer, bool DUMMY> __device__ __forceinline__ void ph_a3(PHASE_ARGS) { resid_gemm<DM, 8, DUMMY>(lds0, G0, bid0, WS_XB, WB<layer>::WOUT, 19, (size_t)(layer >> 1) * DM); }
PHASE_FN ph_f1(PHASE_ARGS) {
    PHASE_IDS(); pg8::Gemm g{XHP(), WSP(bf16, WB<layer>::WGU), MTOK, 2 * DFF, DM, DM, WSP(bf16, WS_XB) + (size_t)SEQ * DM, SEQ / 256, WSP(float, WS_R)}; pg8::StaticOrder S; S.init(MTOK, 2 * DFF, G, bid);
    pg8::EpiSwiglu E{WSP(bf16, WS_PROJ), DFF};
    pg8::gemm_phase<pg8::EpiSwiglu, pg8::StaticOrder, true, true, true>(lds, g, S, E);
}
template <int layer, bool DUMMY> __device__ __forceinline__ void ph_f2(PHASE_ARGS) { resid_gemm<DFF, 11, DUMMY>(lds0, G0, bid0, WS_PROJ, WB<layer>::WDN, -1, 0); }

#define PH(call, nrep) do { call(lds0, G0, bid0); GRID_BAR(); if constexpr ((nrep) >= 1) { call(lds0, G0, bid0); GRID_BAR(); } if constexpr ((nrep) >= 2) { call(lds0, G0, bid0); GRID_BAR(); } } while (0)
#define PH_RES(fn, nrep) do { fn<layer, false>(lds0, G0, bid0); GRID_BAR(); if constexpr ((nrep) >= 1) { fn<layer, true>(lds0, G0, bid0); GRID_BAR(); } if constexpr ((nrep) >= 2) { fn<layer, true>(lds0, G0, bid0); GRID_BAR(); } } while (0)
template <int layer>
__device__ __forceinline__ void layer_body(LAS unsigned char* const lds0, const int G0, const int bid0, const XcdBarrier& bar) {
    if constexpr ((layer & 1) == 0) {
        PH(ph_g1<layer>, PROBE_REP_GEMM);
        PH(ph_prep<layer>, PROBE_REP_PREP);
        PH(ph_scan<layer>, 0);
        if constexpr (PROBE_REP_SCAN >= 1) { ph_scan_noconv<layer>(lds0, G0, bid0); GRID_BAR(); }
        PH(ph_gate<layer>, PROBE_REP_GATE);
        PH_RES(ph_g5, PROBE_REP_GEMM);
    } else {
        PH(ph_a1<layer>, PROBE_REP_GEMM);
        PH(ph_att<layer>, PROBE_REP_ATT);
        PH_RES(ph_a3, PROBE_REP_GEMM);
    }
    { constexpr auto f0 = 0; (void)f0; }
    PH(ph_smp<layer>, PROBE_REP_THIN);
    PH(ph_f1<layer>, PROBE_REP_GEMM);
    PH_RES(ph_f2, PROBE_REP_GEMM);
    if constexpr (layer + 1 < DEPTH) {
        if constexpr (layer & 1) { ph_convert<layer + 1>(lds0, G0, bid0);
            if constexpr (PROBE_REP_THIN >= 1) ph_convert<layer + 1>(lds0, G0, bid0); }
        PH(ph_smp<layer>, PROBE_REP_THIN);
    } else {
        ph_final(lds0, G0, bid0, bar);
    }
}

__global__ void __launch_bounds__(512, 2) fwd_kernel(KArgs a) {
    extern __shared__ __attribute__((aligned(16))) unsigned char smem[];
    LAS unsigned char* const lds0 = (LAS unsigned char*)smem;
    const int tid = threadIdx.x;
    const int G0 = gridDim.x, bid0 = blockIdx.x;
    volatile LAS unsigned* MISC = (volatile LAS unsigned*)(lds0 + LDS_MISC);
    if (tid < 4) MISC[tid] = 0u;
    if (tid < 25) { const unsigned long long v = tid < 23 ? (unsigned long long)a.in[tid] : (tid == 23 ? (unsigned long long)a.out : (unsigned long long)a.ws);
        volatile LAS unsigned* p = (volatile LAS unsigned*)(lds0 + LDS_ARGS) + 2 * tid; p[0] = (unsigned)v; p[1] = (unsigned)(v >> 32); }
    __syncthreads();
    XcdBarrier bar = xcd_barrier_post((unsigned*)(a.ws + WS_CTL) + CW_BAR, MISC);
    ph_convert<0>(lds0, G0, bid0);
    if constexpr (PROBE_REP_THIN >= 1) ph_convert<0>(lds0, G0, bid0);
    PH(ph_rms_in<0>, PROBE_REP_THIN);
    layer_body<0>(lds0, G0, bid0, bar);
    layer_body<1>(lds0, G0, bid0, bar);
    layer_body<2>(lds0, G0, bid0, bar);
    layer_body<3>(lds0, G0, bid0, bar);
}

extern "C" void kernel_launch(void* const* d_in, const int* in_sizes, int n_in, void* d_out, int out_size, void* d_ws, size_t ws_size, hipStream_t stream) {
    static int grid = 0;
    if (grid == 0) {
        if (n_in != 23 || (size_t)out_size != O_END || ws_size < WS_END + ((PROBE_REP_GEMM > 0) ? (size_t)MTOK * DM * 4 : 0)) { fprintf(stderr, "kernel_launch: unexpected sizes (n_in %d out %d ws %zu, need ws %zu)\n", n_in, out_size, ws_size, (size_t)WS_END); grid = -1; return; }
        int dev = 0, cus = 0;
        if (hipGetDevice(&dev) != hipSuccess || hipDeviceGetAttribute(&cus, hipDeviceAttributeMultiprocessorCount, dev) != hipSuccess) { grid = -1; return; }
        if (hipFuncSetAttribute((const void*)fwd_kernel, hipFuncAttributeMaxDynamicSharedMemorySize, LDS_BYTES) != hipSuccess) { fprintf(stderr, "kernel_launch: hipFuncSetAttribute failed\n"); grid = -1; return; }
        int per_cu = 0;
        if (hipOccupancyMaxActiveBlocksPerMultiprocessor(&per_cu, (const void*)fwd_kernel, 512, LDS_BYTES) != hipSuccess || per_cu < 1) fprintf(stderr, "kernel_launch: occupancy query says %d\n", per_cu);
        (void)hipGetLastError();
        if (cus * 8 * 4 < SEQ / 2) { fprintf(stderr, "kernel_launch: %d CUs: the final norm holds 4 rows per wave\n", cus); grid = -1; return; }
        grid = cus;
    }
    if (grid < 0) return;
    if (hipMemsetAsync((char*)d_ws + WS_CTL, 0, CTL_ZERO_BYTES, stream) != hipSuccess) return;
    KArgs a{};
    for (int i = 0; i < 23; ++i) a.in[i] = (const float*)d_in[i];
    a.out = (float*)d_out; a.ws = (unsigned char*)d_ws;
    hipLaunchKernelGGL(fwd_kernel, dim3(grid), dim3(512), LDS_BYTES, stream, a);
}
#endif
```

```cpp
#ifndef EMU
#include <hip/hip_runtime.h>
#include <cstdio>
typedef short bf16x8 __attribute__((ext_vector_type(8)));
typedef short bf16x4 __attribute__((ext_vector_type(4)));
typedef float f32x16 __attribute__((ext_vector_type(16)));
typedef float f32x4 __attribute__((ext_vector_type(4)));
typedef float f32x2 __attribute__((ext_vector_type(2)));
typedef unsigned u32x4 __attribute__((ext_vector_type(4)));
typedef unsigned u32x2 __attribute__((ext_vector_type(2)));
#define LAS __attribute__((address_space(3)))
#define MFMA32(a, b, c) __builtin_amdgcn_mfma_f32_32x32x16_bf16((a), (b), (c), 0, 0, 0)
#define MFMA16(a, b, c) __builtin_amdgcn_mfma_f32_16x16x32_bf16((a), (b), (c), 0, 0, 0)
#define RFL(x) __builtin_amdgcn_readfirstlane(x)
#define WG_BARRIER() do { asm volatile("s_waitcnt lgkmcnt(0)" ::: "memory"); __builtin_amdgcn_s_barrier(); asm volatile("" ::: "memory"); } while (0)
#define WG_BARRIER_WAVE() asm volatile("s_waitcnt lgkmcnt(0)" ::: "memory")
#define FAST_RCP(x) __builtin_amdgcn_rcpf(x)
#define READLANE_F(v, l) __builtin_bit_cast(float, __builtin_amdgcn_readlane(__builtin_bit_cast(int, (float)(v)), (l)))
#define FAST_EXP2(x) __builtin_amdgcn_exp2f(x)
#define ANY_LANE(p) (__builtin_amdgcn_ballot_w64(p) != 0ull)
#define FAST_RSQ(x) __builtin_amdgcn_rsqf(x)
#define CFENCE() asm volatile("" ::: "memory")
#define SCHED_FENCE() __builtin_amdgcn_sched_barrier(0)
#define LOADER_PACE() do {} while (0)
#define PIN_F(x) asm volatile("" : "+v"(x) :: "memory")
typedef short s16x4_t __attribute__((ext_vector_type(4)));
#define LDS_TR16(p) __builtin_bit_cast(u32x2, __builtin_amdgcn_ds_read_tr16_b64_v4i16((LAS s16x4_t*)(p)))
#else
#define LAS
#define MFMA32(a, b, c) emu::mfma32((a), (b), (c))
#define MFMA16(a, b, c) emu::mfma16((a), (b), (c))
#define RFL(x) (x)
#define WG_BARRIER() __syncthreads()
#define WG_BARRIER_WAVE() emu::wave_sync()
#define FAST_RCP(x) (1.0f / (x))
#define READLANE_F(v, l) emu::shfl((float)(v), (l))
#define FAST_EXP2(x) exp2f(x)
#define ANY_LANE(p) (emu::shfl_any(p))
#define FAST_RSQ(x) (1.0f / sqrtf(x))
#define CFENCE() do {} while (0)
#define SCHED_FENCE() do {} while (0)
#define LOADER_PACE() do {} while (0)
#define PIN_F(x) do {} while (0)
static inline u32x2 emu_lds_tr16(const void* p) {
    const int l = emu::lane(); unsigned short e[4];
    for (int q = 0; q < 4; ++q) { const unsigned long long a = emu::shfl((unsigned long long)(size_t)p, (l & ~15) + 4 * q + ((l & 15) >> 2)); e[q] = *(const unsigned short*)((size_t)a + 2 * (l & 3)); }
    u32x2 r; r.x = e[0] | ((unsigned)e[1] << 16); r.y = e[2] | ((unsigned)e[3] << 16); return r;
}
#define LDS_TR16(p) emu_lds_tr16((const void*)(p))
#endif
typedef unsigned short bf16;
#ifndef EMU
__device__ __forceinline__ int tid_opaque() { int t = threadIdx.x; asm volatile("" : "+v"(t)); return t; }
#else
static inline int tid_opaque() { return threadIdx.x; }
#endif

constexpr int DM = 2048, SEQ = 16384, DEPTH = 4, DECB = 16, DECS = 32;
constexpr int MTOK = SEQ + DECB * DECS;
constexpr int NCH = SEQ / 64;
constexpr int NCIDX = NCH + DECB;
constexpr int GQKV = 8192, GZ = 4096, GPROJ = 12352, GPROJ_PAD = 12544, PPITCH = 12288;
constexpr int HV = 32, HK = 16, DK = 128;
constexpr int DFF = 5632;
constexpr int AH = 16, ADH = 128, MAXREL = 256;
constexpr float EPS = 1e-6f;

__device__ __forceinline__ unsigned f2bf(float f) { unsigned u = __builtin_bit_cast(unsigned, f); return (u + 0x7fffu + ((u >> 16) & 1u)) >> 16; }
#ifndef EMU
typedef __bf16 bf16v2_t __attribute__((ext_vector_type(2)));
__device__ __forceinline__ unsigned pk2(float lo, float hi) { f32x2 v; v.x = lo; v.y = hi; return __builtin_bit_cast(unsigned, __builtin_convertvector(v, bf16v2_t)); }
#else
__device__ __forceinline__ unsigned pk2(float lo, float hi) { return f2bf(lo) | (f2bf(hi) << 16); }
#endif
__device__ __forceinline__ float bf2f(unsigned short b) { return __builtin_bit_cast(float, ((unsigned)b) << 16); }
__device__ __forceinline__ float bflo(unsigned w) { return __builtin_bit_cast(float, w << 16); }
__device__ __forceinline__ float bfhi(unsigned w) { return __builtin_bit_cast(float, w & 0xffff0000u); }
__device__ __forceinline__ float wave_sum(float v) {
#pragma unroll
    for (int o = 1; o < 64; o <<= 1) v += __shfl_xor(v, o);
    return v;
}
__device__ __forceinline__ float sigmoidf_(float x) { return FAST_RCP(1.0f + __expf(-x)); }
__device__ __forceinline__ float siluf_(float x) { return x * FAST_RCP(1.0f + __expf(-x)); }
__device__ __forceinline__ float softplusf_(float x) { return x > 20.f ? x : log1pf(__expf(x)); }
__device__ __forceinline__ bf16x8 pack8(float a0, float a1, float a2, float a3, float a4, float a5, float a6, float a7) {
    u32x4 w; w.x = pk2(a0, a1); w.y = pk2(a2, a3); w.z = pk2(a4, a5); w.w = pk2(a6, a7); return __builtin_bit_cast(bf16x8, w);
}
__device__ __forceinline__ bf16x8 acc_frag(const f32x16& v, int s) {
    return s == 0 ? pack8(v[0], v[1], v[2], v[3], v[4], v[5], v[6], v[7]) : pack8(v[8], v[9], v[10], v[11], v[12], v[13], v[14], v[15]);
}
__device__ __forceinline__ int accrow(int r, int h) { return (r & 3) + 8 * (r >> 2) + 4 * h; }
__device__ __forceinline__ int permk(int h, int j) { return 8 * (j >> 2) + 4 * h + (j & 3); }
#ifndef EMU
namespace pg8 {
#define PG8_LAS __attribute__((address_space(3)))
typedef unsigned short bf16_t;
typedef short bf16x8 __attribute__((ext_vector_type(8)));
typedef float f32x4 __attribute__((ext_vector_type(4)));
typedef unsigned u32x4 __attribute__((ext_vector_type(4)));
constexpr int BM = 256, BK = 64, HALF = 128, HTB = HALF * BK * 2  , STAGE_BYTES = 8 * HTB, NXCD = 8, WGM = 4;

__host__ __device__ __forceinline__ int lds_byte(int r, int c) { const int st = (r >> 4) * 2 + (c >> 5), rr = r & 15, cc = c & 31, ob = rr * 64 + cc * 2; return st * 1024 + (ob ^ (((ob >> 9) & 1) << 5)); }
__host__ __device__ __forceinline__ void stage_rc(int b, int& R, int& C) { const int st = b / 1024, sb = b % 1024, swz = sb ^ (((sb >> 9) & 1) << 5); R = (st >> 1) * 16 + swz / 64; C = (st & 1) * 32 + (swz % 64) / 2; }
__host__ __device__ __forceinline__ int perm32(int rho) { const int n = rho >> 4, i = rho & 15; return 8 * (i >> 2) + 4 * n + (i & 3); }

struct Unit { int pm, pn; };
struct Gemm { const bf16_t* A; const bf16_t* Bt; int M, N, K, ld; const bf16_t* A2 = nullptr; int msplit = 1 << 30; const float* R = nullptr; };

struct StaticOrder {
    int nM, nN, nwg, G, c;
    __host__ __device__ void init(int M, int N, int G_, int c_) { nM = M / BM; nN = N / BM; nwg = nM * nN; G = G_; c = c_; }
    __host__ __device__ bool next(int i, Unit& u) const {
        const long L = (long)i * G + c; if (L >= nwg) return false;
        int wgid = (int)L; { const int q = nwg / NXCD, r = nwg % NXCD, xcd = wgid % NXCD, off = wgid / NXCD; wgid = (xcd < r ? xcd * (q + 1) : r * (q + 1) + (xcd - r) * q) + off; }
        const int nig = WGM * nN, gid = wgid / nig, fm = gid * WGM, gsz = (nM - fm) < WGM ? (nM - fm) : WGM;
        u.pm = fm + ((wgid % nig) % gsz); u.pn = (wgid % nig) / gsz; return true;
    }
    __device__ __forceinline__ void a_ready(const Unit&) const {}
    __device__ __forceinline__ void done(const Unit&) const {}
};
__device__ __forceinline__ unsigned cvt_pk_bf16(float lo, float hi) { unsigned r; asm volatile("v_cvt_pk_bf16_f32 %0, %1, %2" : "=v"(r) : "v"(lo), "v"(hi)); return r; }

__device__ __forceinline__ float silu_f(float x) { return x * __builtin_amdgcn_rcpf(1.0f + __expf(-x)); }
struct EpiProj {
    static constexpr bool PERM = true, AFTER_DRAIN = false;
    bf16_t* O; int ldc; float* BA; int n_main;
    __device__ __forceinline__ void operator()(const f32x4 (&acc)[2][2][4][2], const Unit& u, int wr, int wc, int fr, int fq) const {
        const int row0 = u.pm * BM + wr * 64 + fr, col0 = u.pn * BM + wc * 32 + 8 * fq;
        if (u.pn * BM < n_main) {
#pragma unroll
            for (int ai = 0; ai < 2; ++ai)
#pragma unroll
                for (int m = 0; m < 4; ++m) { bf16_t* rowp = O + (size_t)(row0 + ai * HALF + m * 16) * ldc + col0;
#pragma unroll
                    for (int bj = 0; bj < 2; ++bj) { const f32x4 v0 = acc[ai][bj][m][0], v1 = acc[ai][bj][m][1];
                        u32x4 w; w.x = cvt_pk_bf16(v0[0], v0[1]); w.y = cvt_pk_bf16(v0[2], v0[3]); w.z = cvt_pk_bf16(v1[0], v1[1]); w.w = cvt_pk_bf16(v1[2], v1[3]);
                        *(u32x4*)(rowp + bj * HALF) = w; } }
        } else if (wc < 2) {
#pragma unroll
            for (int ai = 0; ai < 2; ++ai)
#pragma unroll
                for (int m = 0; m < 4; ++m) { float* rowp = BA + (size_t)(row0 + ai * HALF + m * 16) * 64 + wc * 32 + 8 * fq;
                    *(f32x4*)(rowp) = acc[ai][0][m][0]; *(f32x4*)(rowp + 4) = acc[ai][0][m][1]; }
        }
    }
};
struct EpiResid {
    static constexpr bool PERM = false, AFTER_DRAIN = false;
    float* X; int ldc; const float* bias; const float* Xin;
    __device__ __forceinline__ void operator()(const f32x4 (&acc)[2][2][4][2], const Unit& u, int wr, int wc, int fr, int fq) const {
        const int row0 = u.pm * BM + wr * 64 + fr, col0 = u.pn * BM + wc * 32 + 4 * fq;
        f32x4 bv[2][2];
#pragma unroll
        for (int bj = 0; bj < 2; ++bj)
#pragma unroll
            for (int n = 0; n < 2; ++n) bv[bj][n] = bias ? *(const f32x4*)(bias + col0 + bj * HALF + n * 16) : (f32x4){0.f, 0.f, 0.f, 0.f};
#pragma unroll
        for (int ai = 0; ai < 2; ++ai)
#pragma unroll
            for (int m = 0; m < 4; ++m) { float* rowp = X + (size_t)(row0 + ai * HALF + m * 16) * ldc + col0;
                f32x4 xv[2][2];
#pragma unroll
                for (int bj = 0; bj < 2; ++bj)
#pragma unroll
                    for (int n = 0; n < 2; ++n) xv[bj][n] = *(const f32x4*)(Xin + (size_t)(row0 + ai * HALF + m * 16) * ldc + col0 + bj * HALF + n * 16);
#pragma unroll
                for (int bj = 0; bj < 2; ++bj)
#pragma unroll
                    for (int n = 0; n < 2; ++n) *(f32x4*)(rowp + bj * HALF + n * 16) = xv[bj][n] + acc[ai][bj][m][n] + bv[bj][n]; }
    }
};
template <bool FIRST> struct EpiResidH {
    static constexpr bool PERM = true, AFTER_DRAIN = false;
    bf16_t* XH; int ldc; const float* bias; const float* Xf; float* SL;
    __device__ __forceinline__ void operator()(const f32x4 (&acc)[2][2][4][2], const Unit& u, int wr, int wc, int fr, int fq) const {
        const int row0 = u.pm * BM + wr * 64 + fr, col0 = u.pn * BM + wc * 32 + 8 * fq;
        f32x4 bv[2][2];
#pragma unroll
        for (int bj = 0; bj < 2; ++bj)
#pragma unroll
            for (int n = 0; n < 2; ++n) bv[bj][n] = bias ? *(const f32x4*)(bias + col0 + bj * HALF + 4 * n) : (f32x4){0.f, 0.f, 0.f, 0.f};
#pragma unroll
        for (int ai = 0; ai < 2; ++ai)
#pragma unroll
            for (int m = 0; m < 4; ++m) { const size_t ro = (size_t)(row0 + ai * HALF + m * 16) * ldc + col0;
                f32x4 x0[2], x1[2];
                if constexpr (FIRST) {
#pragma unroll
                    for (int bj = 0; bj < 2; ++bj) { x0[bj] = *(const f32x4*)(Xf + ro + bj * HALF); x1[bj] = *(const f32x4*)(Xf + ro + bj * HALF + 4); }
                } else {
                    u32x4 xw[2];
#pragma unroll
                    for (int bj = 0; bj < 2; ++bj) xw[bj] = *(const u32x4*)(XH + ro + bj * HALF);
#pragma unroll
                    for (int bj = 0; bj < 2; ++bj) { x0[bj] = (f32x4){bflo(xw[bj].x), bfhi(xw[bj].x), bflo(xw[bj].y), bfhi(xw[bj].y)}; x1[bj] = (f32x4){bflo(xw[bj].z), bfhi(xw[bj].z), bflo(xw[bj].w), bfhi(xw[bj].w)}; }
                }
                float ss = 0.f;
#pragma unroll
                for (int bj = 0; bj < 2; ++bj) { const f32x4 v0 = x0[bj] + acc[ai][bj][m][0] + bv[bj][0], v1 = x1[bj] + acc[ai][bj][m][1] + bv[bj][1];
                    u32x4 w; w.x = cvt_pk_bf16(v0[0], v0[1]); w.y = cvt_pk_bf16(v0[2], v0[3]); w.z = cvt_pk_bf16(v1[0], v1[1]); w.w = cvt_pk_bf16(v1[2], v1[3]);
                    *(u32x4*)(XH + ro + bj * HALF) = w;
                    ss += ((v0[0] * v0[0] + v0[1] * v0[1]) + (v0[2] * v0[2] + v0[3] * v0[3])) + ((v1[0] * v1[0] + v1[1] * v1[1]) + (v1[2] * v1[2] + v1[3] * v1[3])); }
                ss += __shfl_xor(ss, 16); ss += __shfl_xor(ss, 32);
                if (fq == 0) SL[(size_t)(row0 + ai * HALF + m * 16) * 32 + u.pn * 4 + wc] = ss; }
    }
};
struct SingleUnit {
    int pm, pn; bool valid;
    __device__ bool next(int i, Unit& u) const { if (i != 0 || !valid) return false; u.pm = pm; u.pn = pn; return true; }
    __device__ __forceinline__ void a_ready(const Unit&) const {}
    __device__ __forceinline__ void done(const Unit&) const {}
};
struct EpiAtomic {
    static constexpr bool PERM = false, AFTER_DRAIN = false;
    float* X; int ldc; const float* bias;
    __device__ __forceinline__ void operator()(const f32x4 (&acc)[2][2][4][2], const Unit& u, int wr, int wc, int fr, int fq) const {
        const int row0 = u.pm * BM + wr * 64 + fr, col0 = u.pn * BM + wc * 32 + 4 * fq;
#pragma unroll
        for (int ai = 0; ai < 2; ++ai)
#pragma unroll
            for (int m = 0; m < 4; ++m) { float* rowp = X + (size_t)(row0 + ai * HALF + m * 16) * ldc + col0;
#pragma unroll
                for (int bj = 0; bj < 2; ++bj)
#pragma unroll
                    for (int n = 0; n < 2; ++n) { f32x4 v = acc[ai][bj][m][n]; if (bias) v = v + *(const f32x4*)(bias + col0 + bj * HALF + n * 16);
                        float* q = rowp + bj * HALF + n * 16; unsafeAtomicAdd(q, v[0]); unsafeAtomicAdd(q + 1, v[1]); unsafeAtomicAdd(q + 2, v[2]); unsafeAtomicAdd(q + 3, v[3]); } }
    }
};
struct EpiQkv {
    static constexpr bool PERM = true, AFTER_DRAIN = false;
    bf16_t* O; int ldc; const float* bias; float* kp; long dv, ds;
    __device__ __forceinline__ void operator()(const f32x4 (&acc)[2][2][4][2], const Unit& u, int wr, int wc, int fr, int fq) const {
        const int row0 = u.pm * BM + wr * 64 + fr, col0 = u.pn * BM + wc * 32 + 8 * fq;
        f32x4 bv[2][2];
#pragma unroll
        for (int bj = 0; bj < 2; ++bj)
#pragma unroll
            for (int n = 0; n < 2; ++n) bv[bj][n] = *(const f32x4*)(bias + col0 + bj * HALF + 4 * n);
        const int sect = (u.pn * BM) >> 11;
        const bool keep = (u.pm >= 62) && sect > 0;
        float* kvbase = kp + (sect == 2 ? dv : 0l) + (u.pm >= 64 ? ds : 0l);
        const int rbase = (u.pm < 64) ? 62 * BM : 64 * BM;
#pragma unroll
        for (int ai = 0; ai < 2; ++ai)
#pragma unroll
            for (int m = 0; m < 4; ++m) { const int row = row0 + ai * HALF + m * 16; bf16_t* rowp = O + (size_t)row * ldc + col0;
#pragma unroll
                for (int bj = 0; bj < 2; ++bj) { const f32x4 v0 = acc[ai][bj][m][0] + bv[bj][0], v1 = acc[ai][bj][m][1] + bv[bj][1];
                    u32x4 w; w.x = cvt_pk_bf16(v0[0], v0[1]); w.y = cvt_pk_bf16(v0[2], v0[3]); w.z = cvt_pk_bf16(v1[0], v1[1]); w.w = cvt_pk_bf16(v1[2], v1[3]);
                    *(u32x4*)(rowp + bj * HALF) = w;
                    if (keep) { float* fp = kvbase + (size_t)(row - rbase) * 2048 + (col0 + bj * HALF - sect * 2048); *(f32x4*)(fp) = v0; *(f32x4*)(fp + 4) = v1; } } }
    }
};
struct EpiSwiglu {
    static constexpr bool PERM = true, AFTER_DRAIN = false;
    bf16_t* O; int ldc;
    __device__ __forceinline__ void operator()(const f32x4 (&acc)[2][2][4][2], const Unit& u, int wr, int wc, int fr, int fq) const {
        const int row0 = u.pm * BM + wr * 64 + fr, col0 = u.pn * HALF + wc * 32 + 8 * fq;
#pragma unroll
        for (int ai = 0; ai < 2; ++ai)
#pragma unroll
            for (int m = 0; m < 4; ++m) { bf16_t* rowp = O + (size_t)(row0 + ai * HALF + m * 16) * ldc + col0;
                const f32x4 g0 = acc[ai][0][m][0], g1 = acc[ai][0][m][1], u0 = acc[ai][1][m][0], u1 = acc[ai][1][m][1];
                u32x4 w; w.x = cvt_pk_bf16(silu_f(g0[0]) * u0[0], silu_f(g0[1]) * u0[1]); w.y = cvt_pk_bf16(silu_f(g0[2]) * u0[2], silu_f(g0[3]) * u0[3]);
                w.z = cvt_pk_bf16(silu_f(g1[0]) * u1[0], silu_f(g1[1]) * u1[1]); w.w = cvt_pk_bf16(silu_f(g1[2]) * u1[2], silu_f(g1[3]) * u1[3]);
                *(u32x4*)(rowp) = w; }
    }
};

typedef __bf16 bf16v2_pg8 __attribute__((ext_vector_type(2)));
constexpr int RMS_LDS = STAGE_BYTES;
template <class Epi, class Sched, bool ALIGN_EPI = false, bool SP2 = false, bool RMS = false>
__device__ __forceinline__ void gemm_phase(PG8_LAS unsigned char* lds, const Gemm g, const Sched& S, const Epi& E) {
    const int tid = tid_opaque(), wid = __builtin_amdgcn_readfirstlane(tid >> 6), lane = tid & 63, wr = wid >> 2, wc = wid & 3, fr = lane & 15, fq = lane >> 4;
    const int K = g.ld, nt = g.K / BK;
    unsigned voffA[2], voffB[2];
#pragma unroll
    for (int i = 0; i < 2; ++i) { int R, C; stage_rc(tid * 16 + i * 8192, R, C); const int Rb = Epi::PERM ? ((R & ~31) + perm32(R & 31)) : R;
        voffA[i] = (unsigned)(R * K + C) * 2u; voffB[i] = (unsigned)(Rb * K + C) * 2u; }
    const size_t kstep = (size_t)(BK * 2);
    const size_t hstep = (size_t)HALF * K * 2;
    const size_t tstep = 2 * hstep;
    const unsigned ldsw = (unsigned)wid * 1024u;
    const int aoff = lds_byte(wr * 64 + fr, fq * 8), boff = lds_byte(wc * 32 + fr, fq * 8);
#define PG8_SA(b, h) (((b) * 2 + (h)) * HTB)
#define PG8_SB(b, h) ((4 + (b) * 2 + (h)) * HTB)
#define PG8_STAGE(bufoff, gbase, voff) do { _Pragma("unroll") for (int _i = 0; _i < 2; ++_i) \
        __builtin_amdgcn_global_load_lds((const unsigned*)((const char*)(gbase) + (voff)[_i]), (PG8_LAS unsigned*)(lds + (bufoff) + ldsw + _i * 8192), 16, 0, 0); } while (0)
#define PG8_LDA(dst, b, h) do { _Pragma("unroll") for (int m = 0; m < 4; ++m) _Pragma("unroll") for (int k = 0; k < 2; ++k) dst[m][k] = *(const PG8_LAS bf16x8*)(lds + PG8_SA(b, h) + aoff + m * 2048 + k * 1024); } while (0)
#define PG8_LDB(dst, b, h) do { _Pragma("unroll") for (int n = 0; n < 2; ++n) _Pragma("unroll") for (int k = 0; k < 2; ++k) dst[n][k] = *(const PG8_LAS bf16x8*)(lds + PG8_SB(b, h) + boff + n * 2048 + k * 1024); } while (0)
#define PG8_MMA(ai, bj, At, Bt) do { __builtin_amdgcn_s_setprio(1); _Pragma("unroll") for (int m = 0; m < 4; ++m) _Pragma("unroll") for (int n = 0; n < 2; ++n) _Pragma("unroll") for (int k = 0; k < 2; ++k) { \
        acc[ai][bj][m][n] = __builtin_amdgcn_mfma_f32_16x16x32_bf16(Bt[n][k], At[m][k], acc[ai][bj][m][n], 0, 0, 0); } \
        __builtin_amdgcn_s_setprio(0); } while (0)
#define PG8_WAIT_V(n) asm volatile("s_waitcnt vmcnt(" #n ")" ::: "memory")
#define PG8_WAIT_L(n) asm volatile("s_waitcnt lgkmcnt(" #n ")" ::: "memory")
#define PG8_BAR __builtin_amdgcn_s_barrier()
#define PG8_SCHED __builtin_amdgcn_sched_barrier(0)
    Unit cur, nxt; int ui = 0;
    if (!S.next(0, cur)) return;
    f32x4 acc[2][2][4][2];
#pragma unroll
    for (int a = 0; a < 2; ++a)
#pragma unroll
        for (int b = 0; b < 2; ++b)
#pragma unroll
            for (int m = 0; m < 4; ++m)
#pragma unroll
                for (int n = 0; n < 2; ++n) acc[a][b][m][n] = (f32x4){0.f, 0.f, 0.f, 0.f};
    bf16x8 At[4][2], B0[2][2], B1[2][2];
#define PG8_RFETCH(pm_, par_) do { if constexpr (RMS) { if (wid < 4) __builtin_amdgcn_global_load_lds((const unsigned*)(g.R + (size_t)(pm_) * BM + wid * 64 + lane), (PG8_LAS unsigned*)(lds + RMS_LDS + (par_) * 1024 + wid * 256), 4, 0, 0); } } while (0)
#define PG8_ABASE(pm_) ((pm_) < g.msplit ? (const char*)g.A + (size_t)(pm_) * tstep : (const char*)g.A2 + (size_t)((pm_) - g.msplit) * tstep)
    const char* cA = PG8_ABASE(cur.pm); const char* cB = (const char*)g.Bt + (size_t)cur.pn * tstep;
    S.a_ready(cur);
    PG8_RFETCH(cur.pm, 0);
    if constexpr (SP2) {
        PG8_STAGE(PG8_SB(0, 0), cB, voffB); PG8_STAGE(PG8_SB(0, 1), cB + hstep, voffB); PG8_STAGE(PG8_SA(0, 0), cA, voffA); PG8_STAGE(PG8_SA(0, 1), cA + hstep, voffA);
        if (wr == 1) PG8_BAR;
        PG8_WAIT_V(2); PG8_BAR;
        PG8_STAGE(PG8_SB(1, 0), cB + kstep, voffB); PG8_STAGE(PG8_SA(1, 0), cA + kstep, voffA); PG8_STAGE(PG8_SB(1, 1), cB + hstep + kstep, voffB);
        PG8_WAIT_V(6); PG8_BAR;
    } else {
        PG8_STAGE(PG8_SB(0, 0), cB, voffB); PG8_STAGE(PG8_SA(0, 0), cA, voffA); PG8_STAGE(PG8_SB(0, 1), cB + hstep, voffB); PG8_STAGE(PG8_SA(0, 1), cA + hstep, voffA);
        if (wr == 1) PG8_BAR;
        PG8_WAIT_V(4); PG8_BAR;
        PG8_STAGE(PG8_SB(1, 0), cB + kstep, voffB); PG8_STAGE(PG8_SA(1, 0), cA + kstep, voffA); PG8_STAGE(PG8_SB(1, 1), cB + hstep + kstep, voffB);
        PG8_WAIT_V(6); PG8_BAR;
    }
    for (;;) {
        const bool has_next = S.next(ui + 1, nxt);
        const char* nA = has_next ? PG8_ABASE(nxt.pm) : cA; const char* nB = has_next ? (const char*)g.Bt + (size_t)nxt.pn * tstep : cB;
        for (int t = 0; t < nt; t += 2) {
            const bool last = (t == nt - 2);
            const char* a1 = cA + (size_t)(t + 1) * kstep;
            const char* a2 = last ? nA : cA + (size_t)(t + 2) * kstep; const char* b2 = last ? nB : cB + (size_t)(t + 2) * kstep;
            const char* a3 = a2 + kstep; const char* b3 = b2 + kstep;
            if (last && has_next) S.a_ready(nxt);
            if constexpr (SP2) {
            PG8_LDB(B0, 0, 0); PG8_LDB(B1, 0, 1); PG8_SCHED; PG8_LDA(At, 0, 0); PG8_STAGE(PG8_SA(1, 1), a1 + hstep, voffA);
            PG8_WAIT_V(8); PG8_WAIT_L(0); PG8_BAR; PG8_MMA(0, 0, At, B0); PG8_MMA(0, 1, At, B1); PG8_BAR; PG8_SCHED;
            PG8_LDA(At, 0, 1); PG8_STAGE(PG8_SB(0, 0), b2, voffB); PG8_STAGE(PG8_SB(0, 1), b2 + hstep, voffB); PG8_STAGE(PG8_SA(0, 0), a2, voffA);
            PG8_WAIT_V(8); PG8_WAIT_L(0); PG8_BAR; PG8_MMA(1, 0, At, B0); PG8_MMA(1, 1, At, B1); PG8_BAR; PG8_SCHED;
            PG8_LDB(B0, 1, 0); PG8_LDB(B1, 1, 1); PG8_SCHED; PG8_LDA(At, 1, 0); PG8_STAGE(PG8_SA(0, 1), a2 + hstep, voffA);
            PG8_WAIT_V(8); PG8_WAIT_L(0); PG8_BAR; PG8_MMA(0, 0, At, B0); PG8_MMA(0, 1, At, B1); PG8_BAR; PG8_SCHED;
            PG8_LDA(At, 1, 1); PG8_STAGE(PG8_SB(1, 0), b3, voffB); PG8_STAGE(PG8_SB(1, 1), b3 + hstep, voffB); PG8_STAGE(PG8_SA(1, 0), a3, voffA);
            PG8_WAIT_V(8); PG8_WAIT_L(0); PG8_BAR; PG8_MMA(1, 0, At, B0); PG8_MMA(1, 1, At, B1); PG8_BAR; PG8_SCHED;
            } else {
            PG8_LDB(B0, 0, 0); PG8_SCHED; PG8_LDA(At, 0, 0); PG8_STAGE(PG8_SA(1, 1), a1 + hstep, voffA);
            PG8_WAIT_L(8); PG8_BAR; PG8_WAIT_L(0); PG8_MMA(0, 0, At, B0); PG8_BAR; PG8_SCHED;
            PG8_LDB(B1, 0, 1); PG8_STAGE(PG8_SB(0, 0), b2, voffB);
            PG8_BAR; PG8_WAIT_L(0); PG8_MMA(0, 1, At, B1); PG8_BAR;
            PG8_LDA(At, 0, 1); PG8_STAGE(PG8_SA(0, 0), a2, voffA);
            PG8_BAR; PG8_WAIT_L(0); PG8_MMA(1, 0, At, B0); PG8_BAR; PG8_SCHED;
            PG8_STAGE(PG8_SB(0, 1), b2 + hstep, voffB);
            PG8_WAIT_V(6); PG8_BAR; PG8_MMA(1, 1, At, B1); PG8_BAR;
            PG8_LDB(B0, 1, 0); PG8_SCHED; PG8_LDA(At, 1, 0); PG8_STAGE(PG8_SA(0, 1), a2 + hstep, voffA);
            PG8_WAIT_L(8); PG8_BAR; PG8_WAIT_L(0); PG8_MMA(0, 0, At, B0); PG8_BAR; PG8_SCHED;
            PG8_LDB(B1, 1, 1); PG8_STAGE(PG8_SB(1, 0), b3, voffB);
            PG8_BAR; PG8_WAIT_L(0); PG8_MMA(0, 1, At, B1); PG8_BAR;
            PG8_LDA(At, 1, 1); PG8_STAGE(PG8_SA(1, 0), a3, voffA);
            PG8_BAR; PG8_WAIT_L(0); PG8_MMA(1, 0, At, B0); PG8_BAR; PG8_SCHED;
            PG8_STAGE(PG8_SB(1, 1), b3 + hstep, voffB);
            PG8_WAIT_V(6); PG8_BAR; PG8_MMA(1, 1, At, B1); PG8_BAR;
            }
        }
        if constexpr (ALIGN_EPI) { if (wr == 0) PG8_BAR; }
        if constexpr (RMS) {
            const PG8_LAS float* rl = (const PG8_LAS float*)(lds + RMS_LDS + (ui & 1) * 1024) + wr * 64 + fr;
#pragma unroll
            for (int a = 0; a < 2; ++a)
#pragma unroll
                for (int m = 0; m < 4; ++m) { const float r = rl[a * HALF + m * 16];
#pragma unroll
                    for (int b = 0; b < 2; ++b)
#pragma unroll
                        for (int n = 0; n < 2; ++n) acc[a][b][m][n] = acc[a][b][m][n] * r; }
        }
        if constexpr (!Epi::AFTER_DRAIN) { E(acc, cur, wr, wc, fr, fq); S.done(cur); }
        if (!has_next) break;
#pragma unroll
        for (int a = 0; a < 2; ++a)
#pragma unroll
            for (int b = 0; b < 2; ++b)
#pragma unroll
                for (int m = 0; m < 4; ++m)
#pragma unroll
                    for (int n = 0; n < 2; ++n) acc[a][b][m][n] = (f32x4){0.f, 0.f, 0.f, 0.f};
        cur = nxt; cA = nA; cB = nB; ++ui;
        PG8_RFETCH(cur.pm, ui & 1);
        if constexpr (ALIGN_EPI) { if (wr == 1) PG8_BAR; }
    }
    PG8_WAIT_V(0);
    if constexpr (!ALIGN_EPI) { if (wr == 0) PG8_BAR; }
    PG8_BAR;
    if constexpr (Epi::AFTER_DRAIN) { E.fused(acc, cur, wr, wc, fr, fq, lds, wid, lane); S.done(cur); }
#undef PG8_SA
#undef PG8_ABASE
#undef PG8_RFETCH
#undef PG8_SB
#undef PG8_STAGE
#undef PG8_LDA
#undef PG8_LDB
#undef PG8_MMA
#undef PG8_WAIT_V
#undef PG8_WAIT_L
#undef PG8_BAR
#undef PG8_SCHED
}
}
#endif
#ifndef EMU
#define XB_TMO      128
#define XB_XCNT(j)  (256  + 64 * (j))
#define XB_XSUB(j)  (1280 + 64 * (j))
#define XB_XGEN(j)  (2304 + 64 * (j))
#define XB_TOP      3328
#define XB_TOPGEN   3392
#define XCD_BAR_WORDS 3456
#define XB_SPIN_CAP (1u << 18)

__device__ __forceinline__ unsigned xb_ld(unsigned* p)              { return __hip_atomic_load(p, __ATOMIC_RELAXED, __HIP_MEMORY_SCOPE_AGENT); }
__device__ __forceinline__ unsigned xb_add(unsigned* p, unsigned v) { return __hip_atomic_fetch_add(p, v, __ATOMIC_RELAXED, __HIP_MEMORY_SCOPE_AGENT); }
__device__ __forceinline__ unsigned xb_xcc_id() { return (unsigned)__builtin_amdgcn_s_getreg((3 << 11) | 20) & 0xFu; }
#define XB_SPIN(cond, bar) do { unsigned _sp = 0; while (cond) { __builtin_amdgcn_s_sleep(1); \
    if ((++_sp & 255u) == 0u) { if (xb_ld(&(bar)[XB_TMO])) break; if (_sp > XB_SPIN_CAP) { atomicAdd(&(bar)[XB_TMO], 1u); break; } } } } while (0)

struct XcdBarrier {
    unsigned* bar; unsigned x;
    volatile LAS unsigned* st;
};

__device__ __forceinline__ XcdBarrier xcd_barrier_post(unsigned* bar, volatile LAS unsigned* st) {
    XcdBarrier b; b.bar = bar; b.x = xb_xcc_id(); b.st = st;
    if (threadIdx.x == 0) (void)xb_add(&bar[XB_XCNT(b.x)], 1u);
    return b;
}
__device__ __forceinline__ void xcd_barrier_complete(unsigned* bar, unsigned x, unsigned& nloc, unsigned& nx) {
    const unsigned G = gridDim.x * gridDim.y * gridDim.z;
    unsigned sum, cnt, mine, sp = 0u;
    for (;;) {
        sum = 0u; cnt = 0u; mine = 0u;
#pragma unroll
        for (unsigned j = 0; j < 16; ++j) { const unsigned c = xb_ld(&bar[XB_XCNT(j)]); sum += c; cnt += (c > 0u) ? 1u : 0u; mine = (j == x) ? c : mine; }
        if (sum == G) break;
        __builtin_amdgcn_s_sleep(1);
        if ((++sp & 255u) == 0u) { if (xb_ld(&bar[XB_TMO])) break; if (sp > XB_SPIN_CAP) { atomicAdd(&bar[XB_TMO], 1u); break; } }
    }
    nloc = mine > 0u ? mine : 1u; nx = cnt > 0u ? cnt : 1u;
}

__device__ __forceinline__ void xcd_barrier(const XcdBarrier& b) {
    asm volatile("s_waitcnt vmcnt(0)" ::: "memory");
    __syncthreads();
    if (threadIdx.x == 0) {
        unsigned* bar = b.bar;
        __builtin_amdgcn_s_waitcnt(0);
        unsigned nloc = b.st[0], nx = b.st[1];
        if (nloc == 0u) { xcd_barrier_complete(bar, b.x, nloc, nx); b.st[0] = nloc; b.st[1] = nx; }
        const unsigned old = xb_add(&bar[XB_XSUB(b.x)], 1u);
        const unsigned gen = old / nloc;
        if (old + 1u == (gen + 1u) * nloc) {
            __builtin_amdgcn_fence(__ATOMIC_RELEASE, "agent");
            asm volatile("s_waitcnt vmcnt(0)" ::: "memory");
            const unsigned og = xb_add(&bar[XB_TOP], 1u);
            const unsigned tg = og / nx;
            if (og + 1u == (tg + 1u) * nx) xb_add(&bar[XB_TOPGEN], 1u);
            else XB_SPIN(xb_ld(&bar[XB_TOPGEN]) == tg, bar);
            __builtin_amdgcn_fence(__ATOMIC_ACQUIRE, "agent");
            xb_add(&bar[XB_XGEN(b.x)], 1u);
            asm volatile("s_waitcnt vmcnt(0)" ::: "memory");
        } else {
            XB_SPIN(xb_ld(&bar[XB_XGEN(b.x)]) == gen, bar);
            __builtin_amdgcn_fence(__ATOMIC_ACQUIRE, "agent");
            asm volatile("s_waitcnt vmcnt(0)" ::: "memory");
        }
    }
    __syncthreads();
}
#endif
__device__ __forceinline__ void wt_item(const float* W, int K, int N, bf16* WT, int k0, int n0, int orow0, LAS float* scr, int lane) {
#pragma unroll 8
    for (int i = 0; i < 32; ++i) { const int kk = 2 * i + (lane >> 5); scr[kk * 33 + (lane & 31)] = W[(size_t)(k0 + kk) * N + n0 + (lane & 31)]; }
    WG_BARRIER_WAVE();
    const int c = lane & 7;
#pragma unroll
    for (int j = 0; j < 4; ++j) { const int n = (lane >> 3) + 8 * j; const LAS float* s = scr + (8 * c) * 33 + n;
        u32x4 o; o.x = pk2(s[0 * 33], s[1 * 33]); o.y = pk2(s[2 * 33], s[3 * 33]); o.z = pk2(s[4 * 33], s[5 * 33]); o.w = pk2(s[6 * 33], s[7 * 33]);
        *(u32x4*)(WT + (size_t)(orow0 + n) * K + k0 + 8 * c) = o; }
    WG_BARRIER_WAVE();
}
constexpr int WT_SCR = 64 * 65 * 4;
struct WtItem { const float* W; bf16* WT; int K, N, k0, n0, orow0; const float* scale; };
__device__ __forceinline__ void wt_load(const WtItem& it, f32x4 (&v)[16], float& scl, int lane) {
    const float* src = it.W + (size_t)(it.k0 + (lane >> 4)) * it.N + it.n0 + 4 * (lane & 15);
#pragma unroll
    for (int i = 0; i < 16; ++i) v[i] = *(const f32x4*)(src + (size_t)(4 * i) * it.N);
    scl = it.scale ? it.scale[it.k0 + lane] : 1.0f;
}
__device__ __forceinline__ void wt_store(const WtItem& it, const f32x4 (&v)[16], float scl, LAS float* scr, int lane) {
#pragma unroll
    for (int i = 0; i < 16; ++i) { LAS float* d = scr + (4 * i + (lane >> 4)) * 65 + 4 * (lane & 15); const float s = __shfl(scl, 4 * i + (lane >> 4)); d[0] = v[i].x * s; d[1] = v[i].y * s; d[2] = v[i].z * s; d[3] = v[i].w * s; }
    WG_BARRIER_WAVE();
    const int c = lane & 7;
#pragma unroll
    for (int j = 0; j < 8; ++j) { const int n = (lane >> 3) + 8 * j; const LAS float* s = scr + (8 * c) * 65 + n;
        u32x4 o; o.x = pk2(s[0 * 65], s[1 * 65]); o.y = pk2(s[2 * 65], s[3 * 65]); o.z = pk2(s[4 * 65], s[5 * 65]); o.w = pk2(s[6 * 65], s[7 * 65]);
        *(u32x4*)(it.WT + (size_t)(it.orow0 + n) * it.K + it.k0 + 8 * c) = o; }
    WG_BARRIER_WAVE();
}
struct WtJob { const float* W; bf16* WT; int K, N, mode; const float* scale; };
__device__ __forceinline__ int wt_items(const WtJob& j) { return (j.K / 64) * (j.N / 64); }
__device__ __forceinline__ WtItem wt_item_of(const WtJob& j, int item) {
    const int nblk = j.N / 64, kb = item / nblk, nb = item - kb * nblk, n0 = 64 * nb;
    const int orow0 = j.mode == 0 ? n0 : ((n0 >> 7) * 256 + (j.mode == 2 ? 128 : 0) + (n0 & 127));
    return WtItem{j.W, j.WT, j.K, j.N, 64 * kb, n0, orow0, j.scale};
}
__device__ __forceinline__ void wt_run(const WtJob& j, int item, LAS float* scr, int lane) {
    const WtItem it = wt_item_of(j, item); f32x4 v[16]; float scl; wt_load(it, v, scl, lane); wt_store(it, v, scl, scr, lane);
}
__device__ __forceinline__ void rms_row(const float* xrow, const float* w, float* xcopy, bf16* obf, float* of32, int lane) {
    const f32x4* xr = (const f32x4*)xrow + lane; const f32x4* wr = (const f32x4*)w + lane;
    f32x4 v[8]; float ss = 0.f;
#pragma unroll
    for (int j = 0; j < 8; ++j) { v[j] = xr[64 * j]; ss += (v[j].x * v[j].x + v[j].y * v[j].y) + (v[j].z * v[j].z + v[j].w * v[j].w); }
    if (xcopy) {
#pragma unroll
        for (int j = 0; j < 8; ++j) ((f32x4*)xcopy + lane)[64 * j] = v[j]; }
    const float r = 1.0f / sqrtf(wave_sum(ss) * (1.0f / DM) + EPS);
#pragma unroll
    for (int j = 0; j < 8; ++j) { const f32x4 ww = wr[64 * j]; f32x4 y; y.x = v[j].x * r * ww.x; y.y = v[j].y * r * ww.y; y.z = v[j].z * r * ww.z; y.w = v[j].w * r * ww.w;
        if (obf) { u32x2 o; o.x = pk2(y.x, y.y); o.y = pk2(y.z, y.w); ((u32x2*)obf + lane)[64 * j] = o; }
        if (of32) ((f32x4*)of32 + lane)[64 * j] = y; }
}

__device__ __forceinline__ void rms_rows(const float* x, const float* w, float* xcopy, bf16* obf, float* of32, int nrows, int gw, int NGW, int lane) {
    const f32x4* wr = (const f32x4*)w + lane;
    f32x4 v[8], vn[8];
    int m = gw;
    if (m < nrows) { const f32x4* xr = (const f32x4*)(x + (size_t)m * DM) + lane;
#pragma unroll
        for (int j = 0; j < 8; ++j) v[j] = xr[64 * j]; }
#pragma unroll 1
    while (m < nrows) {
        const int mn = m + NGW;
        if (mn < nrows) { const f32x4* xr = (const f32x4*)(x + (size_t)mn * DM) + lane;
#pragma unroll
            for (int j = 0; j < 8; ++j) vn[j] = xr[64 * j]; }
        float ss = 0.f;
#pragma unroll
        for (int j = 0; j < 8; ++j) ss += (v[j].x * v[j].x + v[j].y * v[j].y) + (v[j].z * v[j].z + v[j].w * v[j].w);
        if (xcopy) {
#pragma unroll
            for (int j = 0; j < 8; ++j) ((f32x4*)(xcopy + (size_t)m * DM) + lane)[64 * j] = v[j]; }
        const float r = FAST_RSQ(wave_sum(ss) * (1.0f / DM) + EPS);
#pragma unroll
        for (int j = 0; j < 8; ++j) { const f32x4 ww = wr[64 * j]; f32x4 y; y.x = v[j].x * r * ww.x; y.y = v[j].y * r * ww.y; y.z = v[j].z * r * ww.z; y.w = v[j].w * r * ww.w;
            if (obf) { u32x2 o; o.x = pk2(y.x, y.y); o.y = pk2(y.z, y.w); ((u32x2*)(obf + (size_t)m * DM) + lane)[64 * j] = o; }
            if (of32) ((f32x4*)(of32 + (size_t)m * DM) + lane)[64 * j] = y; }
#pragma unroll
        for (int j = 0; j < 8; ++j) v[j] = vn[j];
        m = mn;
    }
}
__device__ __forceinline__ void rms_h_load(const bf16* xh, int m, u32x4 (&v)[4], int lane) {
    const u32x4* xr = (const u32x4*)(xh + (size_t)m * DM) + lane;
#pragma unroll
    for (int j = 0; j < 4; ++j) v[j] = xr[64 * j];
}
__device__ __forceinline__ void rms_h_finish(const u32x4 (&v)[4], const float* w, bf16* obf, float* of32, int m, int lane) {
    const f32x4* wr = (const f32x4*)w + 2 * lane;
    float ss = 0.f;
#pragma unroll
    for (int j = 0; j < 4; ++j) { const float a0 = bflo(v[j].x), a1 = bfhi(v[j].x), a2 = bflo(v[j].y), a3 = bfhi(v[j].y), a4 = bflo(v[j].z), a5 = bfhi(v[j].z), a6 = bflo(v[j].w), a7 = bfhi(v[j].w);
        ss += ((a0 * a0 + a1 * a1) + (a2 * a2 + a3 * a3)) + ((a4 * a4 + a5 * a5) + (a6 * a6 + a7 * a7)); }
    const float r = FAST_RSQ(wave_sum(ss) * (1.0f / DM) + EPS);
#pragma unroll
    for (int j = 0; j < 4; ++j) { const f32x4 w0 = wr[128 * j], w1 = wr[128 * j + 1];
        f32x4 y0, y1; y0.x = bflo(v[j].x) * r * w0.x; y0.y = bfhi(v[j].x) * r * w0.y; y0.z = bflo(v[j].y) * r * w0.z; y0.w = bfhi(v[j].y) * r * w0.w;
        y1.x = bflo(v[j].z) * r * w1.x; y1.y = bfhi(v[j].z) * r * w1.y; y1.z = bflo(v[j].w) * r * w1.z; y1.w = bfhi(v[j].w) * r * w1.w;
        if (obf) { u32x4 o; o.x = pk2(y0.x, y0.y); o.y = pk2(y0.z, y0.w); o.z = pk2(y1.x, y1.y); o.w = pk2(y1.z, y1.w); ((u32x4*)(obf + (size_t)m * DM) + lane)[64 * j] = o; }
        if (of32) { f32x4* op = (f32x4*)(of32 + (size_t)m * DM) + 2 * lane; op[128 * j] = y0; op[128 * j + 1] = y1; } }
}
__device__ __forceinline__ void rms_rows_h(const bf16* xh, const float* w, bf16* obf, float* of32, int nrows, int gw, int NGW, int lane) {
    u32x4 v[4], vn[4];
    int m = gw;
    if (m < nrows) rms_h_load(xh, m, v, lane);
#pragma unroll 1
    while (m < nrows) {
        const int mn = m + NGW;
        if (mn < nrows) rms_h_load(xh, mn, vn, lane);
        rms_h_finish(v, w, obf, of32, m, lane);
#pragma unroll
        for (int j = 0; j < 4; ++j) v[j] = vn[j];
        m = mn;
    }
}
__device__ __forceinline__ void cvt_rows(const float* x, float* xcopy, bf16* obf, float* rout, int nrows, int gw, int NGW, int lane) {
#pragma unroll 1
    for (int m = gw; m < nrows; m += NGW) { const f32x4* xr = (const f32x4*)(x + (size_t)m * DM) + 2 * lane;
        f32x4 a[4], b[4]; float ss = 0.f;
#pragma unroll
        for (int j = 0; j < 4; ++j) { a[j] = xr[128 * j]; b[j] = xr[128 * j + 1]; }
#pragma unroll
        for (int j = 0; j < 4; ++j) { u32x4 o; o.x = pk2(a[j].x, a[j].y); o.y = pk2(a[j].z, a[j].w); o.z = pk2(b[j].x, b[j].y); o.w = pk2(b[j].z, b[j].w); ((u32x4*)(obf + (size_t)m * DM) + lane)[64 * j] = o;
            ss += ((a[j].x * a[j].x + a[j].y * a[j].y) + (a[j].z * a[j].z + a[j].w * a[j].w)) + ((b[j].x * b[j].x + b[j].y * b[j].y) + (b[j].z * b[j].z + b[j].w * b[j].w));
            if (xcopy) { f32x4* xc = (f32x4*)(xcopy + (size_t)m * DM) + 2 * lane; xc[128 * j] = a[j]; xc[128 * j + 1] = b[j]; } }
        const float r = FAST_RSQ(wave_sum(ss) * (1.0f / DM) + EPS);
        if (lane == 0) rout[m] = r;
    }
}
__device__ __forceinline__ void slots_to_r(const float* sl, float* rout, int nrows, int tlin, int ntlin) {
#pragma unroll 1
    for (int i = tlin; i < nrows * 8; i += ntlin) { const f32x4 v = ((const f32x4*)sl)[i]; float s = (v.x + v.y) + (v.z + v.w);
        s += __shfl_xor(s, 1); s += __shfl_xor(s, 2); s += __shfl_xor(s, 4);
        if ((i & 7) == 0) rout[i >> 3] = FAST_RSQ(s * (1.0f / DM) + EPS); }
}
struct GdnP {
    const bf16* proj;
    const float* ba;
    const float* wconv;
    const float* a_log;
    const float* dt_bias;
    const float* conv_state;
    const float* rec_state;
    float* out_pconv;
    float* out_sconv;
    float* out_prec;
    float* out_srec;
    bf16 *U, *WN, *QG, *KG, *QK;
    float* DEC;
    bf16* o;
};


__device__ __forceinline__ void store_frag16(bf16* fragbase, size_t subtile_stride, const f32x16& v, int lane) {
    const int h = lane >> 5, l31 = lane & 31;
    bf16* fb = fragbase + (size_t)(l31 >> 4) * subtile_stride;
#pragma unroll
    for (int g = 0; g < 4; ++g) { const int lanep = (l31 & 15) + 16 * (2 * (g & 1) + h);
        u32x2 w; w.x = pk2(v[4 * g], v[4 * g + 1]); w.y = pk2(v[4 * g + 2], v[4 * g + 3]);
        *(u32x2*)(fb + lanep * 8 + 4 * (g >> 1)) = w; }
}
__device__ __forceinline__ int perm16(int q, int j) { return 16 * (j >> 2) + 4 * q + (j & 3); }
constexpr int PL_QN = 0, PL_KN = 17408, PL_KT = 34816, PL_VT = 53248, PL_LT = 90112, PL_TB = 126976, PL_END = 129536;

template <int C> struct PrepIn { float s0_b, s0_a; float w0[2], w1[2], w2[2], w3[2]; unsigned hw[3]; f32x2 hs[3]; unsigned xr[C / 2]; };
template <int C>
__device__ __forceinline__ void gdn_prep_fetch(const GdnP& p, int cidx, int hk, PrepIn<C>& in, int lane, int wid) {
    constexpr bool SAMPLE = (C == 32); constexpr int NT = C / 2;
    const int bsm = cidx - NCH;
    const int row0 = SAMPLE ? SEQ + 32 * bsm : 64 * cidx;
    in.s0_b = 0.f; in.s0_a = 0.f;
    if (wid < 2 && lane < C) { const float* bar = p.ba + (size_t)(row0 + lane) * 64; in.s0_b = bar[2 * hk + wid]; in.s0_a = bar[32 + 2 * hk + wid]; }
    const int arr = wid & 3, half = wid >> 2;
    const int chbase = arr == 0 ? hk * 128 : (arr == 1 ? 2048 + hk * 128 : 4096 + (2 * hk + (arr - 2)) * 128);
    const int ch = chbase + 2 * lane;
#pragma unroll
    for (int e = 0; e < 2; ++e) { in.w0[e] = p.wconv[0 * 8192 + ch + e]; in.w1[e] = p.wconv[1 * 8192 + ch + e]; in.w2[e] = p.wconv[2 * 8192 + ch + e]; in.w3[e] = p.wconv[3 * 8192 + ch + e]; }
    const int t0 = half * (C / 2);
#pragma unroll
    for (int q = 0; q < 3; ++q) { const int t = t0 - 3 + q; const int rr = row0 + t; const int rc = SAMPLE ? row0 + (t < 0 ? 0 : t) : (rr < 0 ? 0 : rr);
        in.hw[q] = *(const unsigned*)(p.proj + (size_t)rc * PPITCH + ch);
        if (SAMPLE) { const int si = (3 + t) < 0 ? 0 : ((3 + t) > 2 ? 2 : (3 + t)); in.hs[q] = *(const f32x2*)(p.conv_state + ((size_t)bsm * 3 + si) * 8192 + ch); } else in.hs[q] = (f32x2){0.f, 0.f}; }
#pragma unroll
    for (int tt = 0; tt < NT; ++tt) in.xr[tt] = *(const unsigned*)(p.proj + (size_t)(row0 + t0 + tt) * PPITCH + ch);
}
template <int C>
__device__ __forceinline__ void gdn_prep_unit(const GdnP& p, LAS unsigned char* lds, int cidx, int hk, PrepIn<C>& in, int nx_cidx, int nx_hk) {
    constexpr int NM = C / 32, NKS = C / 16;
    constexpr bool SAMPLE = (C == 32);
    const int tid = tid_opaque(), lane = tid & 63, wid = RFL(tid >> 6), h = lane >> 5, l31 = lane & 31;
    const int bsm = cidx - NCH;
    const int row0 = SAMPLE ? SEQ + 32 * bsm : 64 * cidx;
    LAS bf16* QN = (LAS bf16*)(lds + PL_QN);
    LAS bf16* KN = (LAS bf16*)(lds + PL_KN);
    LAS bf16* KT = (LAS bf16*)(lds + PL_KT);
    LAS bf16* VT = (LAS bf16*)(lds + PL_VT);
    LAS float* LT = (LAS float*)(lds + PL_LT);
    LAS float* TB = (LAS float*)(lds + PL_TB);
    const float s0_b = in.s0_b, s0_a = in.s0_a;
    {
        const int arr = wid & 3, half = wid >> 2;
        const int chbase = arr == 0 ? hk * 128 : (arr == 1 ? 2048 + hk * 128 : 4096 + (2 * hk + (arr - 2)) * 128);
        const int ch = chbase + 2 * lane;
        float w0[2], w1[2], w2[2], w3[2];
#pragma unroll
        for (int e = 0; e < 2; ++e) { w0[e] = in.w0[e]; w1[e] = in.w1[e]; w2[e] = in.w2[e]; w3[e] = in.w3[e]; }
        const int t0 = half * (C / 2);
        float xw[3][2];
#pragma unroll
        for (int q = 0; q < 3; ++q) { const int t = t0 - 3 + q; const int rr = row0 + t; float a = bflo(in.hw[q]), b = bfhi(in.hw[q]);
            if (SAMPLE) { if (t < 0) { a = in.hs[q].x; b = in.hs[q].y; } } else if (rr < 0) { a = 0.f; b = 0.f; }
            xw[q][0] = a; xw[q][1] = b; }
        const bool lastchunk = SAMPLE || (cidx == NCH - 1);
        constexpr int NT = C / 2;
        unsigned xr[NT];
#pragma unroll
        for (int tt = 0; tt < NT; ++tt) xr[tt] = in.xr[tt];
        float ya[NT], yb[NT];
#pragma unroll
        for (int tt = 0; tt < NT; ++tt) {
            const int c = t0 + tt;
            const float x0 = bflo(xr[tt]), x1 = bfhi(xr[tt]);
            const float y0 = w0[0] * xw[0][0] + w1[0] * xw[1][0] + w2[0] * xw[2][0] + w3[0] * x0;
            const float y1 = w0[1] * xw[0][1] + w1[1] * xw[1][1] + w2[1] * xw[2][1] + w3[1] * x1;
            xw[0][0] = xw[1][0]; xw[0][1] = xw[1][1]; xw[1][0] = xw[2][0]; xw[1][1] = xw[2][1]; xw[2][0] = x0; xw[2][1] = x1;
            ya[tt] = siluf_(y0); yb[tt] = siluf_(y1);
        }
        if (lastchunk && half == 1) {
#pragma unroll
            for (int q = 0; q < 3; ++q) { const unsigned w = xr[NT - 3 + q]; float* dst = SAMPLE ? p.out_sconv + ((size_t)bsm * 3 + q) * 8192 + ch : p.out_pconv + (size_t)q * 8192 + ch; dst[0] = bflo(w); dst[1] = bfhi(w); } }
        if (arr < 2) {
            LAS float* scr = (LAS float*)(lds + PL_LT) + (arr + 2 * half) * 2304;
            LAS float* PS = scr + 64 * (NT + 1); LAS float* SC = PS + 64;
#pragma unroll
            for (int tt = 0; tt < NT; ++tt) scr[lane * (NT + 1) + tt] = ya[tt] * ya[tt] + yb[tt] * yb[tt];
            WG_BARRIER_WAVE();
            { const int tq = lane & (NT - 1), part = lane / NT; float s = 0.f;
#pragma unroll
              for (int r = 0; r < NT; ++r) s += scr[(part * NT + r) * (NT + 1) + tq];
              PS[lane] = s; }
            WG_BARRIER_WAVE();
            if (lane < NT) { float s = 0.f;
#pragma unroll
                for (int q = 0; q < 64 / NT; ++q) s += PS[q * NT + lane];
                SC[lane] = FAST_RSQ(s + EPS) * (arr == 0 ? 0.08838834764831845f : 1.0f); }
            WG_BARRIER_WAVE();
#pragma unroll
            for (int tt = 0; tt < NT; ++tt) { const int c = t0 + tt; const float r = SC[tt]; const float y0 = ya[tt] * r, y1 = yb[tt] * r;
                if (arr == 0) *(LAS unsigned*)(QN + c * 136 + 2 * lane) = pk2(y0, y1);
                else { const unsigned w = pk2(y0, y1); *(LAS unsigned*)(KN + c * 136 + 2 * lane) = w; KT[(2 * lane) * 72 + c] = (bf16)(w & 0xffffu); KT[(2 * lane + 1) * 72 + c] = (bf16)(w >> 16); } }
        } else {
#pragma unroll
            for (int tt = 0; tt < NT; ++tt) { const int c = t0 + tt; const unsigned w = pk2(ya[tt], yb[tt]); LAS bf16* vt = VT + ((arr - 2) * 128 + 2 * lane) * 72 + c; vt[0] = (bf16)(w & 0xffffu); vt[72] = (bf16)(w >> 16); }
        }
    }
    if (wid < 2) {
        const int hvl = wid, hv = 2 * hk + hvl, c = lane;
        float g = 0.f, beta = 0.f;
        if (c < C) { beta = sigmoidf_(s0_b); g = -__expf(p.a_log[hv]) * softplusf_(s0_a + p.dt_bias[hv]); }
        float gc = g;
#pragma unroll
        for (int d = 1; d < 64; d <<= 1) { const float t = __shfl_up(gc, d); if (lane >= d) gc += t; }
        const float glast = __shfl(gc, C - 1);
        if (c < C) { const float eg = __expf(gc);
            TB[(0 * 2 + hvl) * 64 + c] = beta; TB[(1 * 2 + hvl) * 64 + c] = gc; TB[(2 * 2 + hvl) * 64 + c] = beta * eg;
            TB[(3 * 2 + hvl) * 64 + c] = eg; TB[(4 * 2 + hvl) * 64 + c] = __expf(glast - gc); }
        if (lane == 0) p.DEC[cidx * 32 + hv] = __expf(glast);
    }
    if (nx_cidx >= 0) gdn_prep_fetch<C>(p, nx_cidx, nx_hk, in, lane, wid);
    WG_BARRIER();
    {
        const int kind = wid >> 2, mr = (wid >> 1) & 1, mc = wid & 1;
        const bool act = (mr < NM) && (mc < NM) && !(kind == 1 && mr > mc);
        if (act) {
            f32x16 acc;
#pragma unroll
            for (int r = 0; r < 16; ++r) acc[r] = 0.f;
            const LAS bf16* Arow = KN + (32 * mr + l31) * 136 + 8 * h;
            const LAS bf16* Brow = (kind == 0 ? KN : QN) + (32 * mc + l31) * 136 + 8 * h;
#pragma unroll
            for (int s = 0; s < 8; ++s) acc = MFMA32(*(const LAS bf16x8*)(Arow + 16 * s), *(const LAS bf16x8*)(Brow + 16 * s), acc);
            const int colx = 32 * mc + l31;
#pragma unroll
            for (int hvl = 0; hvl < 2; ++hvl) {
                const LAS float* beta = TB + (0 * 2 + hvl) * 64; const LAS float* gcv = TB + (1 * 2 + hvl) * 64;
                const float gcol = gcv[colx];
                f32x4 gr[4], br[4];
#pragma unroll
                for (int gq = 0; gq < 4; ++gq) { gr[gq] = *(const LAS f32x4*)(gcv + 32 * mr + 8 * gq + 4 * h); if (kind == 0) br[gq] = *(const LAS f32x4*)(beta + 32 * mr + 8 * gq + 4 * h); }
                if (kind == 0) {
#pragma unroll
                    for (int r = 0; r < 16; ++r) { const int c = 32 * mr + accrow(r, h); const float gcr = gr[r >> 2][r & 3], bcr = br[r >> 2][r & 3];
                        const float e = __expf(fminf(gcr - gcol, 0.f));
                        LT[(hvl * 64 + c) * 72 + colx] = (c > colx) ? bcr * acc[r] * e : 0.f; }
                } else {
                    float v[16];
#pragma unroll
                    for (int r = 0; r < 16; ++r) { const int cp = 32 * mr + accrow(r, h); const float e = __expf(fminf(gcol - gr[r >> 2][r & 3], 0.f)); v[r] = (colx >= cp) ? acc[r] * e : 0.f; }
                    f32x16 vv;
#pragma unroll
                    for (int r = 0; r < 16; ++r) vv[r] = v[r];
                    store_frag16(p.QK + (size_t)(cidx * 32 + 2 * hk + hvl) * 4096 + (size_t)((2 * mc) * NM + mr) * 512, (size_t)NM * 512, vv, lane);
                }
            }
        }
    }
    WG_BARRIER();
    if (wid < 2) {
        const int hvl = wid; LAS float* L = LT + hvl * 64 * 72;
        const int blk = (C == 64) ? h : 0;
        const bool lact = (C == 64) || lane < 32;
        const LAS float* Lb = L + (32 * blk) * 72 + 32 * blk;
        float T[32];
#pragma unroll
        for (int i = 0; i < 32; ++i) {
            float s0 = (i == l31) ? 1.f : 0.f, s1 = 0.f, s2 = 0.f, s3 = 0.f;
#pragma unroll
            for (int j4 = 0; j4 < i; j4 += 4) { const f32x4 lv = *(const LAS f32x4*)(Lb + i * 72 + j4);
                s0 -= lv.x * T[j4]; if (j4 + 1 < i) s1 -= lv.y * T[j4 + 1]; if (j4 + 2 < i) s2 -= lv.z * T[j4 + 2]; if (j4 + 3 < i) s3 -= lv.w * T[j4 + 3]; }
            float s = (s0 + s1) + (s2 + s3);
            PIN_F(s);
            T[i] = s;
        }
        f32x16 X;
        if (C == 64) {
            LAS bf16* scrA = (LAS bf16*)(L + l31 * 72 + 32);
            if (h == 0) {
#pragma unroll
                for (int q = 0; q < 4; ++q) *(LAS u32x4*)(scrA + 8 * q) = (u32x4){pk2(T[8 * q], T[8 * q + 1]), pk2(T[8 * q + 2], T[8 * q + 3]), pk2(T[8 * q + 4], T[8 * q + 5]), pk2(T[8 * q + 6], T[8 * q + 7])};
            } else {
#pragma unroll
                for (int i = 0; i < 32; ++i) ((LAS bf16*)(L + i * 72 + 32))[32 + l31] = (bf16)f2bf(T[i]);
            }
            WG_BARRIER_WAVE();
            f32x16 Pm;
#pragma unroll
            for (int r = 0; r < 16; ++r) Pm[r] = 0.f;
#pragma unroll
            for (int s = 0; s < 2; ++s) { const LAS float* ar = L + (32 + l31) * 72 + 16 * s + 8 * h; const f32x4 a0 = *(const LAS f32x4*)ar, a1 = *(const LAS f32x4*)(ar + 4);
                const bf16x8 af = pack8(a0.x, a0.y, a0.z, a0.w, a1.x, a1.y, a1.z, a1.w);
                const bf16x8 bfr = *(const LAS bf16x8*)(scrA + 16 * s + 8 * h);
                Pm = MFMA32(af, bfr, Pm); }
#pragma unroll
            for (int r = 0; r < 16; ++r) X[r] = 0.f;
#pragma unroll
            for (int s = 0; s < 2; ++s) { const LAS bf16* tb = scrA + 32 + 16 * s + 4 * h; const u32x2 x0 = *(const LAS u32x2*)tb, x1 = *(const LAS u32x2*)(tb + 8);
                X = MFMA32(__builtin_bit_cast(bf16x8, (u32x4){x0.x, x0.y, x1.x, x1.y}), acc_frag(Pm, s), X); }
        }
        WG_BARRIER_WAVE();
        LAS bf16* TU = (LAS bf16*)L; LAS bf16* TW = TU + 64 * 72;
        if (lact) {
            const int col = 32 * blk + l31;
            const float bcol = TB[(0 * 2 + hvl) * 64 + col], bbcol = TB[(2 * 2 + hvl) * 64 + col];
#pragma unroll
            for (int i = 0; i < 32; ++i) { TU[(32 * blk + i) * 72 + col] = (bf16)f2bf(T[i] * bcol); TW[(32 * blk + i) * 72 + col] = (bf16)f2bf(T[i] * bbcol); }
        }
        if (C == 64) {
            const float bc0 = TB[(0 * 2 + hvl) * 64 + l31], bbc0 = TB[(2 * 2 + hvl) * 64 + l31];
#pragma unroll
            for (int r = 0; r < 16; ++r) { const int i = accrow(r, h);
                TU[(32 + i) * 72 + l31] = (bf16)f2bf(-X[r] * bc0); TW[(32 + i) * 72 + l31] = (bf16)f2bf(-X[r] * bbc0);
                TU[i * 72 + 32 + l31] = (bf16)0; TW[i * 72 + 32 + l31] = (bf16)0; }
        }
    } else {
        constexpr int NCT = C / 16, NKC = C / 32;
    #pragma unroll 1
        for (int it = tid - 128; it < 2 * NCT * 4 * 64; it += 384) {
            const int ln = it & 63, ks = (it >> 6) & 3, ct = (it >> 8) % NCT, hvl = (it >> 8) / NCT, q = ln >> 4;
            const int c = 16 * ct + (ln & 15); const float sc = TB[(3 * 2 + hvl) * 64 + c];
            const LAS bf16* src = QN + c * 136 + 32 * ks + 4 * q;
            const u32x2 a = *(const LAS u32x2*)(src), b = *(const LAS u32x2*)(src + 16);
            *(bf16x8*)(p.QG + (size_t)(cidx * 32 + 2 * hk + hvl) * 8192 + ((ct * 4 + ks) * 64 + ln) * 8) =
                pack8(bflo(a.x) * sc, bfhi(a.x) * sc, bflo(a.y) * sc, bfhi(a.y) * sc, bflo(b.x) * sc, bfhi(b.x) * sc, bflo(b.y) * sc, bfhi(b.y) * sc);
        }
    #pragma unroll 1
        for (int it = tid - 128; it < 2 * 8 * NKC * 64; it += 384) {
            const int ln = it & 63, ks = (it >> 6) % NKC, t = ((it >> 6) / NKC) & 7, hvl = (it >> 6) / (NKC * 8), q = ln >> 4;
            const int dkr = 16 * t + (ln & 15); const int c0 = 32 * ks + 4 * q;
            const LAS bf16* src = KT + dkr * 72 + c0; const LAS float* ek = TB + (4 * 2 + hvl) * 64 + c0;
            const u32x2 a = *(const LAS u32x2*)(src), b = *(const LAS u32x2*)(src + 16);
            *(bf16x8*)(p.KG + (size_t)(cidx * 32 + 2 * hk + hvl) * 8192 + ((t * NKC + ks) * 64 + ln) * 8) =
                pack8(bflo(a.x) * ek[0], bfhi(a.x) * ek[1], bflo(a.y) * ek[2], bfhi(a.y) * ek[3], bflo(b.x) * ek[16], bfhi(b.x) * ek[17], bflo(b.y) * ek[18], bfhi(b.y) * ek[19]);
        }

    }
    WG_BARRIER();
#pragma unroll 1
    for (int t = 0; t < 4; ++t) {
        const int id = wid * 4 + t, hvl = id >> 4, kind = (id >> 3) & 1, idx = id & 7, hv = 2 * hk + hvl;
        const LAS bf16* TU = (const LAS bf16*)(LT + hvl * 64 * 72); const LAS bf16* TW = TU + 64 * 72;
        const int m = kind == 0 ? (idx >> 2) : (idx & 1);
        if (m >= NM) continue;
        f32x16 acc;
#pragma unroll
        for (int r = 0; r < 16; ++r) acc[r] = 0.f;
        const LAS bf16* Arow; const LAS bf16* Brow;
        if (kind == 0) { const int vt = idx & 3; Arow = TU + (32 * m + l31) * 72 + 8 * h; Brow = VT + (hvl * 128 + 32 * vt + l31) * 72 + 8 * h; }
        else { const int i = idx >> 1; Arow = KT + (32 * i + l31) * 72 + 8 * h; Brow = TW + (32 * m + l31) * 72 + 8 * h; }
#pragma unroll
        for (int s = 0; s < NKS; ++s) acc = MFMA32(*(const LAS bf16x8*)(Arow + 16 * s), *(const LAS bf16x8*)(Brow + 16 * s), acc);
        if (kind == 0) {
            const int vt = idx & 3; bf16* ub = p.U + (size_t)(cidx * 32 + hv) * 8192;
#pragma unroll
            for (int gq = 0; gq < 4; ++gq) { const int ct = 2 * m + (gq >> 1), vs = 2 * vt + (l31 >> 4), lanep = (l31 & 15) + 16 * (2 * (gq & 1) + h);
                u32x2 w; w.x = pk2(acc[4 * gq], acc[4 * gq + 1]); w.y = pk2(acc[4 * gq + 2], acc[4 * gq + 3]);
                *(u32x2*)(ub + ((ct * 8 + vs) * 64 + lanep) * 4) = w; } }
        else {
            const int i = idx >> 1;
#pragma unroll
            for (int r = 0; r < 16; ++r) acc[r] = -acc[r];
            store_frag16(p.WN + (size_t)(cidx * 32 + hv) * 8192 + (size_t)((2 * m) * 4 + i) * 512, (size_t)4 * 512, acc, lane); }
    }
    WG_BARRIER();
}

template <int C>
__device__ __forceinline__ void gdn_prep_unit(const GdnP& p, LAS unsigned char* lds, int cidx, int hk) {
    const int tid = tid_opaque(); PrepIn<C> in; gdn_prep_fetch<C>(p, cidx, hk, in, tid & 63, RFL(tid >> 6)); gdn_prep_unit<C>(p, lds, cidx, hk, in, -1, 0);
}
constexpr int SCAN_BUF = 61440;
typedef f32x4 acc4;
__device__ __forceinline__ bf16x8 pack_2tiles(const acc4& a, const acc4& b) { return pack8(a[0], a[1], a[2], a[3], b[0], b[1], b[2], b[3]); }
__device__ __forceinline__ void scan_fetch(u32x4 (&v)[15], const GdnP& p, int cidx, int hv, int vt, int tl) {
    const size_t ub = (size_t)(cidx * 32 + hv);
    const u32x4* s0 = (const u32x4*)(p.WN + ub * 8192); const u32x4* s1 = (const u32x4*)(p.QG + ub * 8192);
    const u32x4* s2 = (const u32x4*)(p.KG + ub * 8192); const u32x4* s3 = (const u32x4*)(p.QK + ub * 4096);
#pragma unroll
    for (int i = 0; i < 4; ++i) { v[i] = s0[i * 256 + tl]; v[4 + i] = s1[i * 256 + tl]; v[8 + i] = s2[i * 256 + tl]; }
    v[12] = s3[tl]; v[13] = s3[256 + tl];
    v[14] = ((const u32x4*)(p.U + ub * 8192))[((tl >> 6) * 8 + 2 * vt + ((tl >> 5) & 1)) * 32 + (tl & 31)];
}
__device__ __forceinline__ void scan_put(const u32x4 (&v)[15], LAS unsigned char* buf, int tl) {
#pragma unroll
    for (int i = 0; i < 15; ++i) { *(LAS u32x4*)(buf + (i * 256 + tl) * 16) = v[i]; LOADER_PACE(); }
}
template <int NCT>
__device__ __forceinline__ void scan16_step(acc4 (&S)[8], const LAS unsigned char* buf, int w, float dec, bf16* orow, int lane) {
    constexpr int NKC = NCT / 2;
    const int q = lane >> 4, l15 = lane & 15;
    const LAS bf16x8* WNf = (const LAS bf16x8*)(buf) + lane;
    const LAS bf16x8* QGf = (const LAS bf16x8*)(buf + 16384) + lane;
    const LAS bf16x8* KGf = (const LAS bf16x8*)(buf + 32768) + lane;
    const LAS bf16x8* QKf = (const LAS bf16x8*)(buf + 49152) + lane;
    bf16x8 Sb[4];
#pragma unroll
    for (int ks = 0; ks < 4; ++ks) Sb[ks] = pack_2tiles(S[2 * ks], S[2 * ks + 1]);
    acc4 V[NCT];
#pragma unroll
    for (int ct = 0; ct < NCT; ++ct) { const u32x2 u = *(const LAS u32x2*)(buf + 57344 + (ct * 2 + w) * 512 + lane * 8);
        V[ct][0] = bflo(u.x); V[ct][1] = bfhi(u.x); V[ct][2] = bflo(u.y); V[ct][3] = bfhi(u.y);
#pragma unroll
        for (int ks = 0; ks < 4; ++ks) V[ct] = MFMA16(WNf[(ct * 4 + ks) * 64], Sb[ks], V[ct]); }
    bf16x8 Vb[NKC];
#pragma unroll
    for (int ks = 0; ks < NKC; ++ks) Vb[ks] = pack_2tiles(V[2 * ks], V[2 * ks + 1]);
#pragma unroll
    for (int ct = 0; ct < NCT; ++ct) { acc4 O = (acc4){0.f, 0.f, 0.f, 0.f};
#pragma unroll
        for (int ks = 0; ks < 4; ++ks) O = MFMA16(Sb[ks], QGf[(ct * 4 + ks) * 64], O);
#pragma unroll
        for (int ks = 0; ks <= (ct >> 1); ++ks) O = MFMA16(Vb[ks], QKf[(ct * NKC + ks) * 64], O);
        u32x2 o2; o2.x = pk2(O[0], O[1]); o2.y = pk2(O[2], O[3]);
        *(u32x2*)(orow + (size_t)(16 * ct + l15) * PPITCH + 4 * q) = o2; }
#pragma unroll
    for (int t = 0; t < 8; ++t) { S[t] = S[t] * dec;
#pragma unroll
        for (int ks = 0; ks < NKC; ++ks) S[t] = MFMA16(KGf[(t * NKC + ks) * 64], Vb[ks], S[t]); }
}
#define SCAN_LD4(dst, p0, p1, p2, p3) do { SCHED_FENCE(); dst[0] = (p0); dst[1] = (p1); dst[2] = (p2); dst[3] = (p3); SCHED_FENCE(); } while (0)
#define SCAN_LD(dst, ...) SCAN_LD4(dst, __VA_ARGS__)
__device__ __forceinline__ void scan16_step2(acc4 (&S)[8], const LAS unsigned char* buf, int w, float dec, bf16* orow, int lane) {
    const int q = lane >> 4, l15 = lane & 15;
    const LAS bf16x8* WNf = (const LAS bf16x8*)(buf) + lane;
    const LAS bf16x8* QGf = (const LAS bf16x8*)(buf + 16384) + lane;
    const LAS bf16x8* KGf = (const LAS bf16x8*)(buf + 32768) + lane;
    const LAS bf16x8* QKf = (const LAS bf16x8*)(buf + 49152) + lane;
#define WN_(ct, ks) WNf[((ct) * 4 + (ks)) * 64]
#define QG_(ct, ks) QGf[((ct) * 4 + (ks)) * 64]
#define KG_(t, ks) KGf[((t) * 2 + (ks)) * 64]
#define QK_(ct, ks) QKf[((ct) * 2 + (ks)) * 64]
#define V_GRP(Fc, ks) do { _Pragma("unroll") for (int ct = 0; ct < 4; ++ct) V[ct] = MFMA16(Fc[ct], Sb[ks], V[ct]); } while (0)
#define Q_GRP(Fc, ks) do { _Pragma("unroll") for (int ct = 0; ct < 4; ++ct) O[ct] = MFMA16(Sb[ks], Fc[ct], O[ct]); } while (0)
    bf16x8 F[6][4];
    u32x2 uu[4];
#pragma unroll
    for (int ct = 0; ct < 4; ++ct) uu[ct] = *(const LAS u32x2*)(buf + 57344 + (ct * 2 + w) * 512 + lane * 8);
    SCAN_LD(F[0], WN_(0, 0), WN_(1, 0), WN_(2, 0), WN_(3, 0));
    SCAN_LD(F[1], WN_(0, 1), WN_(1, 1), WN_(2, 1), WN_(3, 1));
    SCAN_LD(F[2], WN_(0, 2), WN_(1, 2), WN_(2, 2), WN_(3, 2));
    SCAN_LD(F[3], WN_(0, 3), WN_(1, 3), WN_(2, 3), WN_(3, 3));
    SCAN_LD(F[4], QG_(0, 0), QG_(1, 0), QG_(2, 0), QG_(3, 0));
    bf16x8 Sb[4];
    Sb[0] = pack_2tiles(S[0], S[1]); Sb[1] = pack_2tiles(S[2], S[3]); Sb[2] = pack_2tiles(S[4], S[5]); Sb[3] = pack_2tiles(S[6], S[7]);
    acc4 V[4], O[4];
#pragma unroll
    for (int ct = 0; ct < 4; ++ct) { V[ct][0] = bflo(uu[ct].x); V[ct][1] = bfhi(uu[ct].x); V[ct][2] = bflo(uu[ct].y); V[ct][3] = bfhi(uu[ct].y); O[ct] = (acc4){0.f, 0.f, 0.f, 0.f}; }
    bf16x8 Vb0, Vb1;
    SCAN_LD(F[5], QG_(0, 1), QG_(1, 1), QG_(2, 1), QG_(3, 1));
    V_GRP(F[0], 0);
    SCAN_LD(F[0], QG_(0, 2), QG_(1, 2), QG_(2, 2), QG_(3, 2));
    V_GRP(F[1], 1);
    SCAN_LD(F[1], QG_(0, 3), QG_(1, 3), QG_(2, 3), QG_(3, 3));
    V_GRP(F[2], 2);
    SCAN_LD(F[2], QK_(0, 0), QK_(1, 0), QK_(2, 0), QK_(3, 0));
    V_GRP(F[3], 3);
    SCAN_LD(F[3], QK_(2, 1), QK_(3, 1), KG_(0, 0), KG_(1, 0));
    Q_GRP(F[4], 0);
    Vb0 = pack_2tiles(V[0], V[1]); Vb1 = pack_2tiles(V[2], V[3]);
    SCAN_LD(F[4], KG_(2, 0), KG_(3, 0), KG_(4, 0), KG_(5, 0));
    Q_GRP(F[5], 1);
    SCAN_LD(F[5], KG_(6, 0), KG_(7, 0), KG_(0, 1), KG_(1, 1));
    Q_GRP(F[0], 2);
    SCAN_LD(F[0], KG_(2, 1), KG_(3, 1), KG_(4, 1), KG_(5, 1));
    Q_GRP(F[1], 3);
    SCAN_LD(F[1], KG_(6, 1), KG_(7, 1), KG_(6, 1), KG_(7, 1));
    _Pragma("unroll") for (int ct = 0; ct < 4; ++ct) O[ct] = MFMA16(Vb0, F[2][ct], O[ct]);
    _Pragma("unroll") for (int t = 0; t < 8; ++t) S[t] = S[t] * dec;
    O[2] = MFMA16(Vb1, F[3][0], O[2]); O[3] = MFMA16(Vb1, F[3][1], O[3]); S[0] = MFMA16(F[3][2], Vb0, S[0]); S[1] = MFMA16(F[3][3], Vb0, S[1]);
    S[2] = MFMA16(F[4][0], Vb0, S[2]); S[3] = MFMA16(F[4][1], Vb0, S[3]); S[4] = MFMA16(F[4][2], Vb0, S[4]); S[5] = MFMA16(F[4][3], Vb0, S[5]);
    _Pragma("unroll") for (int ct = 0; ct < 4; ++ct) { u32x2 o2; o2.x = pk2(O[ct][0], O[ct][1]); o2.y = pk2(O[ct][2], O[ct][3]); *(u32x2*)(orow + (size_t)(16 * ct + l15) * PPITCH + 4 * q) = o2; }
    S[6] = MFMA16(F[5][0], Vb0, S[6]); S[7] = MFMA16(F[5][1], Vb0, S[7]); S[0] = MFMA16(F[5][2], Vb1, S[0]); S[1] = MFMA16(F[5][3], Vb1, S[1]);
    S[2] = MFMA16(F[0][0], Vb1, S[2]); S[3] = MFMA16(F[0][1], Vb1, S[3]); S[4] = MFMA16(F[0][2], Vb1, S[4]); S[5] = MFMA16(F[0][3], Vb1, S[5]);
    S[6] = MFMA16(F[1][0], Vb1, S[6]); S[7] = MFMA16(F[1][1], Vb1, S[7]);
#undef WN_
#undef QG_
#undef KG_
#undef QK_
#undef V_GRP
#undef Q_GRP
}
template <int NM>
__device__ __forceinline__ void gdn_scan_unit(const GdnP& p, LAS unsigned char* lds, int hv, int vt, int cidx0, int nsteps, const float* s_init, float* s_out, int row0) {
    const int tid = tid_opaque(), lane = tid & 63, wid = RFL(tid >> 6), q = lane >> 4, l15 = lane & 15;
    if (wid < 2) {
        const int vcol = 32 * vt + 16 * wid + l15;
        acc4 S[8];
#pragma unroll
        for (int t = 0; t < 8; ++t)
#pragma unroll
            for (int r = 0; r < 4; ++r) S[t][r] = s_init ? s_init[(size_t)(16 * t + 4 * q + r) * 128 + vcol] : 0.f;
        float dreg[4];
#pragma unroll
        for (int i = 0; i < 4; ++i) { const int ti = 64 * i + lane; dreg[i] = ti < nsteps ? p.DEC[(cidx0 + ti) * 32 + hv] : 0.f; }
        WG_BARRIER();
#pragma unroll 1
        for (int t = 0; t < nsteps; ++t) {
            const int tq = t >> 6; const float dsel = tq == 0 ? dreg[0] : (tq == 1 ? dreg[1] : (tq == 2 ? dreg[2] : dreg[3]));
            const float dec = READLANE_F(dsel, t & 63);
            bf16* orow = p.o + (size_t)(row0 + 32 * NM * t) * PPITCH + hv * 128 + 32 * vt + 16 * wid;
            if constexpr (NM == 2) scan16_step2(S, lds + (t & 1) * SCAN_BUF, wid, dec, orow, lane);
            else scan16_step<2 * NM>(S, lds + (t & 1) * SCAN_BUF, wid, dec, orow, lane);
            WG_BARRIER();
        }
#pragma unroll
        for (int t = 0; t < 8; ++t)
#pragma unroll
            for (int r = 0; r < 4; ++r) s_out[(size_t)(16 * t + 4 * q + r) * 128 + vcol] = S[t][r];
    } else if (wid < 4) {
        WG_BARRIER();
#pragma unroll 1
        for (int t = 0; t < nsteps; ++t) WG_BARRIER();
    } else {
        const int tl = tid - 256; u32x4 la[15], lb[15];
        const int clast = cidx0 + nsteps - 1;
        scan_fetch(la, p, cidx0, hv, vt, tl); scan_put(la, lds, tl);
        if (nsteps > 1) {
            scan_fetch(la, p, cidx0 + 1, hv, vt, tl);
            scan_fetch(lb, p, (cidx0 + 2 < clast ? cidx0 + 2 : clast), hv, vt, tl);
        }
        WG_BARRIER();
        if (nsteps > 1) {
#pragma unroll 1
            for (int t = 0; t < nsteps; t += 2) {
                scan_put(la, lds + SCAN_BUF, tl); { const int cn = cidx0 + t + 3; scan_fetch(la, p, cn < clast ? cn : clast, hv, vt, tl); }
                WG_BARRIER();
                scan_put(lb, lds, tl); { const int cn = cidx0 + t + 4; scan_fetch(lb, p, cn < clast ? cn : clast, hv, vt, tl); }
                WG_BARRIER();
            }
        } else WG_BARRIER();
    }
}

__device__ __forceinline__ void gdn_gate_row(const bf16* prow  , const float* wnorm, bf16* og  , int lane) {
    const u32x4* o4 = (const u32x4*)prow + lane; const u32x4* z4 = (const u32x4*)(prow + GQKV) + lane;
    const f32x4* w4 = (const f32x4*)(wnorm + 8 * (lane & 15));
    const f32x4 wa = w4[0], wb = w4[1];
    u32x4* d4 = (u32x4*)og + lane;
#pragma unroll 1
    for (int qh = 0; qh < 2; ++qh) {
        u32x4 ow[4], zw[4];
#pragma unroll
        for (int q = 0; q < 4; ++q) { ow[q] = o4[64 * (4 * qh + q)]; zw[q] = z4[64 * (4 * qh + q)]; }
#pragma unroll
        for (int q = 0; q < 4; ++q) {
            const u32x4 w = ow[q]; const float o0 = bflo(w.x), o1 = bfhi(w.x), o2 = bflo(w.y), o3 = bfhi(w.y), o5 = bfhi(w.z), o4v = bflo(w.z), o6 = bflo(w.w), o7 = bfhi(w.w);
            float ss = (o0 * o0 + o1 * o1) + (o2 * o2 + o3 * o3) + (o4v * o4v + o5 * o5) + (o6 * o6 + o7 * o7);
            ss += __shfl_xor(ss, 1); ss += __shfl_xor(ss, 2); ss += __shfl_xor(ss, 4); ss += __shfl_xor(ss, 8);
            const float r = FAST_RSQ(ss * (1.0f / 128.0f) + EPS);
            const u32x4 z = zw[q]; u32x4 d;
            d.x = pk2(o0 * r * wa.x * siluf_(bflo(z.x)), o1 * r * wa.y * siluf_(bfhi(z.x)));
            d.y = pk2(o2 * r * wa.z * siluf_(bflo(z.y)), o3 * r * wa.w * siluf_(bfhi(z.y)));
            d.z = pk2(o4v * r * wb.x * siluf_(bflo(z.z)), o5 * r * wb.y * siluf_(bfhi(z.z)));
            d.w = pk2(o6 * r * wb.z * siluf_(bflo(z.w)), o7 * r * wb.w * siluf_(bfhi(z.w)));
            d4[64 * (4 * qh + q)] = d; }
    }
}

__device__ __forceinline__ void gdn_gate_rows(const bf16* proj, const float* wnorm, bf16* og, int gw, int NGW, int lane) {
    const f32x4* w4 = (const f32x4*)(wnorm + 8 * (lane & 15)); const f32x4 wa = w4[0], wb = w4[1];
    u32x4 ow[4], zw[4], on[4], zn[4];
    int m = gw, qh = 0;
    if (m < MTOK) { const u32x4* o4 = (const u32x4*)(proj + (size_t)m * PPITCH) + lane; const u32x4* z4 = (const u32x4*)(proj + (size_t)m * PPITCH + GQKV) + lane;
#pragma unroll
        for (int q = 0; q < 4; ++q) { ow[q] = o4[64 * q]; zw[q] = z4[64 * q]; } }
#pragma unroll 1
    while (m < MTOK) {
        const int mn = qh ? m + NGW : m, qn = qh ^ 1;
        if (mn < MTOK) { const u32x4* o4 = (const u32x4*)(proj + (size_t)mn * PPITCH) + lane; const u32x4* z4 = (const u32x4*)(proj + (size_t)mn * PPITCH + GQKV) + lane;
#pragma unroll
            for (int q = 0; q < 4; ++q) { on[q] = o4[64 * (4 * qn + q)]; zn[q] = z4[64 * (4 * qn + q)]; } }
        u32x4* d4 = (u32x4*)(og + (size_t)m * GZ) + lane;
#pragma unroll
        for (int q = 0; q < 4; ++q) {
            const u32x4 w = ow[q]; const float o0 = bflo(w.x), o1 = bfhi(w.x), o2 = bflo(w.y), o3 = bfhi(w.y), o5 = bfhi(w.z), o4v = bflo(w.z), o6 = bflo(w.w), o7 = bfhi(w.w);
            float ss = (o0 * o0 + o1 * o1) + (o2 * o2 + o3 * o3) + (o4v * o4v + o5 * o5) + (o6 * o6 + o7 * o7);
            ss += __shfl_xor(ss, 1); ss += __shfl_xor(ss, 2); ss += __shfl_xor(ss, 4); ss += __shfl_xor(ss, 8);
            const float r = FAST_RSQ(ss * (1.0f / 128.0f) + EPS);
            const u32x4 z = zw[q]; u32x4 d;
            d.x = pk2(o0 * r * wa.x * siluf_(bflo(z.x)), o1 * r * wa.y * siluf_(bfhi(z.x)));
            d.y = pk2(o2 * r * wa.z * siluf_(bflo(z.y)), o3 * r * wa.w * siluf_(bfhi(z.y)));
            d.z = pk2(o4v * r * wb.x * siluf_(bflo(z.z)), o5 * r * wb.y * siluf_(bfhi(z.z)));
            d.w = pk2(o6 * r * wb.z * siluf_(bflo(z.w)), o7 * r * wb.w * siluf_(bfhi(z.w)));
            d4[64 * (4 * qh + q)] = d; }
#pragma unroll
        for (int q = 0; q < 4; ++q) { ow[q] = on[q]; zw[q] = zn[q]; }
        m = mn; qh = qn;
    }
}
struct AttP {
    const bf16* qkv;
    const float* cache_k;
    const float* cache_v;
    const float* relb;
    bf16* ao;
};
constexpr int AL_K = 0, AL_VT = 17408, AL_VP = 160, AL_TILE = AL_VT + 64 * AL_VP * 2, AL_BIAS = 2 * AL_TILE, AL_END = AL_BIAS + 2064;
constexpr int QKVP = 6144;
constexpr float ATT_SCALE = 0.08838834764831845f;

struct AttTileRegs { u32x4 k[2], v[2]; };
__device__ __forceinline__ void att_load_bf16(AttTileRegs& R, const bf16* krow0, const bf16* vrow0, size_t pitch, int nkeys, int tid) {
#pragma unroll
    for (int i = 0; i < 2; ++i) { const int id = tid + 512 * i, key = id >> 4, part = id & 15;
        R.k[i] = key < nkeys ? *(const u32x4*)(krow0 + (size_t)key * pitch + part * 8) : (u32x4){0u, 0u, 0u, 0u};
        R.v[i] = key < nkeys ? *(const u32x4*)(vrow0 + (size_t)key * pitch + part * 8) : (u32x4){0u, 0u, 0u, 0u}; }
}
__device__ __forceinline__ void att_load_f32(AttTileRegs& R, const float* krow0, const float* vrow0, size_t pitch, int tid) {
#pragma unroll
    for (int i = 0; i < 2; ++i) { const int id = tid + 512 * i, key = id >> 4, part = id & 15;
        const f32x4* ks = (const f32x4*)(krow0 + (size_t)key * pitch + part * 8); const f32x4* vs = (const f32x4*)(vrow0 + (size_t)key * pitch + part * 8);
        const f32x4 a = ks[0], b = ks[1], c = vs[0], d = vs[1];
        R.k[i] = (u32x4){pk2(a.x, a.y), pk2(a.z, a.w), pk2(b.x, b.y), pk2(b.z, b.w)};
        R.v[i] = (u32x4){pk2(c.x, c.y), pk2(c.z, c.w), pk2(d.x, d.y), pk2(d.z, d.w)}; }
}
__device__ __forceinline__ void att_store_tile(const AttTileRegs& R, LAS unsigned char* lds, int tid) {
    LAS bf16* K = (LAS bf16*)(lds + AL_K); LAS bf16* V = (LAS bf16*)(lds + AL_VT);
#pragma unroll
    for (int i = 0; i < 2; ++i) { const int id = tid + 512 * i, key = id >> 4, part = id & 15;
        *(LAS u32x4*)(K + key * 136 + part * 8) = R.k[i];
        *(LAS u32x4*)(V + key * AL_VP + part * 8) = R.v[i]; }
}
struct AttState { f32x16 OT[4]; float m, l; };
constexpr float ATT_C1 = ATT_SCALE * 1.4426950408889634f;
constexpr float ATT_DEFER = 8.0f;
template <int NSUB>
__device__ __forceinline__ void att_tile(AttState& st, const bf16x8 (&qf)[8], const LAS unsigned char* lds, const LAS unsigned char* ldsb, int rel0, int lane, int nvalid = 64) {
    const int h = lane >> 5, l31 = lane & 31;
    const LAS bf16* K = (const LAS bf16*)(lds + AL_K); const LAS bf16* V = (const LAS bf16*)(lds + AL_VT); const LAS float* bias = (const LAS float*)(ldsb + AL_BIAS);
    f32x16 sc[NSUB]; float mx = -1e30f;
#pragma unroll
    for (int sub = 0; sub < NSUB; ++sub) {
#pragma unroll
        for (int r = 0; r < 16; ++r) sc[sub][r] = 0.f;
        const LAS bf16* Arow = K + (32 * sub + l31) * 136 + 8 * h;
#pragma unroll
        for (int s = 0; s < 8; ++s) sc[sub] = MFMA32(*(const LAS bf16x8*)(Arow + 16 * s), qf[s], sc[sub]);
        if (rel0 - 63 >= MAXREL) {
            const float bc = bias[2 * MAXREL];
#pragma unroll
            for (int r = 0; r < 16; ++r) { const float x = sc[sub][r] * ATT_C1 + bc; sc[sub][r] = x; mx = fmaxf(mx, x); }
        } else {
#pragma unroll
            for (int r = 0; r < 16; ++r) { int rel = rel0 + l31 - (32 * sub + accrow(r, h)); rel = rel < -MAXREL ? -MAXREL : (rel > MAXREL ? MAXREL : rel);
                const float x = sc[sub][r] * ATT_C1 + bias[rel + MAXREL]; sc[sub][r] = x; mx = fmaxf(mx, x); }
        }
    }
    if (nvalid < 64) {
        mx = -1e30f;
#pragma unroll
        for (int sub = 0; sub < NSUB; ++sub)
#pragma unroll
            for (int r = 0; r < 16; ++r) { if (32 * sub + accrow(r, h) >= nvalid) sc[sub][r] = -1e30f; mx = fmaxf(mx, sc[sub][r]); }
    }
    mx = fmaxf(mx, __shfl_xor(mx, 32));
    if (ANY_LANE(mx > st.m + ATT_DEFER)) {
        const float mnew = fmaxf(st.m, mx), alpha = FAST_EXP2(st.m - mnew);
        st.m = mnew; st.l *= alpha;
#pragma unroll
        for (int dt = 0; dt < 4; ++dt)
#pragma unroll
            for (int r = 0; r < 16; ++r) st.OT[dt][r] *= alpha;
    }
    const float mcur = st.m; float ps = 0.f;
#pragma unroll
    for (int sub = 0; sub < NSUB; ++sub)
#pragma unroll
        for (int r = 0; r < 16; ++r) { const float pv = FAST_EXP2(sc[sub][r] - mcur); sc[sub][r] = pv; ps += pv; }
    st.l += ps;
#pragma unroll
    for (int sub = 0; sub < NSUB; ++sub) {
        const bf16x8 pf0 = acc_frag(sc[sub], 0), pf1 = acc_frag(sc[sub], 1);
        const LAS bf16* vblk = V + (32 * sub + 4 * h + ((lane & 15) >> 2)) * AL_VP + 16 * ((lane >> 4) & 1) + 4 * (lane & 3);
#pragma unroll
        for (int dt = 0; dt < 4; ++dt) {
            const LAS bf16* vb = vblk + 32 * dt;
            u32x4 a0, a1; { const u32x2 x = LDS_TR16(vb), y = LDS_TR16(vb + 8 * AL_VP); a0 = (u32x4){x.x, x.y, y.x, y.y}; }
            { const u32x2 x = LDS_TR16(vb + 16 * AL_VP), y = LDS_TR16(vb + 24 * AL_VP); a1 = (u32x4){x.x, x.y, y.x, y.y}; }
            st.OT[dt] = MFMA32(__builtin_bit_cast(bf16x8, a0), pf0, st.OT[dt]);
            st.OT[dt] = MFMA32(__builtin_bit_cast(bf16x8, a1), pf1, st.OT[dt]);
        }
    }
}
__device__ __forceinline__ void att_init(AttState& st) {
#pragma unroll
    for (int dt = 0; dt < 4; ++dt)
#pragma unroll
        for (int r = 0; r < 16; ++r) st.OT[dt][r] = 0.f;
    st.m = -1e30f; st.l = 0.f;
}
__device__ __forceinline__ void att_load_q(bf16x8 (&qf)[8], const bf16* qrow  , int h) {
#pragma unroll
    for (int s = 0; s < 8; ++s) qf[s] = *(const bf16x8*)(qrow + 16 * s + 8 * h);
}
__device__ __forceinline__ void att_finish(AttState& st, bf16* orow  , int h) {
    const float lt = st.l + __shfl_xor(st.l, 32); const float inv = 1.0f / lt;
#pragma unroll
    for (int dt = 0; dt < 4; ++dt)
#pragma unroll
        for (int g = 0; g < 4; ++g) { u32x2 w; w.x = pk2(st.OT[dt][4 * g] * inv, st.OT[dt][4 * g + 1] * inv); w.y = pk2(st.OT[dt][4 * g + 2] * inv, st.OT[dt][4 * g + 3] * inv);
            *(u32x2*)(orow + 32 * dt + 8 * g + 4 * h) = w; }
}
__device__ __forceinline__ void att_load_bias(const AttP& p, LAS unsigned char* lds, int head, int tid) {
    LAS float* bias = (LAS float*)(lds + AL_BIAS);
    for (int i = tid; i < 2 * MAXREL + 1; i += 512) bias[i] = p.relb[head * (2 * MAXREL + 1) + i] * 1.4426950408889634f;
}
__device__ __forceinline__ void att_prompt_unit(const AttP& p, LAS unsigned char* lds, int g4, int head) {
    const int tid = tid_opaque(), lane = tid & 63, wid = RFL(tid >> 6), h = lane >> 5, l31 = lane & 31;
    const int cq = 4 * g4 + (wid >> 1), q0 = 64 * cq + 32 * (wid & 1);
    att_load_bias(p, lds, head, tid);
    bf16x8 qf[8]; att_load_q(qf, p.qkv + (size_t)(q0 + l31) * QKVP + head * 128, h);
    AttState st; att_init(st);
    const int kc0 = (4 * g4 - 8) > 0 ? (4 * g4 - 8) : 0, kc1 = 4 * g4 + 3;
    AttTileRegs R;
    att_load_bf16(R, p.qkv + (size_t)(64 * kc0) * QKVP + 2048 + head * 128, p.qkv + (size_t)(64 * kc0) * QKVP + 4096 + head * 128, QKVP, 64, tid);
    att_store_tile(R, lds, tid);
    WG_BARRIER();
    for (int kc = kc0; kc <= kc1; ++kc) {
        const int cur = (kc - kc0) & 1;
        if (kc < kc1) att_load_bf16(R, p.qkv + (size_t)(64 * (kc + 1)) * QKVP + 2048 + head * 128, p.qkv + (size_t)(64 * (kc + 1)) * QKVP + 4096 + head * 128, QKVP, 64, tid);
        if (kc >= cq - 8 && kc <= cq) att_tile<2>(st, qf, lds + cur * AL_TILE, lds, q0 - 64 * kc, lane);
        if (kc < kc1) att_store_tile(R, lds + (cur ^ 1) * AL_TILE, tid);
        WG_BARRIER();
    }
    att_finish(st, p.ao + (size_t)(q0 + l31) * DM + head * 128, h);
}
__device__ __forceinline__ void att_sample_unit(const AttP& p, LAS unsigned char* lds, int b, int head) {
    const int tid = tid_opaque(), lane = tid & 63, wid = RFL(tid >> 6), h = lane >> 5, l31 = lane & 31;
    const int row0 = SEQ + 32 * b;
    att_load_bias(p, lds, head, tid);
    bf16x8 qf[8]; AttState st;
    if (wid == 0) { att_load_q(qf, p.qkv + (size_t)(row0 + l31) * QKVP + head * 128, h); att_init(st); }
    const float* ck = p.cache_k + ((size_t)b * 512 * 16 + head) * 128; const float* cv = p.cache_v + ((size_t)b * 512 * 16 + head) * 128;
    AttTileRegs Ra, Rb;
#define ATT_SAMPLE_FETCH(R_, n_) do { const int n__ = (n_); if (n__ < 8) att_load_f32(R_, ck + (size_t)(64 * n__) * 2048, cv + (size_t)(64 * n__) * 2048, 2048, tid); \
        else if (n__ == 8) att_load_bf16(R_, p.qkv + (size_t)row0 * QKVP + 2048 + head * 128, p.qkv + (size_t)row0 * QKVP + 4096 + head * 128, QKVP, 32, tid); } while (0)
    att_load_f32(Ra, ck, cv, 2048, tid);
    att_store_tile(Ra, lds, tid);
    ATT_SAMPLE_FETCH(Ra, 1); ATT_SAMPLE_FETCH(Rb, 2);
    WG_BARRIER();
#pragma unroll 1
    for (int t = 0; t < 9; ++t) {
        const int cur = t & 1;
        if (wid == 0) att_tile<2>(st, qf, lds + cur * AL_TILE, lds, 512 - 64 * t, lane, t < 8 ? 64 : 32);
        if (t & 1) { if (t < 8) att_store_tile(Rb, lds + (cur ^ 1) * AL_TILE, tid); ATT_SAMPLE_FETCH(Rb, t + 3); }
        else { if (t < 8) att_store_tile(Ra, lds + (cur ^ 1) * AL_TILE, tid); ATT_SAMPLE_FETCH(Ra, t + 3); }
        WG_BARRIER();
    }
#undef ATT_SAMPLE_FETCH
    if (wid == 0) att_finish(st, p.ao + (size_t)(row0 + l31) * DM + head * 128, h);
}
#ifndef EMU
constexpr size_t MiB = 1u << 20;
constexpr size_t WS_CTL = 0, CTL_ZERO_BYTES = 1 * MiB;
constexpr size_t WS_BA = 1 * MiB;
constexpr size_t WS_DEC = 6 * MiB;
constexpr size_t WS_WIN = 7 * MiB;
constexpr size_t WS_WOUT = WS_WIN + 49 * MiB;
constexpr size_t WS_WGU = WS_WOUT + 16 * MiB;
constexpr size_t WS_WDN = WS_WGU + 44 * MiB;
constexpr size_t WS_XB = WS_WDN + 22 * MiB;
constexpr size_t WS_PROJ = WS_XB + 66 * MiB;
constexpr size_t WS_U = WS_PROJ + 396 * MiB;
constexpr size_t WS_WN = WS_U + 136 * MiB, WS_QG = WS_WN + 136 * MiB, WS_KG = WS_QG + 136 * MiB, WS_QK = WS_KG + 136 * MiB;
constexpr size_t WS_WIN_B = WS_QK + 68 * MiB;
constexpr size_t WS_WOUT_B = WS_WIN_B + 24 * MiB, WS_WGU_B = WS_WOUT_B + 8 * MiB, WS_WDN_B = WS_WGU_B + 44 * MiB;
constexpr size_t WS_SL = WS_WDN_B + 22 * MiB;
constexpr size_t WS_END = WS_SL + 2 * MiB;
constexpr size_t WS_R = WS_DEC + MiB / 2;
template <int layer> struct WB { static constexpr size_t WIN = (layer & 1) ? WS_WIN_B : WS_WIN, WOUT = (layer & 1) ? WS_WOUT_B : WS_WOUT, WGU = (layer & 1) ? WS_WGU_B : WS_WGU, WDN = (layer & 1) ? WS_WDN_B : WS_WDN; };
static_assert((size_t)GPROJ_PAD * DM * 2 <= 49 * MiB && (size_t)MTOK * DM * 2 <= 66 * MiB && (size_t)MTOK * PPITCH * 2 <= 396 * MiB && (size_t)NCIDX * 32 * 8192 * 2 <= 136 * MiB && (size_t)MTOK * 4096 * 2 <= 136 * MiB, "ws map");
constexpr int CW_BAR = 4096;
constexpr int LDS_MISC = 133120, LDS_ARGS = LDS_MISC + 64, LDS_BYTES = LDS_MISC + 512;
static_assert(PL_END <= LDS_MISC && 2 * SCAN_BUF <= LDS_MISC && AL_END <= LDS_MISC && 8 * WT_SCR <= LDS_MISC && pg8::STAGE_BYTES <= LDS_MISC, "LDS map");
constexpr size_t O_YP = 0, O_YS = 33554432, O_PREC = 34603008, O_PCONV = 35651584, O_PK = 35700736, O_PV = 37797888, O_SREC = 39895040, O_SCONV = 56672256, O_SK = 57458688, O_SV = 59555840, O_END = 61652992;

struct KArgs { const float* in[23]; float* out; unsigned char* ws; };
__device__ __forceinline__ unsigned long long ldarg_u64(LAS unsigned char* lds, int i) {
    volatile LAS unsigned* p = (volatile LAS unsigned*)(lds + LDS_ARGS) + 2 * i; const unsigned lo = RFL(p[0]), hi = RFL(p[1]); return ((unsigned long long)hi << 32) | lo; }
#define ARGF(i) ((const float*)(const __attribute__((address_space(1))) float*)ldarg_u64(lds, (i)))
#define ARGOUT() ((float*)ldarg_u64(lds, 23))
#define ARGWS() ((unsigned char*)ldarg_u64(lds, 24))
#define XHP() ((bf16*)(ARGOUT() + (size_t)SEQ * DM / 2))

#ifndef PROBE_REP_GEMM
#define PROBE_REP_GEMM 0
#endif
#ifndef PROBE_REP_GDN
#define PROBE_REP_GDN 0
#endif
#ifndef PROBE_REP_PREP
#define PROBE_REP_PREP PROBE_REP_GDN
#endif
#ifndef PROBE_REP_SCAN
#define PROBE_REP_SCAN PROBE_REP_GDN
#endif
#ifndef PROBE_REP_GATE
#define PROBE_REP_GATE PROBE_REP_GDN
#endif
#ifndef PROBE_REP_ATT
#define PROBE_REP_ATT 0
#endif
#ifndef PROBE_REP_THIN
#define PROBE_REP_THIN 0
#endif
#define PHASE_IDS() int G = G0, bid = bid0; LAS unsigned char* lds = lds0; asm volatile("" : "+s"(G), "+s"(bid), "+s"(lds)); const int tidp = tid_opaque(), lane = tidp & 63, wid = RFL(tidp >> 6), gw = bid * 8 + wid, NGW = G * 8; (void)lane; (void)gw; (void)NGW; (void)tidp
#define GRID_BAR() do { XcdBarrier b_ = bar; unsigned* bp_ = b_.bar; unsigned bx_ = b_.x; asm volatile("" : "+s"(bp_), "+s"(bx_)); b_.bar = bp_; b_.x = bx_; xcd_barrier(b_); } while (0)
#define WSP(T, off) ((T*)(ARGWS() + (off)))
#define PHASE_FN template <int layer> __device__ __forceinline__ void
#define PHASE_ARGS LAS unsigned char* const lds0, const int G0, const int bid0
template <int layer> __device__ __forceinline__ WtItem conv_item(LAS unsigned char* lds, int r) {
    constexpr int L_ = layer, J_ = layer >> 1;
#define WT_JOB(Wp, WTp, Kv, Nv, modev, scl) { const WtJob jb{(Wp), (WTp), (Kv), (Nv), (modev), (scl)}; const int nj = wt_items(jb); if (r < nj) return wt_item_of(jb, r); r -= nj; }
    if (L_ & 1) { WT_JOB(ARGF(15) + (size_t)J_ * DM * 3 * DM, WSP(bf16, WB<layer>::WIN), DM, 3 * DM, 0, ARGF(6) + (size_t)L_ * DM) WT_JOB(ARGF(18) + (size_t)J_ * DM * DM, WSP(bf16, WB<layer>::WOUT), DM, DM, 0, nullptr) }
    else { WT_JOB(ARGF(9) + (size_t)J_ * DM * GPROJ, WSP(bf16, WB<layer>::WIN), DM, GPROJ, 0, ARGF(6) + (size_t)L_ * DM) WT_JOB(ARGF(14) + (size_t)J_ * GZ * DM, WSP(bf16, WB<layer>::WOUT), GZ, DM, 0, nullptr) }
    WT_JOB(ARGF(20) + (size_t)L_ * DM * DFF, WSP(bf16, WB<layer>::WGU), DM, DFF, 1, ARGF(7) + (size_t)L_ * DM) WT_JOB(ARGF(21) + (size_t)L_ * DM * DFF, WSP(bf16, WB<layer>::WGU), DM, DFF, 2, ARGF(7) + (size_t)L_ * DM)
    { const WtJob jb{ARGF(22) + (size_t)L_ * DFF * DM, WSP(bf16, WB<layer>::WDN), DFF, DM, 0, nullptr}; return wt_item_of(jb, r); }
#undef WT_JOB
}
#ifndef CONV_PACE
#define CONV_PACE 64
#endif
template <int layer, int PART, bool PACED = false> __device__ __forceinline__ void convert_layer(LAS unsigned char* lds, int gwr, int nw, int wid, int lane, int tlin, int ntlin) {
    constexpr int nffn = 3 * (DM / 64) * (DFF / 64); constexpr int nmix = (layer & 1) ? (DM / 64) * (3 * DM / 64) + (DM / 64) * (DM / 64) : (DM / 64) * (GPROJ / 64) + (GZ / 64) * (DM / 64);
    constexpr int nfirst = (layer & 1) ? (DM / 64) * (3 * DM / 64) : (DM / 64) * (GPROJ / 64);
    constexpr int ibeg = PART == 1 ? nfirst : 0, iend = PART == 0 ? nfirst : nffn + nmix;
    LAS float* scr = (LAS float*)(lds + wid * WT_SCR);
    int it = ibeg + gwr; f32x4 va[16], vb[16]; float sa = 1.f, sb = 1.f;
    if (it < iend) { const WtItem I = conv_item<layer>(lds, it); wt_load(I, va, sa, lane); }
#pragma unroll 1
    while (it < iend) {
        const int nx = it + nw; const bool more = nx < iend;
        if (more) { const WtItem N = conv_item<layer>(lds, nx); wt_load(N, vb, sb, lane); }
        { const WtItem I = conv_item<layer>(lds, it); wt_store(I, va, sa, scr, lane); }
        if constexpr (PACED && CONV_PACE > 0) __builtin_amdgcn_s_sleep(CONV_PACE);
#pragma unroll
        for (int i = 0; i < 16; ++i) va[i] = vb[i];
        sa = sb;
        it = nx;
    }
    if (!(layer & 1) && PART != 1) { u32x4* z = (u32x4*)(WSP(bf16, WB<layer>::WIN) + (size_t)GPROJ * DM); const int nz = (GPROJ_PAD - GPROJ) * DM * 2 / 16; for (int i = tlin; i < nz; i += ntlin) z[i] = (u32x4){0u, 0u, 0u, 0u}; }
}
PHASE_FN ph_convert(PHASE_ARGS) { PHASE_IDS(); convert_layer<layer, 0>(lds, gw, NGW, wid, lane, bid * 512 + tidp, G * 512); }
PHASE_FN ph_rms_in(PHASE_ARGS) {
    PHASE_IDS(); const float* xp = ARGF(0); const float* xs = ARGF(1); float* xres = ARGOUT(); bf16* XB = WSP(bf16, WS_XB);
    cvt_rows(xp, nullptr, XHP(), WSP(float, WS_R), SEQ, gw, NGW, lane);
    cvt_rows(xs, xres + (size_t)SEQ * DM, XB + (size_t)SEQ * DM, WSP(float, WS_R) + SEQ, DECB * DECS, NGW - 1 - gw, NGW, lane);
}
PHASE_FN ph_smp(PHASE_ARGS) {
    PHASE_IDS(); const float* xres = ARGOUT(); bf16* XB = WSP(bf16, WS_XB);
    cvt_rows(xres + (size_t)SEQ * DM, nullptr, XB + (size_t)SEQ * DM, WSP(float, WS_R) + SEQ, DECB * DECS, NGW - 1 - gw, NGW, lane);
    slots_to_r(WSP(float, WS_SL), WSP(float, WS_R), SEQ, bid * 512 + tidp, G * 512);
}
__device__ __forceinline__ void ph_final(PHASE_ARGS, const XcdBarrier& bar) {
    PHASE_IDS(); float* xres = ARGOUT(); const float* nw = ARGF(8); const bf16* XH = XHP();
    u32x4 hold[4][4];
#pragma unroll
    for (int i = 0; i < 4; ++i) { const int m = SEQ / 2 + gw + NGW * i; if (m < SEQ) rms_h_load(XH, m, hold[i], lane); }
    rms_rows_h(XH, nw, nullptr, xres, SEQ / 2, gw, NGW, lane);
    rms_rows(xres + (size_t)SEQ * DM, nw, nullptr, nullptr, xres + (size_t)SEQ * DM, DECB * DECS, NGW - 1 - gw, NGW, lane);
    asm volatile("s_waitcnt vmcnt(0)" ::: "memory");
    GRID_BAR();
#pragma unroll
    for (int i = 0; i < 4; ++i) { const int m = SEQ / 2 + gw + NGW * i; if (m < SEQ) rms_h_finish(hold[i], nw, nullptr, xres, m, lane); }
}
PHASE_FN ph_g1(PHASE_ARGS) {
    PHASE_IDS(); pg8::Gemm g{XHP(), WSP(bf16, WB<layer>::WIN), MTOK, GPROJ_PAD, DM, DM, WSP(bf16, WS_XB) + (size_t)SEQ * DM, SEQ / 256, WSP(float, WS_R)}; pg8::StaticOrder S; S.init(MTOK, GPROJ_PAD, G, bid);
    pg8::EpiProj E{WSP(bf16, WS_PROJ), PPITCH, WSP(float, WS_BA), 12288};
    pg8::gemm_phase<pg8::EpiProj, pg8::StaticOrder, true, true, true>(lds, g, S, E);
}
#define MAKE_GDNP(gp) constexpr int j = layer >> 1; const float* in10_ = ARGF(10); const float* in11_ = ARGF(11); const float* in12_ = ARGF(12); const float* in3_ = ARGF(3); const float* in2_ = ARGF(2); float* out_ = ARGOUT(); unsigned char* ws_ = ARGWS(); \
        const GdnP gp{(const bf16*)(ws_ + WS_PROJ), (const float*)(ws_ + WS_BA), in10_ + (size_t)j * 4 * GQKV, in11_ + j * 32, in12_ + j * 32, in3_ + (size_t)j * DECB * 3 * GQKV, in2_ + (size_t)j * DECB * HV * 16384, \
                out_ + O_PCONV + (size_t)j * 3 * GQKV, out_ + O_SCONV + (size_t)j * DECB * 3 * GQKV, out_ + O_PREC + (size_t)j * HV * 16384, out_ + O_SREC + (size_t)j * DECB * HV * 16384, \
                (bf16*)(ws_ + WS_U), (bf16*)(ws_ + WS_WN), (bf16*)(ws_ + WS_QG), (bf16*)(ws_ + WS_KG), (bf16*)(ws_ + WS_QK), (float*)(ws_ + WS_DEC), (bf16*)(ws_ + WS_PROJ)}
PHASE_FN ph_prep(PHASE_ARGS) {
    PHASE_IDS(); MAKE_GDNP(gp);
    PrepIn<64> in; int u = bid;
    if (u < NCH * HK) gdn_prep_fetch<64>(gp, u >> 4, u & 15, in, lane, wid);
#pragma unroll 1
    for (; u < NCH * HK; u += G) { const int un = u + G; const bool more = un < NCH * HK;
        gdn_prep_unit<64>(gp, lds, u >> 4, u & 15, in, more ? (un >> 4) : -1, un & 15); }
#pragma unroll 1
    for (; u < NCH * HK + DECB * HK; u += G) gdn_prep_unit<32>(gp, lds, NCH + ((u - NCH * HK) >> 4), u & 15);
}
template <int layer, bool CONV> __device__ __forceinline__ void ph_scan_(PHASE_ARGS) {
    PHASE_IDS(); MAKE_GDNP(gp);
    if (bid < 4 * HV) { const int x = bid & 7, q = bid >> 3, hv = x + 8 * (q >> 2), vt = q & 3;
        gdn_scan_unit<2>(gp, lds, hv, vt, 0, NCH, nullptr, gp.out_prec + (size_t)hv * 16384, 0);
#ifdef PROBE_SCAN_TWICE
        gdn_scan_unit<2>(gp, lds, hv, vt, 0, NCH, nullptr, gp.out_prec + (size_t)hv * 16384, 0);
#endif
        }
    else {
#ifdef PROBE_OTHER_TWICE
#pragma unroll 1
      for (int rep_ = 0; rep_ < 2; ++rep_) {
#else
      {
#endif
#pragma unroll 1
        for (int u = bid - 4 * HV; u < DECB * HV * 4; u += G - 4 * HV) { const int b = u >> 7, hv = (u >> 2) & 31, vt = u & 3;
            gdn_scan_unit<1>(gp, lds, hv, vt, NCH + b, 1, gp.rec_state + ((size_t)b * HV + hv) * 16384, gp.out_srec + ((size_t)b * HV + hv) * 16384, SEQ + 32 * b); }
        if constexpr (CONV) {
            convert_layer<layer, 1, true>(lds, (bid - 4 * HV) * 8 + wid, (G - 4 * HV) * 8, wid, lane, (bid - 4 * HV) * 512 + tidp, (G - 4 * HV) * 512);
            if constexpr (layer + 1 < DEPTH) convert_layer<layer + 1, 2, true>(lds, (bid - 4 * HV) * 8 + wid, (G - 4 * HV) * 8, wid, lane, (bid - 4 * HV) * 512 + tidp, (G - 4 * HV) * 512); }
        __syncthreads();
      }
    }
}
PHASE_FN ph_scan(PHASE_ARGS) { ph_scan_<layer, true>(lds0, G0, bid0); }
PHASE_FN ph_scan_noconv(PHASE_ARGS) { ph_scan_<layer, false>(lds0, G0, bid0); }
PHASE_FN ph_gate(PHASE_ARGS) {
    PHASE_IDS(); constexpr int j = layer >> 1; const bf16* PROJ = WSP(bf16, WS_PROJ); bf16* OG = WSP(bf16, WS_U); const float* wn = ARGF(13) + j * 128;
    gdn_gate_rows(PROJ, wn, OG, gw, NGW, lane);
}
template <int KC, int SPL, bool DUMMY, bool FIRST = false> __device__ __forceinline__ void resid_gemm(PHASE_ARGS, size_t a_off, size_t b_off, int bias_arg, size_t bias_off) {
    PHASE_IDS(); pg8::Gemm g{WSP(bf16, a_off), WSP(bf16, b_off), SEQ, DM, KC, KC}; pg8::StaticOrder S; S.init(SEQ, DM, G, bid);
    float* X = DUMMY ? WSP(float, WS_END) : ARGOUT(); const float* bias = bias_arg >= 0 ? ARGF(bias_arg) + bias_off : nullptr;
    pg8::EpiResidH<FIRST> E{DUMMY ? WSP(bf16, WS_END) : XHP(), DM, bias, ARGF(0), WSP(float, WS_SL)};
    pg8::gemm_phase<pg8::EpiResidH<FIRST>, pg8::StaticOrder, true, true>(lds, g, S, E);
    __syncthreads();
    { constexpr int KS = KC / SPL; const int su = bid / SPL, ks = bid - su * SPL;
      pg8::Gemm g2{WSP(bf16, a_off) + ks * KS, WSP(bf16, b_off) + ks * KS, MTOK, DM, KS, KC}; const pg8::SingleUnit S2{64 + (su >> 3), su & 7, bid < 16 * SPL};
      pg8::EpiAtomic E2{X, DM, ks == 0 ? bias : nullptr};
      pg8::gemm_phase<pg8::EpiAtomic, pg8::SingleUnit, false, true>(lds, g2, S2, E2); }
}
template <int layer, bool DUMMY> __device__ __forceinline__ void ph_g5(PHASE_ARGS) { resid_gemm<GZ, 16, DUMMY, layer == 0>(lds0, G0, bid0, WS_U, WB<layer>::WOUT, -1, 0); }
PHASE_FN ph_a1(PHASE_ARGS) {
    PHASE_IDS(); constexpr int j = layer >> 1; pg8::Gemm g{XHP(), WSP(bf16, WB<layer>::WIN), MTOK, 3 * DM, DM, DM, WSP(bf16, WS_XB) + (size_t)SEQ * DM, SEQ / 256, WSP(float, WS_R)}; pg8::StaticOrder S; S.init(MTOK, 3 * DM, G, bid);
    static_assert(O_PV - O_PK == O_SV - O_SK, "k/v output spacing");
    pg8::EpiQkv E{WSP(bf16, WS_PROJ), QKVP, ARGF(16) + (size_t)j * 3 * DM, ARGOUT() + O_PK + (size_t)j * 512 * DM, (long)(O_PV - O_PK), (long)(O_SK - O_PK)};
    pg8::gemm_phase<pg8::EpiQkv, pg8::StaticOrder, true, true, true>(lds, g, S, E);
}
PHASE_FN ph_att(PHASE_ARGS) {
    PHASE_IDS(); constexpr int j = layer >> 1;
    const AttP ap{WSP(bf16, WS_PROJ), ARGF(4) + (size_t)j * DECB * 512 * DM, ARGF(5) + (size_t)j * DECB * 512 * DM, ARGF(17) + (size_t)j * AH * 513, WSP(bf16, WS_XB)};
#pragma unroll 1
    for (int u = bid; u < 64 * AH + DECB * AH; u += G) {
        if (u < 64 * AH) att_prompt_unit(ap, lds, u >> 4, u & 15);
        else att_sample_unit(ap, lds, (u - 64 * AH) >> 4, u & 15);
    }
}
template <int layer, bool DUMMY> __device__ __forceinline__ void ph_a3(PHASE_ARGS) { resid_gemm<DM, 8, DUMMY>(lds0, G0, bid0, WS_XB, WB<layer>::WOUT, 19, (size_t)(layer >> 1) * DM); }
PHASE_FN ph_f1(PHASE_ARGS) {
    PHASE_IDS(); pg8::Gemm g{XHP(), WSP(bf16, WB<layer>::WGU), MTOK, 2 * DFF, DM, DM, WSP(bf16, WS_XB) + (size_t)SEQ * DM, SEQ / 256, WSP(float, WS_R)}; pg8::StaticOrder S; S.init(MTOK, 2 * DFF, G, bid);
    pg8::EpiSwiglu E{WSP(bf16, WS_PROJ), DFF};
    pg8::gemm_phase<pg8::EpiSwiglu, pg8::StaticOrder, true, true, true>(lds, g, S, E);
}
template <int layer, bool DUMMY> __device__ __forceinline__ void ph_f2(PHASE_ARGS) { resid_gemm<DFF, 11, DUMMY>(lds0, G0, bid0, WS_PROJ, WB<layer>::WDN, -1, 0); }

#define PH(call, nrep) do { call(lds0, G0, bid0); GRID_BAR(); if constexpr ((nrep) >= 1) { call(lds0, G0, bid0); GRID_BAR(); } if constexpr ((nrep) >= 2) { call(lds0, G0, bid0); GRID_BAR(); } } while (0)
#define PH_RES(fn, nrep) do { fn<layer, false>(lds0, G0, bid0); GRID_BAR(); if constexpr ((nrep) >= 1) { fn<layer, true>(lds0, G0, bid0); GRID_BAR(); } if constexpr ((nrep) >= 2) { fn<layer, true>(lds0, G0, bid0); GRID_BAR(); } } while (0)
template <int layer>
__device__ __forceinline__ void layer_body(LAS unsigned char* const lds0, const int G0, const int bid0, const XcdBarrier& bar) {
    if constexpr ((layer & 1) == 0) {
        PH(ph_g1<layer>, PROBE_REP_GEMM);
        PH(ph_prep<layer>, PROBE_REP_PREP);
        PH(ph_scan<layer>, 0);
        if constexpr (PROBE_REP_SCAN >= 1) { ph_scan_noconv<layer>(lds0, G0, bid0); GRID_BAR(); }
        PH(ph_gate<layer>, PROBE_REP_GATE);
        PH_RES(ph_g5, PROBE_REP_GEMM);
    } else {
        PH(ph_a1<layer>, PROBE_REP_GEMM);
        PH(ph_att<layer>, PROBE_REP_ATT);
        PH_RES(ph_a3, PROBE_REP_GEMM);
    }
    { constexpr auto f0 = 0; (void)f0; }
    PH(ph_smp<layer>, PROBE_REP_THIN);
    PH(ph_f1<layer>, PROBE_REP_GEMM);
    PH_RES(ph_f2, PROBE_REP_GEMM);
    if constexpr (layer + 1 < DEPTH) {
        if constexpr (layer & 1) { ph_convert<layer + 1>(lds0, G0, bid0);
            if constexpr (PROBE_REP_THIN >= 1) ph_convert<layer + 1>(lds0, G0, bid0); }
        PH(ph_smp<layer>, PROBE_REP_THIN);
    } else {
        ph_final(lds0, G0, bid0, bar);
    }
}

__global__ void __launch_bounds__(512, 2) fwd_kernel(KArgs a) {
    extern __shared__ __attribute__((aligned(16))) unsigned char smem[];
    LAS unsigned char* const lds0 = (LAS unsigned char*)smem;
    const int tid = threadIdx.x;
    const int G0 = gridDim.x, bid0 = blockIdx.x;
    volatile LAS unsigned* MISC = (volatile LAS unsigned*)(lds0 + LDS_MISC);
    if (tid < 4) MISC[tid] = 0u;
    if (tid < 25) { const unsigned long long v = tid < 23 ? (unsigned long long)a.in[tid] : (tid == 23 ? (unsigned long long)a.out : (unsigned long long)a.ws);
        volatile LAS unsigned* p = (volatile LAS unsigned*)(lds0 + LDS_ARGS) + 2 * tid; p[0] = (unsigned)v; p[1] = (unsigned)(v >> 32); }
    __syncthreads();
    XcdBarrier bar = xcd_barrier_post((unsigned*)(a.ws + WS_CTL) + CW_BAR, MISC);
    ph_convert<0>(lds0, G0, bid0);
    if constexpr (PROBE_REP_THIN >= 1) ph_convert<0>(lds0, G0, bid0);
    PH(ph_rms_in<0>, PROBE_REP_THIN);
    layer_body<0>(lds0, G0, bid0, bar);
    layer_body<1>(lds0, G0, bid0, bar);
    layer_body<2>(lds0, G0, bid0, bar);
    layer_body<3>(lds0, G0, bid0, bar);
}

extern "C" void kernel_launch(void* const* d_in, const int* in_sizes, int n_in, void* d_out, int out_size, void* d_ws, size_t ws_size, hipStream_t stream) {
    static int grid = 0;
    if (grid == 0) {
        if (n_in != 23 || (size_t)out_size != O_END || ws_size < WS_END + ((PROBE_REP_GEMM > 0) ? (size_t)MTOK * DM * 4 : 0)) { fprintf(stderr, "kernel_launch: unexpected sizes (n_in %d out %d ws %zu, need ws %zu)\n", n_in, out_size, ws_size, (size_t)WS_END); grid = -1; return; }
        int dev = 0, cus = 0;
        if (hipGetDevice(&dev) != hipSuccess || hipDeviceGetAttribute(&cus, hipDeviceAttributeMultiprocessorCount, dev) != hipSuccess) { grid = -1; return; }
        if (hipFuncSetAttribute((const void*)fwd_kernel, hipFuncAttributeMaxDynamicSharedMemorySize, LDS_BYTES) != hipSuccess) { fprintf(stderr, "kernel_launch: hipFuncSetAttribute failed\n"); grid = -1; return; }
        int per_cu = 0;
        if (hipOccupancyMaxActiveBlocksPerMultiprocessor(&per_cu, (const void*)fwd_kernel, 512, LDS_BYTES) != hipSuccess || per_cu < 1) fprintf(stderr, "kernel_launch: occupancy query says %d\n", per_cu);
        (void)hipGetLastError();
        if (cus * 8 * 4 < SEQ / 2) { fprintf(stderr, "kernel_launch: %d CUs: the final norm holds 4 rows per wave\n", cus); grid = -1; return; }
        grid = cus;
    }
    if (grid < 0) return;
    if (hipMemsetAsync((char*)d_ws + WS_CTL, 0, CTL_ZERO_BYTES, stream) != hipSuccess) return;
    KArgs a{};
    for (int i = 0; i < 23; ++i) a.in[i] = (const float*)d_in[i];
    a.out = (float*)d_out; a.ws = (unsigned char*)d_ws;
    hipLaunchKernelGGL(fwd_kernel, dim3(grid), dim3(512), LDS_BYTES, stream, a);
}
#endif
```
